# Optimizing an MI355X kernel written in HIP

```python
import math
import jax, jax.numpy as jnp
from jax import lax
import numpy as np

D_MODEL = 2048
BATCH = 2
SEQ = 4096
DEPTH = 1

MLA_HEADS = 8
MLA_Q_RANK = 512
MLA_KV_RANK = 256
MLA_NOPE_DIM = 128
MLA_ROPE_DIM = 64
MLA_V_DIM = 128
ROPE_THETA = 10000.0
MOBA_HEADS = 8
MOBA_HEAD_DIM = 128
MOBA_BLOCK = 256
MOBA_TOPK = 3
Q_BLOCK = 128
T5_BUCKETS = 32
T5_MAX_DISTANCE = 128
MOE_GROUPS = 4
MOE_EXPERTS_PER_GROUP = 8
MOE_N_EXPERTS = MOE_GROUPS * MOE_EXPERTS_PER_GROUP
MOE_TOPK = 2
MOE_D_FF = 512
LN_EPS = 1e-5
RMS_EPS = 1e-6
DEEPNORM_ALPHA = (2.0 * DEPTH) ** 0.25
DEEPNORM_BETA = (8.0 * DEPTH) ** -0.25
MLA_WIDTH = MLA_HEADS * MLA_V_DIM
MOBA_WIDTH = MOBA_HEADS * MOBA_HEAD_DIM
MIX_WIDTH = MLA_WIDTH + MOBA_WIDTH
IN_SPLITS = [MLA_Q_RANK,
             MLA_Q_RANK + MLA_KV_RANK,
             MLA_Q_RANK + MLA_KV_RANK + MLA_ROPE_DIM,
             MLA_Q_RANK + MLA_KV_RANK + MLA_ROPE_DIM + MOBA_WIDTH,
             MLA_Q_RANK + MLA_KV_RANK + MLA_ROPE_DIM + 2 * MOBA_WIDTH]
IN_COLS = MLA_Q_RANK + MLA_KV_RANK + MLA_ROPE_DIM + 3 * MOBA_WIDTH

kernel_name = "hymba_mla_moba_hiermoe_deepnorm_adaln"


def layer_norm_noaffine(x):
    xf = x.astype(jnp.float32)
    mu = xf.mean(-1, keepdims=True)
    var = jnp.square(xf - mu).mean(-1, keepdims=True)
    return (xf - mu) * lax.rsqrt(var + LN_EPS)


def layer_norm(x, g, b):
    return (layer_norm_noaffine(x) * g + b).astype(x.dtype)


def rms_norm(x, g):
    xf = x.astype(jnp.float32)
    return (xf * lax.rsqrt(jnp.square(xf).mean(-1, keepdims=True) + RMS_EPS) * g).astype(x.dtype)


def rope_tables(S):
    inv = 1.0 / (ROPE_THETA ** (jnp.arange(0, MLA_ROPE_DIM, 2, dtype=jnp.float32) / MLA_ROPE_DIM))
    ang = jnp.arange(S, dtype=jnp.float32)[:, None] * inv[None, :]
    return jnp.cos(ang), jnp.sin(ang)


def apply_rope(x, cos, sin):
    x1, x2 = jnp.split(x.astype(jnp.float32), 2, axis=-1)
    return jnp.concatenate([x1 * cos - x2 * sin, x1 * sin + x2 * cos], axis=-1).astype(x.dtype)


def t5_bucket(rel):
    n = jnp.maximum(rel, 0)
    max_exact = T5_BUCKETS // 2
    nf = jnp.maximum(n, 1).astype(jnp.float32)
    large = max_exact + (jnp.log(nf / max_exact) / math.log(T5_MAX_DISTANCE / max_exact)
                         * (T5_BUCKETS - max_exact)).astype(jnp.int32)
    large = jnp.minimum(large, T5_BUCKETS - 1)
    return jnp.where(n < max_exact, n, large)


def mla_attention(q_nope, q_rope, k_nope, k_rope, v):
    B, S, H, Dn = q_nope.shape
    nqb = S // Q_BLOCK
    scale = 1.0 / math.sqrt(MLA_NOPE_DIM + MLA_ROPE_DIM)
    qn = q_nope.reshape(B, nqb, Q_BLOCK, H, Dn).transpose(1, 0, 2, 3, 4)
    qr = q_rope.reshape(B, nqb, Q_BLOCK, H, MLA_ROPE_DIM).transpose(1, 0, 2, 3, 4)
    kpos = jnp.arange(S)

    def attend_block(args):
        qn_b, qr_b, i = args
        s = (jnp.einsum('bqhd,bkhd->bhqk', qn_b, k_nope)
             + jnp.einsum('bqhd,bkd->bhqk', qr_b, k_rope)).astype(jnp.float32) * scale
        qpos = i * Q_BLOCK + jnp.arange(Q_BLOCK)
        s = jnp.where(kpos[None, :] <= qpos[:, None], s, -jnp.inf)
        p = jax.nn.softmax(s, axis=-1).astype(v.dtype)
        return jnp.einsum('bhqk,bkhd->bqhd', p, v)

    out = lax.map(attend_block, (qn, qr, jnp.arange(nqb)))
    return out.transpose(1, 0, 2, 3, 4).reshape(B, S, H * MLA_V_DIM)


def moba_attention(q, k, v, t5_table):
    B, S, H, Dh = q.shape
    nb = max(-(-S // MOBA_BLOCK), MOBA_TOPK)
    s_pad = nb * MOBA_BLOCK
    nqb = S // Q_BLOCK
    scale = 1.0 / math.sqrt(Dh)
    qf = q.transpose(0, 2, 1, 3).reshape(B * H, S, Dh)
    kf = k.transpose(0, 2, 1, 3).reshape(B * H, S, Dh)
    vf = v.transpose(0, 2, 1, 3).reshape(B * H, S, Dh)
    pad = ((0, 0), (0, s_pad - S), (0, 0))
    kb = jnp.pad(kf, pad).reshape(B * H, nb, MOBA_BLOCK, Dh)
    vb = jnp.pad(vf, pad).reshape(B * H, nb, MOBA_BLOCK, Dh)
    k_mean = kb.astype(jnp.float32).mean(axis=2)
    gate = jnp.einsum('zsd,znd->zsn', qf.astype(jnp.float32), k_mean)
    q_blk = jnp.arange(S) // MOBA_BLOCK
    fully_past = jnp.arange(nb)[None, :] < q_blk[:, None]
    gate = jnp.where(fully_past[None], gate, -jnp.inf)
    _, top_idx = lax.top_k(gate, MOBA_TOPK)
    sel = jnp.concatenate(
        [top_idx, jnp.broadcast_to(q_blk[None, :, None], (B * H, S, 1))], axis=-1)
    n_items = B * H * nqb
    xs = (qf.reshape(n_items, Q_BLOCK, Dh),
          sel.reshape(n_items, Q_BLOCK, MOBA_TOPK + 1),
          jnp.repeat(jnp.arange(B * H), nqb),
          jnp.tile(jnp.arange(nqb), B * H))
    offs = jnp.arange(MOBA_BLOCK)
    slot_rank = jnp.arange(MOBA_TOPK + 1)

    def attend_block(args):
        q_b, sel_b, bh, i = args
        kg = kb[bh, sel_b].reshape(Q_BLOCK, (MOBA_TOPK + 1) * MOBA_BLOCK, Dh)
        vg = vb[bh, sel_b].reshape(Q_BLOCK, (MOBA_TOPK + 1) * MOBA_BLOCK, Dh)
        qpos = i * Q_BLOCK + jnp.arange(Q_BLOCK)
        kpos = (sel_b[:, :, None] * MOBA_BLOCK + offs).reshape(Q_BLOCK, -1)
        slot_ok = (slot_rank[None, :] < (qpos // MOBA_BLOCK)[:, None]) | (slot_rank[None, :] == MOBA_TOPK)
        mask = jnp.repeat(slot_ok, MOBA_BLOCK, axis=1) & (kpos <= qpos[:, None])
        bias = t5_table[t5_bucket(qpos[:, None] - kpos), bh % H].astype(jnp.float32)
        s = jnp.einsum('qd,qkd->qk', q_b, kg).astype(jnp.float32) * scale + bias
        s = jnp.where(mask, s, -jnp.inf)
        p = jax.nn.softmax(s, axis=-1).astype(vg.dtype)
        return jnp.einsum('qk,qkd->qd', p, vg)

    out = lax.map(attend_block, xs)
    return out.reshape(B, H, S, Dh).transpose(0, 2, 1, 3).reshape(B, S, H * Dh)


def mixer(h, w_in, q_norm_g, w_uq, kv_norm_g, w_ukv, w_out, t5_table, cos, sin):
    B, S, _ = h.shape
    proj = h @ w_in
    c_q, c_kv, k_rope, q_mo, k_mo, v_mo = jnp.split(proj, IN_SPLITS, axis=-1)
    q = (rms_norm(c_q, q_norm_g) @ w_uq).reshape(B, S, MLA_HEADS, MLA_NOPE_DIM + MLA_ROPE_DIM)
    q_nope, q_rope = q[..., :MLA_NOPE_DIM], q[..., MLA_NOPE_DIM:]
    kv = (rms_norm(c_kv, kv_norm_g) @ w_ukv).reshape(B, S, MLA_HEADS, MLA_NOPE_DIM + MLA_V_DIM)
    k_nope, v = kv[..., :MLA_NOPE_DIM], kv[..., MLA_NOPE_DIM:]
    q_rope = apply_rope(q_rope, cos[None, :, None, :], sin[None, :, None, :])
    k_rope = apply_rope(k_rope, cos[None], sin[None])
    o_mla = mla_attention(q_nope, q_rope, k_nope, k_rope, v)
    shp = (B, S, MOBA_HEADS, MOBA_HEAD_DIM)
    o_moba = moba_attention(q_mo.reshape(shp), k_mo.reshape(shp), v_mo.reshape(shp), t5_table)
    return jnp.concatenate([o_mla, o_moba], axis=-1) @ w_out


def hier_moe(h, w_rg, b_rg, w_re, b_re, w1, w3, w2):
    B, S, D = h.shape
    T = B * S
    hf = h.reshape(T, D)
    g_prob = jax.nn.softmax((hf @ w_rg + b_rg).astype(jnp.float32), axis=-1)
    g_p, g_idx = lax.top_k(g_prob, 1)
    e_logits = (hf @ w_re + b_re).astype(jnp.float32).reshape(T, MOE_GROUPS, MOE_EXPERTS_PER_GROUP)
    idx = jnp.broadcast_to(g_idx[:, :, None], (T, 1, MOE_EXPERTS_PER_GROUP))
    e_sel = jnp.take_along_axis(e_logits, idx, axis=1)[:, 0]
    e_p, e_idx = lax.top_k(jax.nn.softmax(e_sel, axis=-1), MOE_TOPK)
    e_p = e_p / e_p.sum(-1, keepdims=True)
    weights = g_p * e_p
    expert_id = g_idx * MOE_EXPERTS_PER_GROUP + e_idx
    gates = jnp.zeros((T, MOE_N_EXPERTS), jnp.float32).at[
        jnp.arange(T)[:, None], expert_id].add(weights).astype(h.dtype)
    hid = jax.nn.silu(jnp.einsum('td,edf->tef', hf, w1)) * jnp.einsum('td,edf->tef', hf, w3)
    y = jnp.einsum('tef,efd->td', hid * gates[:, :, None], w2)
    return y.reshape(B, S, D)


def setup_inputs(seed: int = 0) -> dict:
    key = jax.random.key(seed)
    ks = jax.random.split(key, 24)

    def nrm(k, shape, scale):
        return jax.random.normal(k, shape, jnp.float32) * scale

    D = D_MODEL
    return {
        "x": nrm(ks[0], (BATCH, SEQ, D), 1.0),
        "c": nrm(ks[1], (BATCH, D), 1.0),
        "w_ada": nrm(ks[2], (DEPTH, D, 6 * D), 0.5 * D ** -0.5),
        "b_ada": nrm(ks[3], (DEPTH, 6 * D), 0.01),
        "w_in": nrm(ks[4], (DEPTH, D, IN_COLS), D ** -0.5),
        "q_norm_g": 1.0 + nrm(ks[5], (DEPTH, MLA_Q_RANK), 0.01),
        "w_uq": nrm(ks[6], (DEPTH, MLA_Q_RANK, MLA_HEADS * (MLA_NOPE_DIM + MLA_ROPE_DIM)), MLA_Q_RANK ** -0.5),
        "kv_norm_g": 1.0 + nrm(ks[7], (DEPTH, MLA_KV_RANK), 0.01),
        "w_ukv": nrm(ks[8], (DEPTH, MLA_KV_RANK, MLA_HEADS * (MLA_NOPE_DIM + MLA_V_DIM)), MLA_KV_RANK ** -0.5),
        "w_out": nrm(ks[9], (DEPTH, MIX_WIDTH, D), DEEPNORM_BETA * MIX_WIDTH ** -0.5),
        "t5_table": nrm(ks[10], (T5_BUCKETS, MOBA_HEADS), 0.5),
        "ln1_g": 1.0 + nrm(ks[11], (DEPTH, D), 0.01),
        "ln1_b": nrm(ks[12], (DEPTH, D), 0.01),
        "w_router_group": nrm(ks[13], (DEPTH, D, MOE_GROUPS), D ** -0.5),
        "b_router_group": nrm(ks[14], (DEPTH, MOE_GROUPS), 0.01),
        "w_router_expert": nrm(ks[15], (DEPTH, D, MOE_N_EXPERTS), D ** -0.5),
        "b_router_expert": nrm(ks[16], (DEPTH, MOE_N_EXPERTS), 0.01),
        "w1": nrm(ks[17], (DEPTH, MOE_N_EXPERTS, D, MOE_D_FF), D ** -0.5),
        "w3": nrm(ks[18], (DEPTH, MOE_N_EXPERTS, D, MOE_D_FF), D ** -0.5),
        "w2": nrm(ks[19], (DEPTH, MOE_N_EXPERTS, MOE_D_FF, D), DEEPNORM_BETA * MOE_D_FF ** -0.5),
        "ln2_g": 1.0 + nrm(ks[20], (DEPTH, D), 0.01),
        "ln2_b": nrm(ks[21], (DEPTH, D), 0.01),
    }


def reference(x, c, w_ada, b_ada, w_in, q_norm_g, w_uq, kv_norm_g, w_ukv, w_out, t5_table,
              ln1_g, ln1_b, w_router_group, b_router_group, w_router_expert, b_router_expert,
              w1, w3, w2, ln2_g, ln2_b):
    S = x.shape[1]
    cos, sin = rope_tables(S)
    c_act = jax.nn.silu(c)
    for l in range(DEPTH):
        mod = c_act @ w_ada[l] + b_ada[l]
        sh1, sc1, g1, sh2, sc2, g2 = [m[:, None, :] for m in jnp.split(mod, 6, axis=-1)]
        h = (layer_norm_noaffine(x) * (1.0 + sc1) + sh1).astype(x.dtype)
        y = mixer(h, w_in[l], q_norm_g[l], w_uq[l], kv_norm_g[l], w_ukv[l], w_out[l], t5_table, cos, sin)
        x = layer_norm(DEEPNORM_ALPHA * x + g1 * y, ln1_g[l], ln1_b[l])
        h = (layer_norm_noaffine(x) * (1.0 + sc2) + sh2).astype(x.dtype)
        y = hier_moe(h, w_router_group[l], b_router_group[l], w_router_expert[l], b_router_expert[l],
                     w1[l], w3[l], w2[l])
        x = layer_norm(DEEPNORM_ALPHA * x + g2 * y, ln2_g[l], ln2_b[l])
    return x
```

```cpp
#include <hip/hip_runtime.h>
#include <cstdio>
#include <cstdint>

#define LAS __attribute__((address_space(3)))
typedef unsigned short bf16;
typedef float f32x4 __attribute__((ext_vector_type(4)));
typedef unsigned u32x4 __attribute__((ext_vector_type(4)));
typedef unsigned u32x2 __attribute__((ext_vector_type(2)));

constexpr int NB = 2, SEQ = 4096, DM = 2048, NT = NB * SEQ;
constexpr int QR = 512, KVR = 256, NH = 8, QHD = 192, MBLK = 256, NBLK = 16;
constexpr int INCOLS = 3904, PROJ_N = 4096, MODN = 6 * DM;
constexpr int NE = 32, FF = 512;
constexpr float LN_EPS = 1e-5f, RMS_EPS = 1e-6f;
constexpr float ALPHA = 1.189207115002721f;
constexpr int MOD_SH1 = 0, MOD_SC1 = DM, MOD_G1 = 2 * DM, MOD_SH2 = 3 * DM, MOD_SC2 = 4 * DM, MOD_G2 = 5 * DM;
constexpr int PC_KR = 768, PC_QMO = 1024, PC_KMO = 2048, PC_VMO = 3072;

constexpr size_t MiB = 1u << 20;
constexpr size_t WS_CTL = 0, CTL_ZERO_BYTES = 1 * MiB;
constexpr size_t WS_MOD = 1 * MiB;
constexpr size_t WS_ROPE = 2 * MiB;
constexpr size_t WS_KMEAN = 3 * MiB;
constexpr size_t WS_SS = 3 * MiB + 512 * 1024;
constexpr size_t WS_ROUTE = 4 * MiB;
constexpr size_t WS_LIST = 5 * MiB;
constexpr size_t WS_WIN = 8 * MiB;
constexpr size_t WS_WUQ = 24 * MiB;
constexpr size_t WS_WUKV = 26 * MiB;
constexpr size_t WS_WOUT = 28 * MiB;
constexpr size_t WS_W13 = 40 * MiB;
constexpr size_t WS_W2 = 168 * MiB;
constexpr size_t WS_H = 232 * MiB;
constexpr size_t WS_PROJ = 264 * MiB;
constexpr size_t WS_QM = 328 * MiB;
constexpr size_t WS_KV = 352 * MiB;
constexpr size_t WS_ATT = 384 * MiB;
constexpr size_t WS_X1 = 416 * MiB;
constexpr size_t WS_END = 480 * MiB;
constexpr int CW_CNT = 64;

__device__ __forceinline__ unsigned f2bf(float f) { unsigned u = __builtin_bit_cast(unsigned, f); return (u + 0x7fffu + ((u >> 16) & 1u)) >> 16; }
__device__ __forceinline__ float bf2f(unsigned b) { return __builtin_bit_cast(float, b << 16); }
__device__ __forceinline__ unsigned pk2(float lo, float hi) { return f2bf(lo) | (f2bf(hi) << 16); }
__device__ __forceinline__ float wave_sum(float v) {
#pragma unroll
    for (int o = 1; o < 64; o <<= 1) v += __shfl_xor(v, o);
    return v;
}
__device__ __forceinline__ float wave_max(float v) {
#pragma unroll
    for (int o = 1; o < 64; o <<= 1) v = fmaxf(v, __shfl_xor(v, o));
    return v;
}
__device__ __forceinline__ float silu_f(float v) { return v / (1.f + __expf(-v)); }
__device__ __forceinline__ int t5_bucket(int n) {
    if (n < 16) return n;
    int l = 16 + (int)(logf((float)n / 16.f) / 2.0794415416798357f * 16.f);
    return l < 31 ? l : 31;
}
__device__ __forceinline__ int moe_rowbase(const unsigned* cnt, int e) { int s = 0; for (int i = 0; i < e; ++i) s += (int)((cnt[i] + 255u) >> 8) << 8; return s; }

struct Args {
    const float *x, *c, *w_ada, *b_ada, *w_in, *qg, *w_uq, *kvg, *w_ukv, *w_out, *t5, *ln1g, *ln1b, *w_rg, *b_rg, *w_re, *b_re, *w1, *w3, *w2, *ln2g, *ln2b;
    float* out; unsigned char* ws;
};


__device__ __forceinline__ void ph_mod(const Args& a, LAS float* sm, int wg, int nwg) {
    const int tid = threadIdx.x, lane = tid & 63, w = tid >> 6;
    float* MOD = (float*)(a.ws + WS_MOD);
    LAS float* sc = sm;
    LAS float* red = sm + 2 * DM;
    if (wg >= 192) return;
    for (int i = tid; i < 2 * DM; i += 512) sc[i] = silu_f(a.c[i]);
    __syncthreads();
    for (int cg = wg; cg < 192; cg += nwg) {
        const int c4 = lane & 15, ksub = lane >> 4, col = cg * 64 + 4 * c4;
        f32x4 a0 = {0.f, 0.f, 0.f, 0.f}, a1 = {0.f, 0.f, 0.f, 0.f};
#pragma unroll 8
        for (int it = 0; it < 64; ++it) {
            const int k = w * 256 + it * 4 + ksub;
            const f32x4 wv = *(const f32x4*)(a.w_ada + (size_t)k * MODN + col);
            a0 += wv * sc[k]; a1 += wv * sc[DM + k];
        }
#pragma unroll
        for (int j = 0; j < 4; ++j) { a0[j] += __shfl_xor(a0[j], 16); a0[j] += __shfl_xor(a0[j], 32); a1[j] += __shfl_xor(a1[j], 16); a1[j] += __shfl_xor(a1[j], 32); }
        if (ksub == 0) {
#pragma unroll
            for (int j = 0; j < 4; ++j) { red[(w * 2 + 0) * 64 + 4 * c4 + j] = a0[j]; red[(w * 2 + 1) * 64 + 4 * c4 + j] = a1[j]; }
        }
        __syncthreads();
        if (tid < 128) { const int b = tid >> 6, cc = tid & 63; float s = 0.f;
#pragma unroll
            for (int ww = 0; ww < 8; ++ww) s += red[(ww * 2 + b) * 64 + cc];
            MOD[b * MODN + cg * 64 + cc] = s + a.b_ada[cg * 64 + cc]; }
        __syncthreads();
    }
}
__device__ __forceinline__ void ph_rope_table(const Args& a, int wg, int nwg) {
    float* RT = (float*)(a.ws + WS_ROPE);
    for (int idx = wg * 512 + threadIdx.x; idx < SEQ * 32; idx += nwg * 512) {
        const int pos = idx >> 5, i = idx & 31;
        const float inv = 1.0f / powf(10000.0f, (float)(2 * i) / 64.0f);
        const float ang = (float)pos * inv;
        const double ad = (double)ang, q = rint(ad * 0.6366197723675814), r = ad - q * 1.5707963267948966;
        const int qi = ((int)q) & 3; const float rf = (float)r, r2 = rf * rf;
        const float s = rf * (1.f + r2 * (-1.6666667e-1f + r2 * (8.3333333e-3f + r2 * (-1.9841270e-4f + r2 * 2.7557319e-6f))));
        const float c = 1.f + r2 * (-0.5f + r2 * (4.1666667e-2f + r2 * (-1.3888889e-3f + r2 * (2.4801587e-5f + r2 * (-2.7557319e-7f)))));
        float cs, sn;
        if (qi == 0) { cs = c; sn = s; } else if (qi == 1) { cs = -s; sn = c; } else if (qi == 2) { cs = -c; sn = -s; } else { cs = s; sn = -c; }
        RT[2 * idx] = cs; RT[2 * idx + 1] = sn;
    }
}
__device__ __forceinline__ void ph_ln0(const Args& a, int wg, int nwg) {
    const int lane = threadIdx.x & 63, gw = wg * 8 + (threadIdx.x >> 6), NGW = nwg * 8;
    const float* MOD = (const float*)(a.ws + WS_MOD); bf16* H = (bf16*)(a.ws + WS_H);
    for (int b = 0; b < NB; ++b) {
        f32x4 sc[8], sh[8];
#pragma unroll
        for (int j = 0; j < 8; ++j) { sc[j] = *(const f32x4*)(MOD + b * MODN + MOD_SC1 + 4 * lane + 256 * j) + 1.0f; sh[j] = *(const f32x4*)(MOD + b * MODN + MOD_SH1 + 4 * lane + 256 * j); }
        for (int r = gw; r < SEQ; r += NGW) {
            const size_t row = (size_t)b * SEQ + r;
            const float* xr = a.x + row * DM + 4 * lane;
            f32x4 v[8]; float s = 0.f;
#pragma unroll
            for (int j = 0; j < 8; ++j) { v[j] = *(const f32x4*)(xr + 256 * j); s += (v[j][0] + v[j][1]) + (v[j][2] + v[j][3]); }
            const float mean = wave_sum(s) * (1.f / DM); float s2 = 0.f;
#pragma unroll
            for (int j = 0; j < 8; ++j) { v[j] = v[j] - mean; s2 += (v[j][0] * v[j][0] + v[j][1] * v[j][1]) + (v[j][2] * v[j][2] + v[j][3] * v[j][3]); }
            const float rstd = 1.0f / sqrtf(wave_sum(s2) * (1.f / DM) + LN_EPS);
            bf16* hr = H + row * DM + 4 * lane;
#pragma unroll
            for (int j = 0; j < 8; ++j) { const f32x4 o = v[j] * rstd * sc[j] + sh[j]; u32x2 w; w.x = pk2(o[0], o[1]); w.y = pk2(o[2], o[3]); *(u32x2*)(hr + 256 * j) = w; }
        }
    }
}
__device__ __forceinline__ void ph_kmean(const Args& a, int wg, int nwg) {
    const int lane = threadIdx.x & 63, gw = wg * 8 + (threadIdx.x >> 6), NGW = nwg * 8;
    const bf16* PROJ = (const bf16*)(a.ws + WS_PROJ); float* KM = (float*)(a.ws + WS_KMEAN);
    for (int t = gw; t < 16 * NBLK; t += NGW) {
        const int bh = t >> 4, blk = t & 15, b = bh >> 3, h = bh & 7;
        const bf16* p = PROJ + ((size_t)b * SEQ + blk * MBLK) * PROJ_N + PC_KMO + h * 128 + 2 * lane;
        float s0 = 0.f, s1 = 0.f;
#pragma unroll 8
        for (int r = 0; r < MBLK; ++r) { const unsigned u = *(const unsigned*)(p + (size_t)r * PROJ_N); s0 += bf2f(u & 0xffffu); s1 += bf2f(u >> 16); }
        KM[(size_t)t * 128 + 2 * lane] = s0 * (1.f / MBLK); KM[(size_t)t * 128 + 2 * lane + 1] = s1 * (1.f / MBLK);
    }
}
constexpr int P6_LDS = 131072 + 16 * 36 * 4;
__device__ __forceinline__ void ph_ln1_route(const Args& a, LAS unsigned char* lds, int wg, int nwg) {
    const int tid = threadIdx.x, lane = tid & 63, w = tid >> 6;
    const float* MOD = (const float*)(a.ws + WS_MOD); bf16* H = (bf16*)(a.ws + WS_H); float* X1 = (float*)(a.ws + WS_X1);
    int* EID = (int*)(a.ws + WS_ROUTE); float* WGT = (float*)(a.ws + WS_ROUTE + 65536); int* LIST = (int*)(a.ws + WS_LIST);
    unsigned* CNT = (unsigned*)(a.ws + WS_CTL) + CW_CNT;
    LAS float* hrow = (LAS float*)lds; LAS float* LG = (LAS float*)(lds + 131072);
    for (int r0 = wg * 16; r0 < NT; r0 += nwg * 16) {
        const int b = r0 / SEQ;
        for (int rr = 0; rr < 2; ++rr) {
            const int row = r0 + 2 * w + rr;
            float* xr = X1 + (size_t)row * DM + 4 * lane;
            f32x4 v[8]; float s = 0.f;
#pragma unroll
            for (int j = 0; j < 8; ++j) { v[j] = *(const f32x4*)(xr + 256 * j); s += (v[j][0] + v[j][1]) + (v[j][2] + v[j][3]); }
            float mean = wave_sum(s) * (1.f / DM), s2 = 0.f;
#pragma unroll
            for (int j = 0; j < 8; ++j) { v[j] = v[j] - mean; s2 += (v[j][0] * v[j][0] + v[j][1] * v[j][1]) + (v[j][2] * v[j][2] + v[j][3] * v[j][3]); }
            float rstd = 1.0f / sqrtf(wave_sum(s2) * (1.f / DM) + LN_EPS);
            s = 0.f;
#pragma unroll
            for (int j = 0; j < 8; ++j) { const f32x4 g = *(const f32x4*)(a.ln1g + 4 * lane + 256 * j), bb = *(const f32x4*)(a.ln1b + 4 * lane + 256 * j);
                v[j] = v[j] * rstd * g + bb; *(f32x4*)(xr + 256 * j) = v[j]; s += (v[j][0] + v[j][1]) + (v[j][2] + v[j][3]); }
            mean = wave_sum(s) * (1.f / DM); s2 = 0.f;
#pragma unroll
            for (int j = 0; j < 8; ++j) { v[j] = v[j] - mean; s2 += (v[j][0] * v[j][0] + v[j][1] * v[j][1]) + (v[j][2] * v[j][2] + v[j][3] * v[j][3]); }
            rstd = 1.0f / sqrtf(wave_sum(s2) * (1.f / DM) + LN_EPS);
            bf16* hr = H + (size_t)row * DM + 4 * lane; LAS float* hl = hrow + (2 * w + rr) * DM + 4 * lane;
#pragma unroll
            for (int j = 0; j < 8; ++j) { const f32x4 sc = *(const f32x4*)(MOD + b * MODN + MOD_SC2 + 4 * lane + 256 * j) + 1.0f, sh = *(const f32x4*)(MOD + b * MODN + MOD_SH2 + 4 * lane + 256 * j);
                const f32x4 o = v[j] * rstd * sc + sh; *(LAS f32x4*)(hl + 256 * j) = o; u32x2 wv; wv.x = pk2(o[0], o[1]); wv.y = pk2(o[2], o[3]); *(u32x2*)(hr + 256 * j) = wv; }
        }
        __syncthreads();
        float acc[16][5];
#pragma unroll
        for (int r = 0; r < 16; ++r)
#pragma unroll
            for (int e = 0; e < 5; ++e) acc[r][e] = 0.f;
#pragma unroll 1
        for (int j = 0; j < 8; ++j) {
            const int k0 = 4 * lane + 256 * j;
            f32x4 we[4]; float wgv[4];
#pragma unroll
            for (int i = 0; i < 4; ++i) { we[i] = *(const f32x4*)(a.w_re + (size_t)(k0 + i) * 32 + 4 * w); wgv[i] = w < 4 ? a.w_rg[(size_t)(k0 + i) * 4 + w] : 0.f; }
#pragma unroll
            for (int r = 0; r < 16; ++r) { const f32x4 h4 = *(const LAS f32x4*)(hrow + r * DM + k0);
#pragma unroll
                for (int i = 0; i < 4; ++i) { acc[r][0] += h4[i] * we[i][0]; acc[r][1] += h4[i] * we[i][1]; acc[r][2] += h4[i] * we[i][2]; acc[r][3] += h4[i] * we[i][3]; acc[r][4] += h4[i] * wgv[i]; } }
        }
#pragma unroll
        for (int r = 0; r < 16; ++r)
#pragma unroll
            for (int e = 0; e < 5; ++e) acc[r][e] = wave_sum(acc[r][e]);
        if (lane == 0) {
#pragma unroll
            for (int r = 0; r < 16; ++r) {
#pragma unroll
                for (int e = 0; e < 4; ++e) LG[r * 36 + 4 * w + e] = acc[r][e];
                if (w < 4) LG[r * 36 + 32 + w] = acc[r][4]; }
        }
        __syncthreads();
        if (tid < 16) {
            const int t = r0 + tid; const LAS float* lg = LG + tid * 36;
            float g[4]; int gi = 0;
#pragma unroll
            for (int i = 0; i < 4; ++i) g[i] = lg[32 + i] + a.b_rg[i];
            float gm = g[0];
#pragma unroll
            for (int i = 1; i < 4; ++i) if (g[i] > gm) { gm = g[i]; gi = i; }
            float gs = 0.f;
#pragma unroll
            for (int i = 0; i < 4; ++i) gs += expf(g[i] - gm);
            const float gp = 1.0f / gs;
            float el[8];
#pragma unroll
            for (int i = 0; i < 8; ++i) el[i] = lg[gi * 8 + i] + a.b_re[gi * 8 + i];
            int i1 = 0; float m1 = el[0];
#pragma unroll
            for (int i = 1; i < 8; ++i) if (el[i] > m1) { m1 = el[i]; i1 = i; }
            int i2 = -1; float m2 = -INFINITY;
#pragma unroll
            for (int i = 0; i < 8; ++i) if (i != i1 && el[i] > m2) { m2 = el[i]; i2 = i; }
            const float p2 = expf(m2 - m1), inv = 1.0f / (1.0f + p2);
            const int e1 = gi * 8 + i1, e2 = gi * 8 + i2;
            EID[2 * t] = e1; EID[2 * t + 1] = e2; WGT[2 * t] = gp * inv; WGT[2 * t + 1] = gp * p2 * inv;
            const unsigned p1 = atomicAdd(CNT + e1, 1u); LIST[e1 * NT + p1] = 2 * t;
            const unsigned p2i = atomicAdd(CNT + e2, 1u); LIST[e2 * NT + p2i] = 2 * t + 1;
        }
        __syncthreads();
    }
}
__device__ __forceinline__ void ph_final(const Args& a, int wg, int nwg) {
    const int lane = threadIdx.x & 63, gw = wg * 8 + (threadIdx.x >> 6), NGW = nwg * 8;
    const float* MOD = (const float*)(a.ws + WS_MOD); const float* X1 = (const float*)(a.ws + WS_X1); const bf16* YS = (const bf16*)(a.ws + WS_PROJ);
    for (int row = gw; row < NT; row += NGW) {
        const int b = row / SEQ;
        const float* xr = X1 + (size_t)row * DM + 4 * lane; const bf16* y0 = YS + (size_t)(2 * row) * DM + 4 * lane; const bf16* y1 = y0 + DM;
        f32x4 v[8]; float s = 0.f;
#pragma unroll
        for (int j = 0; j < 8; ++j) { const f32x4 g2 = *(const f32x4*)(MOD + b * MODN + MOD_G2 + 4 * lane + 256 * j); const u32x2 u0 = *(const u32x2*)(y0 + 256 * j), u1 = *(const u32x2*)(y1 + 256 * j);
            f32x4 y; y[0] = bf2f(u0.x & 0xffffu) + bf2f(u1.x & 0xffffu); y[1] = bf2f(u0.x >> 16) + bf2f(u1.x >> 16); y[2] = bf2f(u0.y & 0xffffu) + bf2f(u1.y & 0xffffu); y[3] = bf2f(u0.y >> 16) + bf2f(u1.y >> 16);
            v[j] = *(const f32x4*)(xr + 256 * j) * ALPHA + g2 * y; s += (v[j][0] + v[j][1]) + (v[j][2] + v[j][3]); }
        const float mean = wave_sum(s) * (1.f / DM); float s2 = 0.f;
#pragma unroll
        for (int j = 0; j < 8; ++j) { v[j] = v[j] - mean; s2 += (v[j][0] * v[j][0] + v[j][1] * v[j][1]) + (v[j][2] * v[j][2] + v[j][3] * v[j][3]); }
        const float rstd = 1.0f / sqrtf(wave_sum(s2) * (1.f / DM) + LN_EPS);
        float* o = a.out + (size_t)row * DM + 4 * lane;
#pragma unroll
        for (int j = 0; j < 8; ++j) { const f32x4 g = *(const f32x4*)(a.ln2g + 4 * lane + 256 * j), bb = *(const f32x4*)(a.ln2b + 4 * lane + 256 * j); *(f32x4*)(o + 256 * j) = v[j] * rstd * g + bb; }
    }
}

template <int PH> __global__ void __launch_bounds__(512, 2) k_thin(Args a) {
    extern __shared__ __attribute__((aligned(16))) unsigned char lds[];
    const int wg = blockIdx.x, nwg = gridDim.x;
    if (PH == 0) { ph_mod(a, (LAS float*)lds, wg, nwg); ph_rope_table(a, wg, nwg); }
    if (PH == 1) ph_ln0(a, wg, nwg);
    if (PH == 3) ph_kmean(a, wg, nwg);
    if (PH == 6) ph_ln1_route(a, (LAS unsigned char*)lds, wg, nwg);
    if (PH == 9) ph_final(a, wg, nwg);
}

template <class F> __global__ void __launch_bounds__(256) nk_gemm(F f, int K) {
    __shared__ float As[16][68]; __shared__ float Bs[16][68];
    const int tid = threadIdx.x, tx = tid & 15, ty = tid >> 4, z = blockIdx.z, m0 = blockIdx.y * 64, n0 = blockIdx.x * 64;
    if (!f.active(z, m0)) return;
    float acc[4][4] = {};
    const int ar = tid >> 2, ak = (tid & 3) * 4; const bf16* arow = f.arow(z, m0 + ar);
    const int bk = tid >> 4, bn = (tid & 15) * 4;
    for (int k0 = 0; k0 < K; k0 += 16) {
        float a4[4] = {0.f, 0.f, 0.f, 0.f};
        if (arow) { const u32x2 u = *(const u32x2*)(arow + k0 + ak); a4[0] = bf2f(u.x & 0xffffu); a4[1] = bf2f(u.x >> 16); a4[2] = bf2f(u.y & 0xffffu); a4[3] = bf2f(u.y >> 16); }
#pragma unroll
        for (int i = 0; i < 4; ++i) As[ak + i][ar] = a4[i];
#pragma unroll
        for (int i = 0; i < 4; ++i) Bs[bk][bn + i] = f.b(z, k0 + bk, n0 + bn + i);
        __syncthreads();
#pragma unroll
        for (int kk = 0; kk < 16; ++kk) { float av[4], bv[4];
#pragma unroll
            for (int i = 0; i < 4; ++i) { av[i] = As[kk][ty * 4 + i]; bv[i] = Bs[kk][tx * 4 + i]; }
#pragma unroll
            for (int i = 0; i < 4; ++i)
#pragma unroll
                for (int j = 0; j < 4; ++j) acc[i][j] += av[i] * bv[j]; }
        __syncthreads();
    }
#pragma unroll
    for (int i = 0; i < 4; ++i)
#pragma unroll
        for (int j = 0; j < 4; ++j) f.store(z, m0 + ty * 4 + i, n0 + tx * 4 + j, acc[i][j]);
}
struct FProj { const bf16* A; const float* W; float* C;
    __device__ bool active(int, int) const { return true; }
    __device__ const bf16* arow(int, int m) const { return A + (size_t)m * DM; }
    __device__ float b(int, int k, int n) const { return W[(size_t)k * INCOLS + n]; }
    __device__ void store(int, int m, int n, float v) const { C[(size_t)m * INCOLS + n] = v; } };
struct FQ { const bf16* PROJ; const float* W; const float* g; float* C;
    __device__ bool active(int, int) const { return true; }
    __device__ const bf16* arow(int, int m) const { return PROJ + (size_t)m * PROJ_N; }
    __device__ float b(int, int k, int n) const { return g[k] * W[(size_t)k * 1536 + n]; }
    __device__ void store(int, int m, int n, float v) const { C[(size_t)m * 1536 + n] = v; } };
struct FKV { const bf16* PROJ; const float* W; const float* g; const float* SS; bf16* KV;
    __device__ bool active(int, int) const { return true; }
    __device__ const bf16* arow(int, int m) const { return PROJ + (size_t)m * PROJ_N + QR; }
    __device__ float b(int, int k, int n) const { return g[k] * W[(size_t)k * 2048 + n]; }
    __device__ void store(int, int m, int n, float v) const { const float* s = SS + (size_t)m * 12 + 8; const float rs = 1.0f / sqrtf(((s[0] + s[1]) + (s[2] + s[3])) * (1.f / KVR) + RMS_EPS); KV[(size_t)m * 2048 + n] = (bf16)f2bf(v * rs); } };
struct FOut { const bf16* ATT; const float* W; const float* x; const float* MOD; float* X1;
    __device__ bool active(int, int) const { return true; }
    __device__ const bf16* arow(int, int m) const { return ATT + (size_t)m * DM; }
    __device__ float b(int, int k, int n) const { return W[(size_t)k * DM + n]; }
    __device__ void store(int, int m, int n, float v) const { const int b_ = m / SEQ; X1[(size_t)m * DM + n] = ALPHA * x[(size_t)m * DM + n] + MOD[b_ * MODN + MOD_G1 + n] * v; } };
struct FMoe1 { const bf16* H; const float* w1; const float* w3; const unsigned* cnt; const int* LIST; float* C;
    __device__ bool active(int e, int m0) const { return m0 < (int)cnt[e]; }
    __device__ const bf16* arow(int e, int m) const { return m < (int)cnt[e] ? H + (size_t)(LIST[e * NT + m] >> 1) * DM : nullptr; }
    __device__ float b(int e, int k, int n) const { return n < FF ? w1[((size_t)e * DM + k) * FF + n] : w3[((size_t)e * DM + k) * FF + n - FF]; }
    __device__ void store(int e, int m, int n, float v) const { if (m < (int)cnt[e]) C[(size_t)(moe_rowbase(cnt, e) + m) * 1024 + n] = v; } };
struct FMoe2 { const bf16* HID; const float* w2; const unsigned* cnt; const int* LIST; bf16* YS;
    __device__ bool active(int e, int m0) const { return m0 < (int)cnt[e]; }
    __device__ const bf16* arow(int e, int m) const { return m < (int)cnt[e] ? HID + (size_t)(moe_rowbase(cnt, e) + m) * FF : nullptr; }
    __device__ float b(int e, int k, int n) const { return w2[((size_t)e * FF + k) * DM + n]; }
    __device__ void store(int e, int m, int n, float v) const { if (m < (int)cnt[e]) YS[(size_t)LIST[e * NT + m] * DM + n] = (bf16)f2bf(v); } };

__global__ void __launch_bounds__(256) nk_epi_proj(Args a) {
    const int row = blockIdx.x, tid = threadIdx.x, pos = row % SEQ;
    const float* T = (const float*)(a.ws + WS_W13) + (size_t)row * INCOLS; bf16* P = (bf16*)(a.ws + WS_PROJ) + (size_t)row * PROJ_N;
    const float* RT = (const float*)(a.ws + WS_ROPE); float* SS = (float*)(a.ws + WS_SS) + (size_t)row * 12;
    __shared__ float red[2][256];
    float sq = 0.f, skv = 0.f;
    for (int n = tid; n < PROJ_N; n += 256) {
        float v;
        if (n < PC_KR) { v = T[n]; if (n < QR) sq += v * v; else skv += v * v; }
        else if (n < PC_KR + 64) { const int jj = n - PC_KR, i = jj >> 1, s = jj & 1; const float x1 = T[768 + i], x2 = T[768 + 32 + i], cs = RT[2 * (pos * 32 + i)], sn = RT[2 * (pos * 32 + i) + 1]; v = s == 0 ? x1 * cs - x2 * sn : x1 * sn + x2 * cs; }
        else if (n < PC_QMO) v = 0.f;
        else v = T[n - 192];
        P[n] = (bf16)f2bf(v);
    }
    red[0][tid] = sq; red[1][tid] = skv; __syncthreads();
    for (int o = 128; o > 0; o >>= 1) { if (tid < o) { red[0][tid] += red[0][tid + o]; red[1][tid] += red[1][tid + o]; } __syncthreads(); }
    if (tid < 12) SS[tid] = tid == 0 ? red[0][0] : (tid == 8 ? red[1][0] : 0.f);
}
__global__ void __launch_bounds__(256) nk_epi_q(Args a) {
    const int row = blockIdx.x, tid = threadIdx.x, pos = row % SEQ;
    const float* T = (const float*)(a.ws + WS_W13) + (size_t)row * 1536; bf16* Q = (bf16*)(a.ws + WS_QM) + (size_t)row * 1536;
    const float* RT = (const float*)(a.ws + WS_ROPE); const float* s = (const float*)(a.ws + WS_SS) + (size_t)row * 12;
    const float rs = 1.0f / sqrtf((((s[0] + s[1]) + (s[2] + s[3])) + ((s[4] + s[5]) + (s[6] + s[7]))) * (1.f / QR) + RMS_EPS);
    for (int n = tid; n < 1536; n += 256) {
        const int h = n / QHD, j = n % QHD; float v;
        if (j < 128) v = T[n] * rs;
        else { const int jj = j - 128, i = jj >> 1, sx = jj & 1; const float x1 = T[h * QHD + 128 + i] * rs, x2 = T[h * QHD + 160 + i] * rs, cs = RT[2 * (pos * 32 + i)], sn = RT[2 * (pos * 32 + i) + 1]; v = sx == 0 ? x1 * cs - x2 * sn : x1 * sn + x2 * cs; }
        Q[n] = (bf16)f2bf(v);
    }
}
__global__ void __launch_bounds__(256) nk_epi_moe1(Args a) {
    const unsigned* cnt = (const unsigned*)(a.ws + WS_CTL) + CW_CNT; const int e = blockIdx.x, m0 = blockIdx.y * 64;
    if (m0 >= (int)cnt[e]) return;
    const int* LIST = (const int*)(a.ws + WS_LIST); const float* WGT = (const float*)(a.ws + WS_ROUTE + 65536);
    const float* T = (const float*)(a.ws + WS_W13); bf16* HID = (bf16*)(a.ws + WS_QM); const int rb = moe_rowbase(cnt, e);
    for (int m = m0; m < m0 + 64 && m < (int)cnt[e]; ++m) { const float w = WGT[LIST[e * NT + m]]; const size_t R = (size_t)(rb + m);
        for (int f = threadIdx.x; f < FF; f += 256) { const float a1 = T[R * 1024 + f], a3 = T[R * 1024 + FF + f]; HID[R * FF + f] = (bf16)f2bf(silu_f(a1) * a3 * w); } }
}
__global__ void __launch_bounds__(128) nk_attn_mla(Args a) {
    __shared__ float sc[2][SEQ]; __shared__ float qv[2][QHD];
    const int lane = threadIdx.x & 63, w = threadIdx.x >> 6, b = blockIdx.z, h = blockIdx.y, q = blockIdx.x * 2 + w;
    const bf16* QM = (const bf16*)(a.ws + WS_QM); const bf16* KV = (const bf16*)(a.ws + WS_KV); const bf16* PROJ = (const bf16*)(a.ws + WS_PROJ); bf16* ATT = (bf16*)(a.ws + WS_ATT);
    const size_t row = (size_t)b * SEQ + q; const float scale = 0.07216878364870322f;
    for (int d = lane; d < QHD; d += 64) qv[w][d] = bf2f(QM[row * 1536 + h * QHD + d]);
    __syncthreads();
    float mx = -INFINITY;
    for (int k = lane; k <= q; k += 64) { const size_t kr = (size_t)b * SEQ + k; const bf16* kn = KV + kr * 2048 + h * 256; const bf16* kp = PROJ + kr * PROJ_N + PC_KR; float dsum = 0.f;
        for (int d = 0; d < 128; ++d) dsum += qv[w][d] * bf2f(kn[d]);
        for (int d = 0; d < 64; ++d) dsum += qv[w][128 + d] * bf2f(kp[d]);
        dsum *= scale; sc[w][k] = dsum; mx = fmaxf(mx, dsum); }
    mx = wave_max(mx); float sum = 0.f;
    for (int k = lane; k <= q; k += 64) { const float p = expf(sc[w][k] - mx); sc[w][k] = p; sum += p; }
    sum = wave_sum(sum);
    __syncthreads();
    float o0 = 0.f, o1 = 0.f;
    for (int k = 0; k <= q; ++k) { const unsigned u = *(const unsigned*)(KV + ((size_t)b * SEQ + k) * 2048 + h * 256 + 128 + 2 * lane); const float p = sc[w][k]; o0 += p * bf2f(u & 0xffffu); o1 += p * bf2f(u >> 16); }
    const float inv = 1.0f / sum;
    *(unsigned*)(ATT + row * DM + h * 128 + 2 * lane) = pk2(o0 * inv, o1 * inv);
}
__global__ void __launch_bounds__(256) nk_attn_moba(Args a) {
    __shared__ float sc[4][1024]; __shared__ float qv[4][128]; __shared__ int selb[4][4];
    const int lane = threadIdx.x & 63, w = threadIdx.x >> 6, b = blockIdx.z, h = blockIdx.y, q = blockIdx.x * 4 + w, qblk = q / MBLK;
    const bf16* PROJ = (const bf16*)(a.ws + WS_PROJ); bf16* ATT = (bf16*)(a.ws + WS_ATT); const float* KM = (const float*)(a.ws + WS_KMEAN) + (size_t)(b * NH + h) * NBLK * 128;
    const size_t row = (size_t)b * SEQ + q; const float scale = 0.08838834764831845f;
    for (int d = lane; d < 128; d += 64) qv[w][d] = bf2f(PROJ[row * PROJ_N + PC_QMO + h * 128 + d]);
    __syncthreads();
    float gate = -INFINITY;
    if (lane < qblk) { float s = 0.f; for (int d = 0; d < 128; ++d) s += qv[w][d] * KM[lane * 128 + d]; gate = s; }
    const int nsel = qblk < 3 ? qblk : 3;
    for (int s = 0; s < nsel; ++s) {
        float bv = gate; int bi = lane;
#pragma unroll
        for (int o = 1; o < 64; o <<= 1) { const float ov = __shfl_xor(bv, o); const int oi = __shfl_xor(bi, o); if (ov > bv || (ov == bv && oi < bi)) { bv = ov; bi = oi; } }
        if (lane == 0) selb[w][s] = bi;
        if (lane == bi) gate = -INFINITY;
    }
    if (lane == 0) selb[w][nsel] = qblk;
    __syncthreads();
    float mx = -INFINITY;
    for (int s = 0; s <= nsel; ++s) { const int blk = selb[w][s];
        for (int kk = lane; kk < MBLK; kk += 64) { const int key = blk * MBLK + kk; float v = -INFINITY;
            if (key <= q) { const bf16* kp = PROJ + ((size_t)b * SEQ + key) * PROJ_N + PC_KMO + h * 128; float dsum = 0.f;
                for (int d = 0; d < 128; ++d) dsum += qv[w][d] * bf2f(kp[d]);
                v = dsum * scale + a.t5[t5_bucket(q - key) * NH + h]; }
            sc[w][s * MBLK + kk] = v; mx = fmaxf(mx, v); } }
    mx = wave_max(mx); float sum = 0.f;
    for (int i = lane; i < (nsel + 1) * MBLK; i += 64) { const float p = expf(sc[w][i] - mx); sc[w][i] = p; sum += p; }
    sum = wave_sum(sum);
    __syncthreads();
    float o0 = 0.f, o1 = 0.f;
    for (int s = 0; s <= nsel; ++s) { const int blk = selb[w][s];
        for (int kk = 0; kk < MBLK; ++kk) { const int key = blk * MBLK + kk; if (key > q) break;
            const unsigned u = *(const unsigned*)(PROJ + ((size_t)b * SEQ + key) * PROJ_N + PC_VMO + h * 128 + 2 * lane); const float p = sc[w][s * MBLK + kk]; o0 += p * bf2f(u & 0xffffu); o1 += p * bf2f(u >> 16); } }
    const float inv = 1.0f / sum;
    *(unsigned*)(ATT + row * DM + 1024 + h * 128 + 2 * lane) = pk2(o0 * inv, o1 * inv);
}

extern "C" void kernel_launch(void* const* d_in, const int* in_sizes, int n_in, void* d_out, int out_size, void* d_ws, size_t ws_size, hipStream_t stream) {
    if (n_in != 22 || in_sizes[0] != NT * DM || out_size != NT * DM || ws_size < WS_END) { fprintf(stderr, "kernel_launch: unexpected shapes (n_in %d, in0 %d, out %d, ws %zu)\n", n_in, n_in > 0 ? in_sizes[0] : -1, out_size, ws_size); return; }
    Args a{};
    const float** ap = (const float**)&a;
    for (int i = 0; i < 22; ++i) ap[i] = (const float*)d_in[i];
    a.out = (float*)d_out; a.ws = (unsigned char*)d_ws;
    unsigned char* ws = a.ws;
    static bool attr_done = false;
    if (!attr_done) { attr_done = true; (void)hipFuncSetAttribute((const void*)k_thin<6>, hipFuncAttributeMaxDynamicSharedMemorySize, P6_LDS); }
    (void)hipMemsetAsync(ws + WS_CTL, 0, CTL_ZERO_BYTES, stream);
    const unsigned* cnt = (const unsigned*)(ws + WS_CTL) + CW_CNT;
    k_thin<0><<<256, 512, 32768, stream>>>(a);
    k_thin<1><<<256, 512, 0, stream>>>(a);
    nk_gemm<FProj><<<dim3(INCOLS / 64, NT / 64, 1), 256, 0, stream>>>(FProj{(const bf16*)(ws + WS_H), a.w_in, (float*)(ws + WS_W13)}, DM);
    nk_epi_proj<<<NT, 256, 0, stream>>>(a);
    nk_gemm<FQ><<<dim3(1536 / 64, NT / 64, 1), 256, 0, stream>>>(FQ{(const bf16*)(ws + WS_PROJ), a.w_uq, a.qg, (float*)(ws + WS_W13)}, QR);
    nk_epi_q<<<NT, 256, 0, stream>>>(a);
    nk_gemm<FKV><<<dim3(2048 / 64, NT / 64, 1), 256, 0, stream>>>(FKV{(const bf16*)(ws + WS_PROJ), a.w_ukv, a.kvg, (const float*)(ws + WS_SS), (bf16*)(ws + WS_KV)}, KVR);
    k_thin<3><<<256, 512, 0, stream>>>(a);
    nk_attn_mla<<<dim3(SEQ / 2, NH, NB), 128, 0, stream>>>(a);
    nk_attn_moba<<<dim3(SEQ / 4, NH, NB), 256, 0, stream>>>(a);
    nk_gemm<FOut><<<dim3(DM / 64, NT / 64, 1), 256, 0, stream>>>(FOut{(const bf16*)(ws + WS_ATT), a.w_out, a.x, (const float*)(ws + WS_MOD), (float*)(ws + WS_X1)}, DM);
    k_thin<6><<<256, 512, P6_LDS, stream>>>(a);
    nk_gemm<FMoe1><<<dim3(1024 / 64, NT / 64, NE), 256, 0, stream>>>(FMoe1{(const bf16*)(ws + WS_H), a.w1, a.w3, cnt, (const int*)(ws + WS_LIST), (float*)(ws + WS_W13)}, DM);
    nk_epi_moe1<<<dim3(NE, NT / 64), 256, 0, stream>>>(a);
    nk_gemm<FMoe2><<<dim3(DM / 64, NT / 64, NE), 256, 0, stream>>>(FMoe2{(const bf16*)(ws + WS_QM), a.w2, cnt, (const int*)(ws + WS_LIST), (bf16*)(ws + WS_PROJ)}, FF);
    k_thin<9><<<256, 512, 0, stream>>>(a);
}
```

```cpp
#include <hip/hip_runtime.h>
#include <cstdio>
#include <cstdint>

#define LAS __attribute__((address_space(3)))
typedef unsigned short bf16;
typedef float f32x4 __attribute__((ext_vector_type(4)));
typedef unsigned u32x4 __attribute__((ext_vector_type(4)));
typedef unsigned u32x2 __attribute__((ext_vector_type(2)));

constexpr int NB = 2, SEQ = 4096, DM = 2048, NT = NB * SEQ;
constexpr int QR = 512, KVR = 256, NH = 8, QHD = 192, MBLK = 256, NBLK = 16;
constexpr int INCOLS = 3904, PROJ_N = 4096, MODN = 6 * DM;
constexpr int NE = 32, FF = 512;
constexpr float LN_EPS = 1e-5f, RMS_EPS = 1e-6f;
constexpr float ALPHA = 1.189207115002721f;
constexpr int MOD_SH1 = 0, MOD_SC1 = DM, MOD_G1 = 2 * DM, MOD_SH2 = 3 * DM, MOD_SC2 = 4 * DM, MOD_G2 = 5 * DM;
constexpr int PC_KR = 768, PC_QMO = 1024, PC_KMO = 2048, PC_VMO = 3072;

constexpr size_t MiB = 1u << 20;
constexpr size_t WS_CTL = 0, CTL_ZERO_BYTES = 1 * MiB;
constexpr size_t WS_MOD = 1 * MiB;
constexpr size_t WS_ROPE = 2 * MiB;
constexpr size_t WS_KMEAN = 3 * MiB;
constexpr size_t WS_SS = 3 * MiB + 512 * 1024;
constexpr size_t WS_ROUTE = 4 * MiB;
constexpr size_t WS_LIST = 5 * MiB;
constexpr size_t WS_WIN = 8 * MiB;
constexpr size_t WS_WUQ = 24 * MiB;
constexpr size_t WS_WUKV = 26 * MiB;
constexpr size_t WS_WOUT = 28 * MiB;
constexpr size_t WS_W13 = 40 * MiB;
constexpr size_t WS_W2 = 168 * MiB;
constexpr size_t WS_H = 232 * MiB;
constexpr size_t WS_PROJ = 264 * MiB;
constexpr size_t WS_QM = 328 * MiB;
constexpr size_t WS_KV = 352 * MiB;
constexpr size_t WS_ATT = 384 * MiB;
constexpr size_t WS_X1 = 416 * MiB;
constexpr size_t WS_END = 480 * MiB;
constexpr int CW_CNT = 64;
constexpr int CW_QUEUE = 128;

__device__ __forceinline__ unsigned f2bf(float f) { unsigned u = __builtin_bit_cast(unsigned, f); return (u + 0x7fffu + ((u >> 16) & 1u)) >> 16; }
__device__ __forceinline__ float bf2f(unsigned b) { return __builtin_bit_cast(float, b << 16); }
__device__ __forceinline__ unsigned pk2(float lo, float hi) { return f2bf(lo) | (f2bf(hi) << 16); }
__device__ __forceinline__ float wave_sum(float v) {
#pragma unroll
    for (int o = 1; o < 64; o <<= 1) v += __shfl_xor(v, o);
    return v;
}
__device__ __forceinline__ float wave_max(float v) {
#pragma unroll
    for (int o = 1; o < 64; o <<= 1) v = fmaxf(v, __shfl_xor(v, o));
    return v;
}
__device__ __forceinline__ int tid_opaque() { int t = threadIdx.x; asm volatile("" : "+v"(t)); return t; }
__device__ __forceinline__ float silu_f(float v) { return v / (1.f + __expf(-v)); }
__device__ __forceinline__ int t5_bucket(int n) {
    if (n < 16) return n;
    int l = 16 + (int)(logf((float)n / 16.f) / 2.0794415416798357f * 16.f);
    return l < 31 ? l : 31;
}
__device__ __forceinline__ int moe_rowbase(const unsigned* cnt, int e) { int s = 0; for (int i = 0; i < e; ++i) s += (int)((cnt[i] + 255u) >> 8) << 8; return s; }

struct Args {
    const float *x, *c, *w_ada, *b_ada, *w_in, *qg, *w_uq, *kvg, *w_ukv, *w_out, *t5, *ln1g, *ln1b, *w_rg, *b_rg, *w_re, *b_re, *w1, *w3, *w2, *ln2g, *ln2b;
    float* out; unsigned char* ws;
};


__device__ __forceinline__ void ph_mod(const Args& a, LAS float* sm, int wg, int nwg) {
    const int tid = tid_opaque(), lane = tid & 63, w = __builtin_amdgcn_readfirstlane(tid >> 6);
    float* MOD = (float*)(a.ws + WS_MOD);
    LAS float* sc = sm;
    LAS float* red = sm + 2 * DM;
    if (wg >= 192) return;
    for (int i = tid; i < 2 * DM; i += 512) sc[i] = silu_f(a.c[i]);
    __syncthreads();
    for (int cg = wg; cg < 192; cg += nwg) {
        const int c4 = lane & 15, ksub = lane >> 4, col = cg * 64 + 4 * c4;
        f32x4 a0 = {0.f, 0.f, 0.f, 0.f}, a1 = {0.f, 0.f, 0.f, 0.f};
#pragma unroll 8
        for (int it = 0; it < 64; ++it) {
            const int k = w * 256 + it * 4 + ksub;
            const f32x4 wv = *(const f32x4*)(a.w_ada + (size_t)k * MODN + col);
            a0 += wv * sc[k]; a1 += wv * sc[DM + k];
        }
#pragma unroll
        for (int j = 0; j < 4; ++j) { a0[j] += __shfl_xor(a0[j], 16); a0[j] += __shfl_xor(a0[j], 32); a1[j] += __shfl_xor(a1[j], 16); a1[j] += __shfl_xor(a1[j], 32); }
        if (ksub == 0) {
#pragma unroll
            for (int j = 0; j < 4; ++j) { red[(w * 2 + 0) * 64 + 4 * c4 + j] = a0[j]; red[(w * 2 + 1) * 64 + 4 * c4 + j] = a1[j]; }
        }
        __syncthreads();
        if (tid < 128) { const int b = tid >> 6, cc = tid & 63; float s = 0.f;
#pragma unroll
            for (int ww = 0; ww < 8; ++ww) s += red[(ww * 2 + b) * 64 + cc];
            MOD[b * MODN + cg * 64 + cc] = s + a.b_ada[cg * 64 + cc]; }
        __syncthreads();
    }
}
__device__ __forceinline__ void ph_rope_table(const Args& a, int wg, int nwg) {
    float* RT = (float*)(a.ws + WS_ROPE);
    for (int idx = wg * 512 + tid_opaque(); idx < SEQ * 32; idx += nwg * 512) {
        const int pos = idx >> 5, i = idx & 31;
        const float inv = 1.0f / powf(10000.0f, (float)(2 * i) / 64.0f);
        const float ang = (float)pos * inv;
        const double ad = (double)ang, q = rint(ad * 0.6366197723675814), r = ad - q * 1.5707963267948966;
        const int qi = ((int)q) & 3; const float rf = (float)r, r2 = rf * rf;
        const float s = rf * (1.f + r2 * (-1.6666667e-1f + r2 * (8.3333333e-3f + r2 * (-1.9841270e-4f + r2 * 2.7557319e-6f))));
        const float c = 1.f + r2 * (-0.5f + r2 * (4.1666667e-2f + r2 * (-1.3888889e-3f + r2 * (2.4801587e-5f + r2 * (-2.7557319e-7f)))));
        float cs, sn;
        if (qi == 0) { cs = c; sn = s; } else if (qi == 1) { cs = -s; sn = c; } else if (qi == 2) { cs = -c; sn = -s; } else { cs = s; sn = -c; }
        RT[2 * idx] = cs; RT[2 * idx + 1] = sn;
    }
}
__device__ __forceinline__ void ph_ln0(const Args& a, int wg, int nwg) {
    const int tid = tid_opaque(), lane = tid & 63, gw = wg * 8 + __builtin_amdgcn_readfirstlane(tid >> 6), NGW = nwg * 8;
    const float* MOD = (const float*)(a.ws + WS_MOD); bf16* H = (bf16*)(a.ws + WS_H);
    for (int b = 0; b < NB; ++b) {
        f32x4 sc[8], sh[8];
#pragma unroll
        for (int j = 0; j < 8; ++j) { sc[j] = *(const f32x4*)(MOD + b * MODN + MOD_SC1 + 4 * lane + 256 * j) + 1.0f; sh[j] = *(const f32x4*)(MOD + b * MODN + MOD_SH1 + 4 * lane + 256 * j); }
        for (int r = gw; r < SEQ; r += NGW) {
            const size_t row = (size_t)b * SEQ + r;
            const float* xr = a.x + row * DM + 4 * lane;
            f32x4 v[8]; float s = 0.f;
#pragma unroll
            for (int j = 0; j < 8; ++j) { v[j] = *(const f32x4*)(xr + 256 * j); s += (v[j][0] + v[j][1]) + (v[j][2] + v[j][3]); }
            const float mean = wave_sum(s) * (1.f / DM); float s2 = 0.f;
#pragma unroll
            for (int j = 0; j < 8; ++j) { v[j] = v[j] - mean; s2 += (v[j][0] * v[j][0] + v[j][1] * v[j][1]) + (v[j][2] * v[j][2] + v[j][3] * v[j][3]); }
            const float rstd = 1.0f / sqrtf(wave_sum(s2) * (1.f / DM) + LN_EPS);
            bf16* hr = H + row * DM + 4 * lane;
#pragma unroll
            for (int j = 0; j < 8; ++j) { const f32x4 o = v[j] * rstd * sc[j] + sh[j]; u32x2 w; w.x = pk2(o[0], o[1]); w.y = pk2(o[2], o[3]); *(u32x2*)(hr + 256 * j) = w; }
        }
    }
}
__device__ __forceinline__ void ph_kmean(const Args& a, int wg, int nwg) {
    const int tid = tid_opaque(), lane = tid & 63, gw = wg * 8 + __builtin_amdgcn_readfirstlane(tid >> 6), NGW = nwg * 8;
    const bf16* PROJ = (const bf16*)(a.ws + WS_PROJ); float* KM = (float*)(a.ws + WS_KMEAN);
    for (int t = gw; t < 16 * NBLK; t += NGW) {
        const int bh = t >> 4, blk = t & 15, b = bh >> 3, h = bh & 7;
        const bf16* p = PROJ + ((size_t)b * SEQ + blk * MBLK) * PROJ_N + PC_KMO + h * 128 + 2 * lane;
        float s0 = 0.f, s1 = 0.f;
#pragma unroll 8
        for (int r = 0; r < MBLK; ++r) { const unsigned u = *(const unsigned*)(p + (size_t)r * PROJ_N); s0 += bf2f(u & 0xffffu); s1 += bf2f(u >> 16); }
        KM[(size_t)t * 128 + 2 * lane] = s0 * (1.f / MBLK); KM[(size_t)t * 128 + 2 * lane + 1] = s1 * (1.f / MBLK);
    }
}
constexpr int P6_LDS = 131072 + 16 * 36 * 4;
__device__ __forceinline__ void ph_ln1_route(const Args& a, LAS unsigned char* lds, int wg, int nwg) {
    const int tid = tid_opaque(), lane = tid & 63, w = __builtin_amdgcn_readfirstlane(tid >> 6);
    const float* MOD = (const float*)(a.ws + WS_MOD); bf16* H = (bf16*)(a.ws + WS_H); float* X1 = (float*)(a.ws + WS_X1);
    int* EID = (int*)(a.ws + WS_ROUTE); float* WGT = (float*)(a.ws + WS_ROUTE + 65536); int* LIST = (int*)(a.ws + WS_LIST);
    unsigned* CNT = (unsigned*)(a.ws + WS_CTL) + CW_CNT;
    LAS float* hrow = (LAS float*)lds; LAS float* LG = (LAS float*)(lds + 131072);
    for (int r0 = wg * 16; r0 < NT; r0 += nwg * 16) {
        const int b = r0 / SEQ;
        for (int rr = 0; rr < 2; ++rr) {
            const int row = r0 + 2 * w + rr;
            float* xr = X1 + (size_t)row * DM + 4 * lane;
            f32x4 v[8]; float s = 0.f;
#pragma unroll
            for (int j = 0; j < 8; ++j) { v[j] = *(const f32x4*)(xr + 256 * j); s += (v[j][0] + v[j][1]) + (v[j][2] + v[j][3]); }
            float mean = wave_sum(s) * (1.f / DM), s2 = 0.f;
#pragma unroll
            for (int j = 0; j < 8; ++j) { v[j] = v[j] - mean; s2 += (v[j][0] * v[j][0] + v[j][1] * v[j][1]) + (v[j][2] * v[j][2] + v[j][3] * v[j][3]); }
            float rstd = 1.0f / sqrtf(wave_sum(s2) * (1.f / DM) + LN_EPS);
            s = 0.f;
#pragma unroll
            for (int j = 0; j < 8; ++j) { const f32x4 g = *(const f32x4*)(a.ln1g + 4 * lane + 256 * j), bb = *(const f32x4*)(a.ln1b + 4 * lane + 256 * j);
                v[j] = v[j] * rstd * g + bb; *(f32x4*)(xr + 256 * j) = v[j]; s += (v[j][0] + v[j][1]) + (v[j][2] + v[j][3]); }
            mean = wave_sum(s) * (1.f / DM); s2 = 0.f;
#pragma unroll
            for (int j = 0; j < 8; ++j) { v[j] = v[j] - mean; s2 += (v[j][0] * v[j][0] + v[j][1] * v[j][1]) + (v[j][2] * v[j][2] + v[j][3] * v[j][3]); }
            rstd = 1.0f / sqrtf(wave_sum(s2) * (1.f / DM) + LN_EPS);
            bf16* hr = H + (size_t)row * DM + 4 * lane; LAS float* hl = hrow + (2 * w + rr) * DM + 4 * lane;
#pragma unroll
            for (int j = 0; j < 8; ++j) { const f32x4 sc = *(const f32x4*)(MOD + b * MODN + MOD_SC2 + 4 * lane + 256 * j) + 1.0f, sh = *(const f32x4*)(MOD + b * MODN + MOD_SH2 + 4 * lane + 256 * j);
                const f32x4 o = v[j] * rstd * sc + sh; *(LAS f32x4*)(hl + 256 * j) = o; u32x2 wv; wv.x = pk2(o[0], o[1]); wv.y = pk2(o[2], o[3]); *(u32x2*)(hr + 256 * j) = wv; }
        }
        __syncthreads();
        float acc[16][5];
#pragma unroll
        for (int r = 0; r < 16; ++r)
#pragma unroll
            for (int e = 0; e < 5; ++e) acc[r][e] = 0.f;
#pragma unroll 1
        for (int j = 0; j < 8; ++j) {
            const int k0 = 4 * lane + 256 * j;
            f32x4 we[4]; float wgv[4];
#pragma unroll
            for (int i = 0; i < 4; ++i) { we[i] = *(const f32x4*)(a.w_re + (size_t)(k0 + i) * 32 + 4 * w); wgv[i] = w < 4 ? a.w_rg[(size_t)(k0 + i) * 4 + w] : 0.f; }
#pragma unroll
            for (int r = 0; r < 16; ++r) { const f32x4 h4 = *(const LAS f32x4*)(hrow + r * DM + k0);
#pragma unroll
                for (int i = 0; i < 4; ++i) { acc[r][0] += h4[i] * we[i][0]; acc[r][1] += h4[i] * we[i][1]; acc[r][2] += h4[i] * we[i][2]; acc[r][3] += h4[i] * we[i][3]; acc[r][4] += h4[i] * wgv[i]; } }
        }
#pragma unroll
        for (int r = 0; r < 16; ++r)
#pragma unroll
            for (int e = 0; e < 5; ++e) acc[r][e] = wave_sum(acc[r][e]);
        if (lane == 0) {
#pragma unroll
            for (int r = 0; r < 16; ++r) {
#pragma unroll
                for (int e = 0; e < 4; ++e) LG[r * 36 + 4 * w + e] = acc[r][e];
                if (w < 4) LG[r * 36 + 32 + w] = acc[r][4]; }
        }
        __syncthreads();
        if (tid < 16) {
            const int t = r0 + tid; const LAS float* lg = LG + tid * 36;
            float g[4]; int gi = 0;
#pragma unroll
            for (int i = 0; i < 4; ++i) g[i] = lg[32 + i] + a.b_rg[i];
            float gm = g[0];
#pragma unroll
            for (int i = 1; i < 4; ++i) if (g[i] > gm) { gm = g[i]; gi = i; }
            float gs = 0.f;
#pragma unroll
            for (int i = 0; i < 4; ++i) gs += expf(g[i] - gm);
            const float gp = 1.0f / gs;
            float el[8];
#pragma unroll
            for (int i = 0; i < 8; ++i) el[i] = lg[gi * 8 + i] + a.b_re[gi * 8 + i];
            int i1 = 0; float m1 = el[0];
#pragma unroll
            for (int i = 1; i < 8; ++i) if (el[i] > m1) { m1 = el[i]; i1 = i; }
            int i2 = -1; float m2 = -INFINITY;
#pragma unroll
            for (int i = 0; i < 8; ++i) if (i != i1 && el[i] > m2) { m2 = el[i]; i2 = i; }
            const float p2 = expf(m2 - m1), inv = 1.0f / (1.0f + p2);
            const int e1 = gi * 8 + i1, e2 = gi * 8 + i2;
            EID[2 * t] = e1; EID[2 * t + 1] = e2; WGT[2 * t] = gp * inv; WGT[2 * t + 1] = gp * p2 * inv;
            const unsigned p1 = atomicAdd(CNT + e1, 1u); LIST[e1 * NT + p1] = 2 * t;
            const unsigned p2i = atomicAdd(CNT + e2, 1u); LIST[e2 * NT + p2i] = 2 * t + 1;
        }
        __syncthreads();
    }
}
__device__ __forceinline__ void ph_final(const Args& a, int wg, int nwg) {
    const int tid = tid_opaque(), lane = tid & 63, gw = wg * 8 + __builtin_amdgcn_readfirstlane(tid >> 6), NGW = nwg * 8;
    const float* MOD = (const float*)(a.ws + WS_MOD); const float* X1 = (const float*)(a.ws + WS_X1); const bf16* YS = (const bf16*)(a.ws + WS_PROJ);
    for (int row = gw; row < NT; row += NGW) {
        const int b = row / SEQ;
        const float* xr = X1 + (size_t)row * DM + 4 * lane; const bf16* y0 = YS + (size_t)(2 * row) * DM + 4 * lane; const bf16* y1 = y0 + DM;
        f32x4 v[8]; float s = 0.f;
#pragma unroll
        for (int j = 0; j < 8; ++j) { const f32x4 g2 = *(const f32x4*)(MOD + b * MODN + MOD_G2 + 4 * lane + 256 * j); const u32x2 u0 = *(const u32x2*)(y0 + 256 * j), u1 = *(const u32x2*)(y1 + 256 * j);
            f32x4 y; y[0] = bf2f(u0.x & 0xffffu) + bf2f(u1.x & 0xffffu); y[1] = bf2f(u0.x >> 16) + bf2f(u1.x >> 16); y[2] = bf2f(u0.y & 0xffffu) + bf2f(u1.y & 0xffffu); y[3] = bf2f(u0.y >> 16) + bf2f(u1.y >> 16);
            v[j] = *(const f32x4*)(xr + 256 * j) * ALPHA + g2 * y; s += (v[j][0] + v[j][1]) + (v[j][2] + v[j][3]); }
        const float mean = wave_sum(s) * (1.f / DM); float s2 = 0.f;
#pragma unroll
        for (int j = 0; j < 8; ++j) { v[j] = v[j] - mean; s2 += (v[j][0] * v[j][0] + v[j][1] * v[j][1]) + (v[j][2] * v[j][2] + v[j][3] * v[j][3]); }
        const float rstd = 1.0f / sqrtf(wave_sum(s2) * (1.f / DM) + LN_EPS);
        float* o = a.out + (size_t)row * DM + 4 * lane;
#pragma unroll
        for (int j = 0; j < 8; ++j) { const f32x4 g = *(const f32x4*)(a.ln2g + 4 * lane + 256 * j), bb = *(const f32x4*)(a.ln2b + 4 * lane + 256 * j); *(f32x4*)(o + 256 * j) = v[j] * rstd * g + bb; }
    }
}

template <int PH> __global__ void __launch_bounds__(512, 2) k_thin(Args a) {
    extern __shared__ __attribute__((aligned(16))) unsigned char lds[];
    const int wg = blockIdx.x, nwg = gridDim.x;
    if (PH == 0) { ph_mod(a, (LAS float*)lds, wg, nwg); ph_rope_table(a, wg, nwg); }
    if (PH == 1) ph_ln0(a, wg, nwg);
    if (PH == 3) ph_kmean(a, wg, nwg);
    if (PH == 6) ph_ln1_route(a, (LAS unsigned char*)lds, wg, nwg);
    if (PH == 9) ph_final(a, wg, nwg);
}

template <class F> __global__ void __launch_bounds__(256) nk_gemm(F f, int K) {
    __shared__ float As[16][68]; __shared__ float Bs[16][68];
    const int tid = threadIdx.x, tx = tid & 15, ty = tid >> 4, z = blockIdx.z, m0 = blockIdx.y * 64, n0 = blockIdx.x * 64;
    if (!f.active(z, m0)) return;
    float acc[4][4] = {};
    const int ar = tid >> 2, ak = (tid & 3) * 4; const bf16* arow = f.arow(z, m0 + ar);
    const int bk = tid >> 4, bn = (tid & 15) * 4;
    for (int k0 = 0; k0 < K; k0 += 16) {
        float a4[4] = {0.f, 0.f, 0.f, 0.f};
        if (arow) { const u32x2 u = *(const u32x2*)(arow + k0 + ak); a4[0] = bf2f(u.x & 0xffffu); a4[1] = bf2f(u.x >> 16); a4[2] = bf2f(u.y & 0xffffu); a4[3] = bf2f(u.y >> 16); }
#pragma unroll
        for (int i = 0; i < 4; ++i) As[ak + i][ar] = a4[i];
#pragma unroll
        for (int i = 0; i < 4; ++i) Bs[bk][bn + i] = f.b(z, k0 + bk, n0 + bn + i);
        __syncthreads();
#pragma unroll
        for (int kk = 0; kk < 16; ++kk) { float av[4], bv[4];
#pragma unroll
            for (int i = 0; i < 4; ++i) { av[i] = As[kk][ty * 4 + i]; bv[i] = Bs[kk][tx * 4 + i]; }
#pragma unroll
            for (int i = 0; i < 4; ++i)
#pragma unroll
                for (int j = 0; j < 4; ++j) acc[i][j] += av[i] * bv[j]; }
        __syncthreads();
    }
#pragma unroll
    for (int i = 0; i < 4; ++i)
#pragma unroll
        for (int j = 0; j < 4; ++j) f.store(z, m0 + ty * 4 + i, n0 + tx * 4 + j, acc[i][j]);
}
struct FProj { const bf16* A; const float* W; float* C;
    __device__ bool active(int, int) const { return true; }
    __device__ const bf16* arow(int, int m) const { return A + (size_t)m * DM; }
    __device__ float b(int, int k, int n) const { return W[(size_t)k * INCOLS + n]; }
    __device__ void store(int, int m, int n, float v) const { C[(size_t)m * INCOLS + n] = v; } };
struct FQ { const bf16* PROJ; const float* W; const float* g; float* C;
    __device__ bool active(int, int) const { return true; }
    __device__ const bf16* arow(int, int m) const { return PROJ + (size_t)m * PROJ_N; }
    __device__ float b(int, int k, int n) const { return g[k] * W[(size_t)k * 1536 + n]; }
    __device__ void store(int, int m, int n, float v) const { C[(size_t)m * 1536 + n] = v; } };
struct FKV { const bf16* PROJ; const float* W; const float* g; const float* SS; bf16* KV;
    __device__ bool active(int, int) const { return true; }
    __device__ const bf16* arow(int, int m) const { return PROJ + (size_t)m * PROJ_N + QR; }
    __device__ float b(int, int k, int n) const { return g[k] * W[(size_t)k * 2048 + n]; }
    __device__ void store(int, int m, int n, float v) const { const float* s = SS + (size_t)m * 12 + 8; const float rs = 1.0f / sqrtf(((s[0] + s[1]) + (s[2] + s[3])) * (1.f / KVR) + RMS_EPS); KV[(size_t)m * 2048 + n] = (bf16)f2bf(v * rs); } };
struct FOut { const bf16* ATT; const float* W; const float* x; const float* MOD; float* X1;
    __device__ bool active(int, int) const { return true; }
    __device__ const bf16* arow(int, int m) const { return ATT + (size_t)m * DM; }
    __device__ float b(int, int k, int n) const { return W[(size_t)k * DM + n]; }
    __device__ void store(int, int m, int n, float v) const { const int b_ = m / SEQ; X1[(size_t)m * DM + n] = ALPHA * x[(size_t)m * DM + n] + MOD[b_ * MODN + MOD_G1 + n] * v; } };
struct FMoe1 { const bf16* H; const float* w1; const float* w3; const unsigned* cnt; const int* LIST; float* C;
    __device__ bool active(int e, int m0) const { return m0 < (int)cnt[e]; }
    __device__ const bf16* arow(int e, int m) const { return m < (int)cnt[e] ? H + (size_t)(LIST[e * NT + m] >> 1) * DM : nullptr; }
    __device__ float b(int e, int k, int n) const { return n < FF ? w1[((size_t)e * DM + k) * FF + n] : w3[((size_t)e * DM + k) * FF + n - FF]; }
    __device__ void store(int e, int m, int n, float v) const { if (m < (int)cnt[e]) C[(size_t)(moe_rowbase(cnt, e) + m) * 1024 + n] = v; } };
struct FMoe2 { const bf16* HID; const float* w2; const unsigned* cnt; const int* LIST; bf16* YS;
    __device__ bool active(int e, int m0) const { return m0 < (int)cnt[e]; }
    __device__ const bf16* arow(int e, int m) const { return m < (int)cnt[e] ? HID + (size_t)(moe_rowbase(cnt, e) + m) * FF : nullptr; }
    __device__ float b(int e, int k, int n) const { return w2[((size_t)e * FF + k) * DM + n]; }
    __device__ void store(int e, int m, int n, float v) const { if (m < (int)cnt[e]) YS[(size_t)LIST[e * NT + m] * DM + n] = (bf16)f2bf(v); } };

__global__ void __launch_bounds__(256) nk_epi_proj(Args a) {
    const int row = blockIdx.x, tid = threadIdx.x, pos = row % SEQ;
    const float* T = (const float*)(a.ws + WS_W13) + (size_t)row * INCOLS; bf16* P = (bf16*)(a.ws + WS_PROJ) + (size_t)row * PROJ_N;
    const float* RT = (const float*)(a.ws + WS_ROPE); float* SS = (float*)(a.ws + WS_SS) + (size_t)row * 12;
    __shared__ float red[2][256];
    float sq = 0.f, skv = 0.f;
    for (int n = tid; n < PROJ_N; n += 256) {
        float v;
        if (n < PC_KR) { v = T[n]; if (n < QR) sq += v * v; else skv += v * v; }
        else if (n < PC_KR + 64) { const int jj = n - PC_KR, i = jj >> 1, s = jj & 1; const float x1 = T[768 + i], x2 = T[768 + 32 + i], cs = RT[2 * (pos * 32 + i)], sn = RT[2 * (pos * 32 + i) + 1]; v = s == 0 ? x1 * cs - x2 * sn : x1 * sn + x2 * cs; }
        else if (n < PC_QMO) v = 0.f;
        else v = T[n - 192];
        P[n] = (bf16)f2bf(v);
    }
    red[0][tid] = sq; red[1][tid] = skv; __syncthreads();
    for (int o = 128; o > 0; o >>= 1) { if (tid < o) { red[0][tid] += red[0][tid + o]; red[1][tid] += red[1][tid + o]; } __syncthreads(); }
    if (tid < 12) SS[tid] = tid == 0 ? red[0][0] : (tid == 8 ? red[1][0] : 0.f);
}
__global__ void __launch_bounds__(256) nk_epi_q(Args a) {
    const int row = blockIdx.x, tid = threadIdx.x, pos = row % SEQ;
    const float* T = (const float*)(a.ws + WS_W13) + (size_t)row * 1536; bf16* Q = (bf16*)(a.ws + WS_QM) + (size_t)row * 1536;
    const float* RT = (const float*)(a.ws + WS_ROPE); const float* s = (const float*)(a.ws + WS_SS) + (size_t)row * 12;
    const float rs = 1.0f / sqrtf((((s[0] + s[1]) + (s[2] + s[3])) + ((s[4] + s[5]) + (s[6] + s[7]))) * (1.f / QR) + RMS_EPS);
    for (int n = tid; n < 1536; n += 256) {
        const int h = n / QHD, j = n % QHD; float v;
        if (j < 128) v = T[n] * rs;
        else { const int jj = j - 128, i = jj >> 1, sx = jj & 1; const float x1 = T[h * QHD + 128 + i] * rs, x2 = T[h * QHD + 160 + i] * rs, cs = RT[2 * (pos * 32 + i)], sn = RT[2 * (pos * 32 + i) + 1]; v = sx == 0 ? x1 * cs - x2 * sn : x1 * sn + x2 * cs; }
        Q[n] = (bf16)f2bf(v);
    }
}
__global__ void __launch_bounds__(256) nk_epi_moe1(Args a) {
    const unsigned* cnt = (const unsigned*)(a.ws + WS_CTL) + CW_CNT; const int e = blockIdx.x, m0 = blockIdx.y * 64;
    if (m0 >= (int)cnt[e]) return;
    const int* LIST = (const int*)(a.ws + WS_LIST); const float* WGT = (const float*)(a.ws + WS_ROUTE + 65536);
    const float* T = (const float*)(a.ws + WS_W13); bf16* HID = (bf16*)(a.ws + WS_QM); const int rb = moe_rowbase(cnt, e);
    for (int m = m0; m < m0 + 64 && m < (int)cnt[e]; ++m) { const float w = WGT[LIST[e * NT + m]]; const size_t R = (size_t)(rb + m);
        for (int f = threadIdx.x; f < FF; f += 256) { const float a1 = T[R * 1024 + f], a3 = T[R * 1024 + FF + f]; HID[R * FF + f] = (bf16)f2bf(silu_f(a1) * a3 * w); } }
}
__global__ void __launch_bounds__(128) nk_attn_mla(Args a) {
    __shared__ float sc[2][SEQ]; __shared__ float qv[2][QHD];
    const int lane = threadIdx.x & 63, w = threadIdx.x >> 6, b = blockIdx.z, h = blockIdx.y, q = blockIdx.x * 2 + w;
    const bf16* QM = (const bf16*)(a.ws + WS_QM); const bf16* KV = (const bf16*)(a.ws + WS_KV); const bf16* PROJ = (const bf16*)(a.ws + WS_PROJ); bf16* ATT = (bf16*)(a.ws + WS_ATT);
    const size_t row = (size_t)b * SEQ + q; const float scale = 0.07216878364870322f;
    for (int d = lane; d < QHD; d += 64) qv[w][d] = bf2f(QM[row * 1536 + h * QHD + d]);
    __syncthreads();
    float mx = -INFINITY;
    for (int k = lane; k <= q; k += 64) { const size_t kr = (size_t)b * SEQ + k; const bf16* kn = KV + kr * 2048 + h * 256; const bf16* kp = PROJ + kr * PROJ_N + PC_KR; float dsum = 0.f;
        for (int d = 0; d < 128; ++d) dsum += qv[w][d] * bf2f(kn[d]);
        for (int d = 0; d < 64; ++d) dsum += qv[w][128 + d] * bf2f(kp[d]);
        dsum *= scale; sc[w][k] = dsum; mx = fmaxf(mx, dsum); }
    mx = wave_max(mx); float sum = 0.f;
    for (int k = lane; k <= q; k += 64) { const float p = expf(sc[w][k] - mx); sc[w][k] = p; sum += p; }
    sum = wave_sum(sum);
    __syncthreads();
    float o0 = 0.f, o1 = 0.f;
    for (int k = 0; k <= q; ++k) { const unsigned u = *(const unsigned*)(KV + ((size_t)b * SEQ + k) * 2048 + h * 256 + 128 + 2 * lane); const float p = sc[w][k]; o0 += p * bf2f(u & 0xffffu); o1 += p * bf2f(u >> 16); }
    const float inv = 1.0f / sum;
    *(unsigned*)(ATT + row * DM + h * 128 + 2 * lane) = pk2(o0 * inv, o1 * inv);
}
__global__ void __launch_bounds__(256) nk_attn_moba(Args a) {
    __shared__ float sc[4][1024]; __shared__ float qv[4][128]; __shared__ int selb[4][4];
    const int lane = threadIdx.x & 63, w = threadIdx.x >> 6, b = blockIdx.z, h = blockIdx.y, q = blockIdx.x * 4 + w, qblk = q / MBLK;
    const bf16* PROJ = (const bf16*)(a.ws + WS_PROJ); bf16* ATT = (bf16*)(a.ws + WS_ATT); const float* KM = (const float*)(a.ws + WS_KMEAN) + (size_t)(b * NH + h) * NBLK * 128;
    const size_t row = (size_t)b * SEQ + q; const float scale = 0.08838834764831845f;
    for (int d = lane; d < 128; d += 64) qv[w][d] = bf2f(PROJ[row * PROJ_N + PC_QMO + h * 128 + d]);
    __syncthreads();
    float gate = -INFINITY;
    if (lane < qblk) { float s = 0.f; for (int d = 0; d < 128; ++d) s += qv[w][d] * KM[lane * 128 + d]; gate = s; }
    const int nsel = qblk < 3 ? qblk : 3;
    for (int s = 0; s < nsel; ++s) {
        float bv = gate; int bi = lane;
#pragma unroll
        for (int o = 1; o < 64; o <<= 1) { const float ov = __shfl_xor(bv, o); const int oi = __shfl_xor(bi, o); if (ov > bv || (ov == bv && oi < bi)) { bv = ov; bi = oi; } }
        if (lane == 0) selb[w][s] = bi;
        if (lane == bi) gate = -INFINITY;
    }
    if (lane == 0) selb[w][nsel] = qblk;
    __syncthreads();
    float mx = -INFINITY;
    for (int s = 0; s <= nsel; ++s) { const int blk = selb[w][s];
        for (int kk = lane; kk < MBLK; kk += 64) { const int key = blk * MBLK + kk; float v = -INFINITY;
            if (key <= q) { const bf16* kp = PROJ + ((size_t)b * SEQ + key) * PROJ_N + PC_KMO + h * 128; float dsum = 0.f;
                for (int d = 0; d < 128; ++d) dsum += qv[w][d] * bf2f(kp[d]);
                v = dsum * scale + a.t5[t5_bucket(q - key) * NH + h]; }
            sc[w][s * MBLK + kk] = v; mx = fmaxf(mx, v); } }
    mx = wave_max(mx); float sum = 0.f;
    for (int i = lane; i < (nsel + 1) * MBLK; i += 64) { const float p = expf(sc[w][i] - mx); sc[w][i] = p; sum += p; }
    sum = wave_sum(sum);
    __syncthreads();
    float o0 = 0.f, o1 = 0.f;
    for (int s = 0; s <= nsel; ++s) { const int blk = selb[w][s];
        for (int kk = 0; kk < MBLK; ++kk) { const int key = blk * MBLK + kk; if (key > q) break;
            const unsigned u = *(const unsigned*)(PROJ + ((size_t)b * SEQ + key) * PROJ_N + PC_VMO + h * 128 + 2 * lane); const float p = sc[w][s * MBLK + kk]; o0 += p * bf2f(u & 0xffffu); o1 += p * bf2f(u >> 16); } }
    const float inv = 1.0f / sum;
    *(unsigned*)(ATT + row * DM + 1024 + h * 128 + 2 * lane) = pk2(o0 * inv, o1 * inv);
}

namespace pg8 {
typedef unsigned short bf16_t;
typedef short bf16x8 __attribute__((ext_vector_type(8)));
constexpr int BM = 256, BK = 64, HALF = 128, HTB = HALF * BK * 2, STAGE_BYTES = 8 * HTB, NXCD = 8, WGM = 8;
__host__ __device__ __forceinline__ int lds_byte(int r, int c) { const int st = (r >> 4) * 2 + (c >> 5), rr = r & 15, cc = c & 31, ob = rr * 64 + cc * 2; return st * 1024 + (ob ^ (((ob >> 9) & 1) << 5)); }
__host__ __device__ __forceinline__ void stage_rc(int b, int& R, int& C) { const int st = b / 1024, sb = b % 1024, swz = sb ^ (((sb >> 9) & 1) << 5); R = (st >> 1) * 16 + swz / 64; C = (st & 1) * 32 + (swz % 64) / 2; }
__host__ __device__ __forceinline__ int perm32(int rho) { const int n = rho >> 4, i = rho & 15; return 8 * (i >> 2) + 4 * n + (i & 3); }

struct Unit { int pm, pn, e, mt, cnt; };
struct Gemm { const bf16_t* A; const bf16_t* Bt; int K, lda, ldb; };

struct StaticOrder {
    int nM, nN, nwg, G, c;
    __device__ void init(int M, int N, int G_, int c_) { nM = M / BM; nN = N / BM; nwg = nM * nN; G = G_; c = c_; }
    __device__ bool next(int i, Unit& u) const {
        const long L = (long)i * G + c; if (L >= nwg) return false;
        int wgid = (int)L; { const int q = nwg / NXCD, r = nwg % NXCD, xcd = wgid % NXCD, off = wgid / NXCD; wgid = (xcd < r ? xcd * (q + 1) : r * (q + 1) + (xcd - r) * q) + off; }
        const int nig = WGM * nN, gid = wgid / nig, fm = gid * WGM, gsz = (nM - fm) < WGM ? (nM - fm) : WGM;
        u.pm = fm + ((wgid % nig) % gsz); u.pn = (wgid % nig) / gsz; u.e = 0; u.mt = 0; u.cnt = 0; return true;
    }
};
struct MoeOrder {
    const unsigned* cnt; int NPN, G, c;
    __device__ bool next(int i, Unit& u) const {
        int L = i * G + c, rb = 0;
        for (int e = 0; e < NE; ++e) { const int ce = (int)cnt[e], nm = (ce + 255) >> 8, nu = nm * NPN;
            if (L < nu) { u.e = e; u.mt = L / NPN; u.pn = e * NPN + L % NPN; u.pm = rb + u.mt; u.cnt = ce; return true; }
            L -= nu; rb += nm; }
        return false;
    }
};
struct ADense { int lda;
    __device__ __forceinline__ void get(const Unit& u, unsigned (&off)[2][2]) const {
        const int tid = tid_opaque();
#pragma unroll
        for (int i = 0; i < 2; ++i) { int R, C; stage_rc(tid * 16 + i * 8192, R, C);
#pragma unroll
            for (int h = 0; h < 2; ++h) off[h][i] = (unsigned)((u.pm * BM + h * HALF + R) * lda + C) * 2u; } } };
struct AGather { const int* LIST; int lda;
    __device__ __forceinline__ void get(const Unit& u, unsigned (&off)[2][2]) const {
        const int tid = tid_opaque();
#pragma unroll
        for (int i = 0; i < 2; ++i) { int R, C; stage_rc(tid * 16 + i * 8192, R, C);
#pragma unroll
            for (int h = 0; h < 2; ++h) { const int idx = u.mt * BM + h * HALF + R; const int tok = idx < u.cnt ? (LIST[u.e * NT + idx] >> 1) : 0; off[h][i] = (unsigned)(tok * lda + C) * 2u; } } } };

template <class Epi, class Sched, class AOff, bool ALIGN_EPI>
__device__ __forceinline__ void gemm_phase(LAS unsigned char* lds, const Gemm g, const Sched& S, const AOff& AO, const Epi& E) {
    const int tid = tid_opaque(), wid = __builtin_amdgcn_readfirstlane(tid >> 6), lane = tid & 63, wr = wid >> 2, wc = wid & 3, fr = lane & 15, fq = lane >> 4;
    const int K = g.K, nt = K / BK;
    unsigned voffB[2];
#pragma unroll
    for (int i = 0; i < 2; ++i) { int R, C; stage_rc(tid * 16 + i * 8192, R, C); const int Rb = Epi::PERM ? ((R & ~31) + perm32(R & 31)) : R;
        voffB[i] = (unsigned)(Rb * g.ldb + C) * 2u; }
    const size_t kstep = (size_t)(BK * 2);
    const size_t hstepB = (size_t)HALF * g.ldb * 2, tstepB = 2 * hstepB;
    const unsigned ldsw = (unsigned)wid * 1024u;
    const int aoff = lds_byte(wr * 64 + fr, fq * 8), boff = lds_byte(wc * 32 + fr, fq * 8);
#define PG8_SA(b, h) (((b) * 2 + (h)) * HTB)
#define PG8_SB(b, h) ((4 + (b) * 2 + (h)) * HTB)
#define PG8_STAGE(bufoff, gbase, voff) do { _Pragma("unroll") for (int _i = 0; _i < 2; ++_i) \
        __builtin_amdgcn_global_load_lds((const unsigned*)((const char*)(gbase) + (voff)[_i]), (LAS unsigned*)(lds + (bufoff) + ldsw + _i * 8192), 16, 0, 0); } while (0)
#define PG8_LDA(dst, b, h) do { _Pragma("unroll") for (int m = 0; m < 4; ++m) _Pragma("unroll") for (int k = 0; k < 2; ++k) dst[m][k] = *(const LAS bf16x8*)(lds + PG8_SA(b, h) + aoff + m * 2048 + k * 1024); } while (0)
#define PG8_LDB(dst, b, h) do { _Pragma("unroll") for (int n = 0; n < 2; ++n) _Pragma("unroll") for (int k = 0; k < 2; ++k) dst[n][k] = *(const LAS bf16x8*)(lds + PG8_SB(b, h) + boff + n * 2048 + k * 1024); } while (0)
#define PG8_MMA(ai, bj, At, Bt) do { __builtin_amdgcn_s_setprio(1); _Pragma("unroll") for (int m = 0; m < 4; ++m) _Pragma("unroll") for (int n = 0; n < 2; ++n) _Pragma("unroll") for (int k = 0; k < 2; ++k) \
        acc[ai][bj][m][n] = __builtin_amdgcn_mfma_f32_16x16x32_bf16(Bt[n][k], At[m][k], acc[ai][bj][m][n], 0, 0, 0); __builtin_amdgcn_s_setprio(0); } while (0)
#define PG8_WAIT_V(n) asm volatile("s_waitcnt vmcnt(" #n ")" ::: "memory")
#define PG8_WAIT_L(n) asm volatile("s_waitcnt lgkmcnt(" #n ")" ::: "memory")
#define PG8_BAR __builtin_amdgcn_s_barrier()
#define PG8_SCHED __builtin_amdgcn_sched_barrier(0)
    Unit cur, nxt; int ui = 0;
    if (!S.next(0, cur)) return;
    f32x4 acc[2][2][4][2];
#pragma unroll
    for (int a = 0; a < 2; ++a)
#pragma unroll
        for (int b = 0; b < 2; ++b)
#pragma unroll
            for (int m = 0; m < 4; ++m)
#pragma unroll
                for (int n = 0; n < 2; ++n) acc[a][b][m][n] = (f32x4){0.f, 0.f, 0.f, 0.f};
    bf16x8 At[4][2], B0[2][2], B1[2][2];
    const char* Ab = (const char*)g.A;
    const char* cB = (const char*)g.Bt + (size_t)cur.pn * tstepB;
    unsigned offC[2][2], offN[2][2];
    AO.get(cur, offC);
    PG8_STAGE(PG8_SB(0, 0), cB, voffB); PG8_STAGE(PG8_SB(0, 1), cB + hstepB, voffB); PG8_STAGE(PG8_SA(0, 0), Ab, offC[0]); PG8_STAGE(PG8_SA(0, 1), Ab, offC[1]);
    if (wr == 1) PG8_BAR;
    PG8_WAIT_V(2); PG8_BAR;
    PG8_STAGE(PG8_SB(1, 0), cB + kstep, voffB); PG8_STAGE(PG8_SA(1, 0), Ab + kstep, offC[0]); PG8_STAGE(PG8_SB(1, 1), cB + hstepB + kstep, voffB);
    PG8_WAIT_V(6); PG8_BAR;
    for (;;) {
        const bool has_next = S.next(ui + 1, nxt);
        if (!has_next) nxt = cur;
        AO.get(nxt, offN);
        const char* nB = (const char*)g.Bt + (size_t)nxt.pn * tstepB;
        for (int t = 0; t < nt; t += 2) {
            const bool last = (t == nt - 2);
            const char* a1 = Ab + (size_t)(t + 1) * kstep;
            const char* a2 = last ? Ab : Ab + (size_t)(t + 2) * kstep; const char* b2 = last ? nB : cB + (size_t)(t + 2) * kstep;
            const char* a3 = a2 + kstep; const char* b3 = b2 + kstep;
            PG8_LDB(B0, 0, 0); PG8_LDB(B1, 0, 1); PG8_SCHED; PG8_LDA(At, 0, 0); PG8_STAGE(PG8_SA(1, 1), a1, offC[1]);
            if (last) {
#pragma unroll
                for (int h = 0; h < 2; ++h)
#pragma unroll
                    for (int i = 0; i < 2; ++i) offC[h][i] = offN[h][i]; }
            PG8_WAIT_V(8); PG8_WAIT_L(0); PG8_BAR; PG8_MMA(0, 0, At, B0); PG8_MMA(0, 1, At, B1); PG8_BAR; PG8_SCHED;
            PG8_LDA(At, 0, 1); PG8_STAGE(PG8_SB(0, 0), b2, voffB); PG8_STAGE(PG8_SB(0, 1), b2 + hstepB, voffB); PG8_STAGE(PG8_SA(0, 0), a2, offC[0]);
            PG8_WAIT_V(8); PG8_WAIT_L(0); PG8_BAR; PG8_MMA(1, 0, At, B0); PG8_MMA(1, 1, At, B1); PG8_BAR; PG8_SCHED;
            PG8_LDB(B0, 1, 0); PG8_LDB(B1, 1, 1); PG8_SCHED; PG8_LDA(At, 1, 0); PG8_STAGE(PG8_SA(0, 1), a2, offC[1]);
            PG8_WAIT_V(8); PG8_WAIT_L(0); PG8_BAR; PG8_MMA(0, 0, At, B0); PG8_MMA(0, 1, At, B1); PG8_BAR; PG8_SCHED;
            PG8_LDA(At, 1, 1); PG8_STAGE(PG8_SB(1, 0), b3, voffB); PG8_STAGE(PG8_SB(1, 1), b3 + hstepB, voffB); PG8_STAGE(PG8_SA(1, 0), a3, offC[0]);
            PG8_WAIT_V(8); PG8_WAIT_L(0); PG8_BAR; PG8_MMA(1, 0, At, B0); PG8_MMA(1, 1, At, B1); PG8_BAR; PG8_SCHED;
        }
        if constexpr (ALIGN_EPI) { if (wr == 0) PG8_BAR; }
        E(acc, cur, wr, wc, fr, fq);
        if (!has_next) break;
#pragma unroll
        for (int a = 0; a < 2; ++a)
#pragma unroll
            for (int b = 0; b < 2; ++b)
#pragma unroll
                for (int m = 0; m < 4; ++m)
#pragma unroll
                    for (int n = 0; n < 2; ++n) acc[a][b][m][n] = (f32x4){0.f, 0.f, 0.f, 0.f};
        cur = nxt; cB = nB; ++ui;
        if constexpr (ALIGN_EPI) { if (wr == 1) PG8_BAR; }
    }
    PG8_WAIT_V(0);
    if constexpr (!ALIGN_EPI) { if (wr == 0) PG8_BAR; }
    PG8_BAR;
#undef PG8_SA
#undef PG8_SB
#undef PG8_STAGE
#undef PG8_LDA
#undef PG8_LDB
#undef PG8_MMA
#undef PG8_WAIT_V
#undef PG8_WAIT_L
#undef PG8_BAR
#undef PG8_SCHED
}

__device__ __forceinline__ unsigned cvt_pk_bf16(float lo, float hi) { unsigned r; asm volatile("v_cvt_pk_bf16_f32 %0, %1, %2" : "=v"(r) : "v"(lo), "v"(hi)); return r; }
__device__ __forceinline__ u32x4 pack8(const f32x4 v0, const f32x4 v1) { u32x4 w; w.x = cvt_pk_bf16(v0[0], v0[1]); w.y = cvt_pk_bf16(v0[2], v0[3]); w.z = cvt_pk_bf16(v1[0], v1[1]); w.w = cvt_pk_bf16(v1[2], v1[3]); return w; }
__device__ __forceinline__ void rope8(f32x4& v0, f32x4& v1, const float* RT, int pos, int i0) {
    const f32x4 t0 = *(const f32x4*)(RT + (size_t)(pos * 32 + i0) * 2), t1 = *(const f32x4*)(RT + (size_t)(pos * 32 + i0) * 2 + 4);
    f32x4 o0, o1;
    o0[0] = v0[0] * t0[0] - v0[1] * t0[1]; o0[1] = v0[0] * t0[1] + v0[1] * t0[0]; o0[2] = v0[2] * t0[2] - v0[3] * t0[3]; o0[3] = v0[2] * t0[3] + v0[3] * t0[2];
    o1[0] = v1[0] * t1[0] - v1[1] * t1[1]; o1[1] = v1[0] * t1[1] + v1[1] * t1[0]; o1[2] = v1[2] * t1[2] - v1[3] * t1[3]; o1[3] = v1[2] * t1[3] + v1[3] * t1[2];
    v0 = o0; v1 = o1;
}
struct EpiProj {
    static constexpr bool PERM = true;
    bf16_t* P; const float* RT; float* SS;
    __device__ __forceinline__ void operator()(const f32x4 (&acc)[2][2][4][2], const Unit& u, int wr, int wc, int fr, int fq) const {
        const int row0 = u.pm * BM + wr * 64 + fr, col0 = u.pn * BM + wc * 32 + 8 * fq;
#pragma unroll
        for (int ai = 0; ai < 2; ++ai)
#pragma unroll
            for (int m = 0; m < 4; ++m) { const int row = row0 + ai * HALF + m * 16; bf16_t* rowp = P + (size_t)row * PROJ_N + col0;
                if (u.pn < 3) { float s = 0.f;
#pragma unroll
                    for (int bj = 0; bj < 2; ++bj)
#pragma unroll
                        for (int n = 0; n < 2; ++n) { const f32x4 x = acc[ai][bj][m][n]; s += (x[0] * x[0] + x[1] * x[1]) + (x[2] * x[2] + x[3] * x[3]); }
                    s += __shfl_xor(s, 16); s += __shfl_xor(s, 32);
                    if (fq == 0) SS[(size_t)row * 12 + (u.pn < 2 ? u.pn * 4 + wc : 8 + wc)] = s; }
#pragma unroll
                for (int bj = 0; bj < 2; ++bj) { f32x4 v0 = acc[ai][bj][m][0], v1 = acc[ai][bj][m][1];
                    if (bj == 0 && u.pn == 3 && wc < 2) rope8(v0, v1, RT, row & (SEQ - 1), 16 * wc + 4 * fq);
                    *(u32x4*)(rowp + bj * HALF) = pack8(v0, v1); }
                asm volatile("" ::: "memory"); }
    }
};
struct EpiQ {
    static constexpr bool PERM = true;
    bf16_t* Q; const float* RT; const float* SS;
    __device__ __forceinline__ void operator()(const f32x4 (&acc)[2][2][4][2], const Unit& u, int wr, int wc, int fr, int fq) const {
        const int row0 = u.pm * BM + wr * 64 + fr, col0 = u.pn * BM + wc * 32 + 8 * fq;
#pragma unroll
        for (int ai = 0; ai < 2; ++ai)
#pragma unroll
            for (int m = 0; m < 4; ++m) { const int row = row0 + ai * HALF + m * 16; bf16_t* rowp = Q + (size_t)row * 1536 + col0;
                const f32x4 s0 = *(const f32x4*)(SS + (size_t)row * 12), s1 = *(const f32x4*)(SS + (size_t)row * 12 + 4);
                const float rs = 1.0f / sqrtf((((s0[0] + s0[1]) + (s0[2] + s0[3])) + ((s1[0] + s1[1]) + (s1[2] + s1[3]))) * (1.f / QR) + RMS_EPS);
#pragma unroll
                for (int bj = 0; bj < 2; ++bj) { f32x4 v0 = acc[ai][bj][m][0] * rs, v1 = acc[ai][bj][m][1] * rs; const int jh = (col0 + bj * HALF) % QHD;
                    if (jh >= 128) rope8(v0, v1, RT, row & (SEQ - 1), (jh - 128) >> 1);
                    *(u32x4*)(rowp + bj * HALF) = pack8(v0, v1); }
                asm volatile("" ::: "memory"); }
    }
};
struct EpiKV {
    static constexpr bool PERM = true;
    bf16_t* O; const float* SS;
    __device__ __forceinline__ void operator()(const f32x4 (&acc)[2][2][4][2], const Unit& u, int wr, int wc, int fr, int fq) const {
        const int row0 = u.pm * BM + wr * 64 + fr, col0 = u.pn * BM + wc * 32 + 8 * fq;
#pragma unroll
        for (int ai = 0; ai < 2; ++ai)
#pragma unroll
            for (int m = 0; m < 4; ++m) { const int row = row0 + ai * HALF + m * 16; bf16_t* rowp = O + (size_t)row * 2048 + col0;
                const f32x4 s0 = *(const f32x4*)(SS + (size_t)row * 12 + 8);
                const float rs = 1.0f / sqrtf(((s0[0] + s0[1]) + (s0[2] + s0[3])) * (1.f / KVR) + RMS_EPS);
#pragma unroll
                for (int bj = 0; bj < 2; ++bj) *(u32x4*)(rowp + bj * HALF) = pack8(acc[ai][bj][m][0] * rs, acc[ai][bj][m][1] * rs);
                asm volatile("" ::: "memory"); }
    }
};
struct EpiOut {
    static constexpr bool PERM = false;
    const float* x; const float* MOD; float* X1;
    __device__ __forceinline__ void operator()(const f32x4 (&acc)[2][2][4][2], const Unit& u, int wr, int wc, int fr, int fq) const {
        const int row0 = u.pm * BM + wr * 64 + fr, col0 = u.pn * BM + wc * 32 + 4 * fq; const int b = (u.pm * BM) / SEQ;
        f32x4 g1[2][2];
#pragma unroll
        for (int bj = 0; bj < 2; ++bj)
#pragma unroll
            for (int n = 0; n < 2; ++n) g1[bj][n] = *(const f32x4*)(MOD + b * MODN + MOD_G1 + col0 + bj * HALF + n * 16);
#pragma unroll
        for (int ai = 0; ai < 2; ++ai)
#pragma unroll
            for (int m = 0; m < 4; ++m) { const size_t off = (size_t)(row0 + ai * HALF + m * 16) * DM + col0;
#pragma unroll
                for (int bj = 0; bj < 2; ++bj)
#pragma unroll
                    for (int n = 0; n < 2; ++n) { const f32x4 xv = *(const f32x4*)(x + off + bj * HALF + n * 16); *(f32x4*)(X1 + off + bj * HALF + n * 16) = xv * ALPHA + g1[bj][n] * acc[ai][bj][m][n]; }
                asm volatile("" ::: "memory"); }
    }
};
struct EpiMoe1 {
    static constexpr bool PERM = true;
    bf16_t* HID; const int* LIST; const float* WGT;
    __device__ __forceinline__ void operator()(const f32x4 (&acc)[2][2][4][2], const Unit& u, int wr, int wc, int fr, int fq) const {
        const int r0 = wr * 64 + fr, col0 = (u.pn & 3) * 128 + wc * 32 + 8 * fq;
#pragma unroll
        for (int ai = 0; ai < 2; ++ai)
#pragma unroll
            for (int m = 0; m < 4; ++m) { const int rl = r0 + ai * HALF + m * 16, idx = u.mt * BM + rl;
                const float w = idx < u.cnt ? WGT[LIST[u.e * NT + idx]] : 0.f;
                f32x4 h0, h1;
#pragma unroll
                for (int j = 0; j < 4; ++j) { h0[j] = silu_f(acc[ai][0][m][0][j]) * acc[ai][1][m][0][j] * w; h1[j] = silu_f(acc[ai][0][m][1][j]) * acc[ai][1][m][1][j] * w; }
                *(u32x4*)(HID + (size_t)(u.pm * BM + rl) * FF + col0) = pack8(h0, h1);
                asm volatile("" ::: "memory"); }
    }
};
struct EpiMoe2 {
    static constexpr bool PERM = true;
    bf16_t* YS; const int* LIST;
    __device__ __forceinline__ void operator()(const f32x4 (&acc)[2][2][4][2], const Unit& u, int wr, int wc, int fr, int fq) const {
        const int r0 = wr * 64 + fr, col0 = (u.pn & 7) * BM + wc * 32 + 8 * fq;
#pragma unroll
        for (int ai = 0; ai < 2; ++ai)
#pragma unroll
            for (int m = 0; m < 4; ++m) { const int idx = u.mt * BM + r0 + ai * HALF + m * 16;
                if (idx < u.cnt) { bf16_t* rowp = YS + (size_t)LIST[u.e * NT + idx] * DM + col0;
#pragma unroll
                    for (int bj = 0; bj < 2; ++bj) *(u32x4*)(rowp + bj * HALF) = pack8(acc[ai][bj][m][0], acc[ai][bj][m][1]); }
                asm volatile("" ::: "memory"); }
    }
};
}

namespace att {
typedef short bf16x8 __attribute__((ext_vector_type(8)));
typedef short s16x4 __attribute__((ext_vector_type(4)));
typedef float f32x16 __attribute__((ext_vector_type(16)));
constexpr int SHM_V = 16384, SHM_K = 16384, SHM_R = 8192;
constexpr int L_V = 0, L_K = 32768, L_R = 65536, L_WS = 81920, L_LUT = 83968, L_KM = 84992, L_QW = 93184, L_END = 93200;
constexpr float THR = 8.f;
#define KSWZ(row, colB) ((row) * 256 + ((colB) ^ (((row) & 7) << 4)))
#define SBAR() __builtin_amdgcn_sched_barrier(0)
__device__ __forceinline__ int v_st(int k, int c) { const int kk = (k & ~0xC) | ((k & 4) << 1) | ((k & 8) >> 1); return ((kk >> 3) * 4 + (c >> 5)) * 512 + ((kk & 7) * 32 + (c & 31)) * 2; }
__device__ __forceinline__ int v_rd_base(int lane) { return ((lane & 3) << 3) | (((lane >> 2) & 3) << 6) | (((lane >> 4) & 1) << 5) | (((lane >> 5) & 1) << 8); }
constexpr int v_rd_off(int d0, int ks, int half) { return d0 * 512 + ks * 4096 + half * 2048; }
__device__ __forceinline__ int crow(int r, int hi) { return (r & 3) + 8 * (r >> 2) + 4 * hi; }
__device__ __forceinline__ unsigned cvtpk(float lo, float hi) { unsigned r; asm volatile("v_cvt_pk_bf16_f32 %0, %1, %2" : "=v"(r) : "v"(lo), "v"(hi)); return r; }

template <int SC1000> __device__ __forceinline__ void partialSM(f32x16& p0, f32x16& p1, float& m_reg, float& alpha, float SCALE) {
    float pmax = p0[0];
#pragma unroll
    for (int r = 1; r < 16; ++r) pmax = fmaxf(pmax, p0[r]);
#pragma unroll
    for (int r = 0; r < 16; ++r) pmax = fmaxf(pmax, p1[r]);
    { auto rr = __builtin_amdgcn_permlane32_swap(__float_as_uint(pmax), __float_as_uint(pmax), false, false); pmax = fmaxf(__uint_as_float(rr[0]), __uint_as_float(rr[1])); }
    const float C2 = 1.4426950408889634f * SCALE; float mn;
    if (__builtin_expect(__all((pmax - m_reg) * SCALE <= THR), 1)) { mn = m_reg; alpha = 1.f; }
    else { mn = fmaxf(m_reg, pmax); alpha = __builtin_amdgcn_exp2f((m_reg - mn) * C2); m_reg = mn; }
    const float mnL = -mn * C2;
#pragma unroll
    for (int r = 0; r < 16; ++r) p0[r] = fmaf(p0[r], C2, mnL);
#pragma unroll
    for (int r = 0; r < 16; ++r) p1[r] = fmaf(p1[r], C2, mnL);
#pragma unroll
    for (int r = 0; r < 16; ++r) p0[r] = __builtin_amdgcn_exp2f(p0[r]);
}
__device__ __forceinline__ void finishSM(f32x16& p0, f32x16& p1, float alpha, float& l_reg, bf16x8& pa0, bf16x8& pa1, bf16x8& pa2, bf16x8& pa3) {
#pragma unroll
    for (int r = 0; r < 16; ++r) p1[r] = __builtin_amdgcn_exp2f(p1[r]);
    float ps = 0;
#pragma unroll
    for (int r = 0; r < 16; ++r) ps += p0[r];
#pragma unroll
    for (int r = 0; r < 16; ++r) ps += p1[r];
    { auto rr = __builtin_amdgcn_permlane32_swap(__float_as_uint(ps), __float_as_uint(ps), false, false); ps = __uint_as_float(rr[0]) + __uint_as_float(rr[1]); }
    l_reg = l_reg * alpha + ps;
#define PK4(P, B_, OUT) do { unsigned a0 = cvtpk(P[B_+0], P[B_+1]), a1 = cvtpk(P[B_+2], P[B_+3]);                          \
        unsigned b0 = cvtpk(P[B_+4], P[B_+5]), b1 = cvtpk(P[B_+6], P[B_+7]);                                             \
        auto r0 = __builtin_amdgcn_permlane32_swap(a0, b0, false, false); auto r1 = __builtin_amdgcn_permlane32_swap(a1, b1, false, false); \
        u32x4 w = {r0[0], r1[0], r0[1], r1[1]}; OUT = __builtin_bit_cast(bf16x8, w); } while (0)
    PK4(p0, 0, pa0); PK4(p0, 8, pa1); PK4(p1, 0, pa2); PK4(p1, 8, pa3);
#undef PK4
}
template <int KB, int NQ>
__device__ __forceinline__ void qkt(f32x16& p0, f32x16& p1, LAS const unsigned char* lds, int r32, int hi, const bf16x8* qr) {
    p0 = f32x16{}; p1 = f32x16{};
    LAS const unsigned char* kb[4];
#pragma unroll
    for (int dd = 0; dd < 4; ++dd) kb[dd] = lds + L_K + KB * SHM_K + KSWZ(r32, (dd * 16 + hi * 8) * 2);
#pragma unroll
    for (int d0 = 0; d0 < 8; ++d0) { LAS const unsigned char* p = kb[d0 & 3] + (d0 >> 2) * 128;
        const bf16x8 b0 = *(LAS const bf16x8*)p, b1 = *(LAS const bf16x8*)(p + 32 * 256);
        p0 = __builtin_amdgcn_mfma_f32_32x32x16_bf16(b0, qr[d0], p0, 0, 0, 0);
        p1 = __builtin_amdgcn_mfma_f32_32x32x16_bf16(b1, qr[d0], p1, 0, 0, 0); }
    if constexpr (NQ == 12) {
#pragma unroll
        for (int c = 0; c < 4; ++c) { LAS const unsigned char* p = lds + L_R + KB * SHM_R + r32 * 128 + ((c * 32 + hi * 16) ^ ((r32 & 7) << 4));
            const bf16x8 b0 = *(LAS const bf16x8*)p, b1 = *(LAS const bf16x8*)(p + 32 * 128);
            p0 = __builtin_amdgcn_mfma_f32_32x32x16_bf16(b0, qr[8 + c], p0, 0, 0, 0);
            p1 = __builtin_amdgcn_mfma_f32_32x32x16_bf16(b1, qr[8 + c], p1, 0, 0, 0); }
    }
}
template <int VB>
__device__ __forceinline__ void pv_tile(f32x16* o, int vb0, bf16x8 pa0, bf16x8 pa1, bf16x8 pa2, bf16x8 pa3) {
#define TRRD(dst, off) asm volatile("ds_read_b64_tr_b16 %0, %1 offset:%2" : "=&v"(dst) : "v"(vb0), "i"(off) : "memory")
#define PV_D0(d0) do { s16x4 l0, l1, l2, l3, h0, h1, h2, h3; constexpr int b_ = L_V + VB * SHM_V + v_rd_off(d0, 0, 0);   \
        TRRD(l0, b_); TRRD(h0, b_ + 2048); TRRD(l1, b_ + 4096); TRRD(h1, b_ + 6144); TRRD(l2, b_ + 8192); TRRD(h2, b_ + 10240); TRRD(l3, b_ + 12288); TRRD(h3, b_ + 14336); \
        asm volatile("s_waitcnt lgkmcnt(0)" ::: "memory"); SBAR();                                                           \
        o[d0] = __builtin_amdgcn_mfma_f32_32x32x16_bf16(pa0, (bf16x8){l0[0], l0[1], l0[2], l0[3], h0[0], h0[1], h0[2], h0[3]}, o[d0], 0, 0, 0);   \
        o[d0] = __builtin_amdgcn_mfma_f32_32x32x16_bf16(pa1, (bf16x8){l1[0], l1[1], l1[2], l1[3], h1[0], h1[1], h1[2], h1[3]}, o[d0], 0, 0, 0);   \
        o[d0] = __builtin_amdgcn_mfma_f32_32x32x16_bf16(pa2, (bf16x8){l2[0], l2[1], l2[2], l2[3], h2[0], h2[1], h2[2], h2[3]}, o[d0], 0, 0, 0);   \
        o[d0] = __builtin_amdgcn_mfma_f32_32x32x16_bf16(pa3, (bf16x8){l3[0], l3[1], l3[2], l3[3], h3[0], h3[1], h3[2], h3[3]}, o[d0], 0, 0, 0); } while (0)
    PV_D0(0); PV_D0(1); PV_D0(2); PV_D0(3);
#undef PV_D0
#undef TRRD
}

template <bool MLA>
__device__ __forceinline__ void attn_unit(const Args& a, LAS unsigned char* lds, int bh, int qt) {
    constexpr int NQ = MLA ? 12 : 8;
    constexpr float SCALE = MLA ? 0.07216878364870322f : 0.08838834764831845f;
    const int tid = tid_opaque(), wid = __builtin_amdgcn_readfirstlane(tid >> 6), lane = tid & 63, r32 = lane & 31, hi = lane >> 5;
    const int b = bh >> 3, h = bh & 7, q0 = qt * 256; const size_t rb = (size_t)b * SEQ;
    const bf16* PROJ = (const bf16*)(a.ws + WS_PROJ); const bf16* KV = (const bf16*)(a.ws + WS_KV); const bf16* QM = (const bf16*)(a.ws + WS_QM); bf16* ATT = (bf16*)(a.ws + WS_ATT);
    const bf16* Qp = MLA ? QM + (rb + q0 + wid * 32 + r32) * 1536 + h * QHD : PROJ + (rb + q0 + wid * 32 + r32) * PROJ_N + PC_QMO + h * 128;
    const int ldk = MLA ? 2048 : PROJ_N;
    const bf16* Kp = MLA ? KV + rb * 2048 + h * 256 : PROJ + rb * PROJ_N + PC_KMO + h * 128;
    const bf16* Vp = MLA ? KV + rb * 2048 + h * 256 + 128 : PROJ + rb * PROJ_N + PC_VMO + h * 128;
    const bf16* Rp = PROJ + rb * PROJ_N + PC_KR;
    bf16x8 qr[NQ];
#pragma unroll
    for (int d0 = 0; d0 < NQ; ++d0) qr[d0] = *(const bf16x8*)(Qp + d0 * 16 + hi * 8);
    LAS float* wsf = (LAS float*)(lds + L_WS) + wid * 64; LAS float* li_l = wsf; LAS float* al_l = wsf + 32;
    LAS float* LUT = (LAS float*)(lds + L_LUT); LAS float* KMl = (LAS float*)(lds + L_KM);
    unsigned selmask = 0u; float farb = 0.f;
    if constexpr (!MLA) {
        const float invs = 1.0f / SCALE;
        if (tid <= 128) LUT[tid] = a.t5[t5_bucket(tid < 128 ? tid : 128) * NH + h] * invs;
        const float* KMg = (const float*)(a.ws + WS_KMEAN) + (size_t)bh * NBLK * 128;
        for (int i = tid; i < qt * 128; i += 512) KMl[i] = KMg[i];
        farb = a.t5[31 * NH + h] * invs;
        __syncthreads();
        float g[16];
#pragma unroll
        for (int jb = 0; jb < 16; ++jb) { g[jb] = -INFINITY;
            if (jb < qt) { float s = 0.f;
#pragma unroll
                for (int d0 = 0; d0 < 8; ++d0) { const f32x4 k0 = *(LAS const f32x4*)(KMl + jb * 128 + 16 * d0 + 8 * hi), k1 = *(LAS const f32x4*)(KMl + jb * 128 + 16 * d0 + 8 * hi + 4);
                    const u32x4 qu = __builtin_bit_cast(u32x4, qr[d0]);
                    s += __uint_as_float(qu[0] << 16) * k0[0] + __uint_as_float(qu[0] & 0xffff0000u) * k0[1] + __uint_as_float(qu[1] << 16) * k0[2] + __uint_as_float(qu[1] & 0xffff0000u) * k0[3];
                    s += __uint_as_float(qu[2] << 16) * k1[0] + __uint_as_float(qu[2] & 0xffff0000u) * k1[1] + __uint_as_float(qu[3] << 16) * k1[2] + __uint_as_float(qu[3] & 0xffff0000u) * k1[3]; }
                s += __shfl_xor(s, 32); g[jb] = s; } }
        const int nsel = qt < 3 ? qt : 3;
#pragma unroll
        for (int s = 0; s < 3; ++s) if (s < nsel) { float best = -INFINITY; int bi = 0;
#pragma unroll
            for (int jb = 0; jb < 16; ++jb) { const bool ok = jb < qt && !((selmask >> jb) & 1u) && g[jb] > best; best = ok ? g[jb] : best; bi = ok ? jb : bi; }
            selmask |= 1u << bi; }
    }
    const int sr = tid >> 4, sc = (tid & 15) * 8, vst0 = v_st(sr, sc), vst1 = v_st(32 + sr, sc), kws = KSWZ(sr, sc * 2);
    const int rrow = tid >> 3, rch = tid & 7, rws = rrow * 128 + ((rch * 16) ^ ((rrow & 7) << 4));
    const int vb0 = (int)(unsigned)(uintptr_t)lds + v_rd_base(lane);
    bf16x8 st_k0, st_k1, st_v0, st_v1, st_r;
#define SLOAD(tt) do { const size_t kr_ = (size_t)((tt) * 64 + sr); st_k0 = *(const bf16x8*)(Kp + kr_ * ldk + sc); st_k1 = *(const bf16x8*)(Kp + (kr_ + 32) * ldk + sc);      \
        st_v0 = *(const bf16x8*)(Vp + kr_ * ldk + sc); st_v1 = *(const bf16x8*)(Vp + (kr_ + 32) * ldk + sc);                                                          \
        if constexpr (MLA) st_r = *(const bf16x8*)(Rp + (size_t)((tt) * 64 + rrow) * PROJ_N + rch * 8); } while (0)
#define SWRITE(bf) do { *(LAS bf16x8*)(lds + L_K + (bf) * SHM_K + kws) = st_k0; *(LAS bf16x8*)(lds + L_K + (bf) * SHM_K + kws + 32 * 256) = st_k1;                       \
        *(LAS bf16x8*)(lds + L_V + (bf) * SHM_V + vst0) = st_v0; *(LAS bf16x8*)(lds + L_V + (bf) * SHM_V + vst1) = st_v1;                                              \
        if constexpr (MLA) *(LAS bf16x8*)(lds + L_R + (bf) * SHM_R + rws) = st_r; } while (0)
    const int NTL = 4 * (qt + 1);
    const int qlo = q0 + wid * 32, qpos = qlo + r32;
    float m_reg = -1e30f, l_reg = 0.f; f32x16 o[4] = {};
    SLOAD(0); SWRITE(0);
    __syncthreads();
#define STEP(t, BUF) do {                                                                                                                                             \
        const int kbase_ = (t) * 64; const bool more_ = (t) + 1 < NTL;                                                                                               \
        if (more_) SLOAD((t) + 1);                                                                                                                                    \
        bool act_ = kbase_ <= qlo + 31;                                                                                                                               \
        bool sel_ = true;                                                                                                                                             \
        if constexpr (!MLA) { if (kbase_ < q0) { sel_ = ((selmask >> (kbase_ >> 8)) & 1u) != 0u; act_ = __any(sel_) != 0; } }                                         \
        if (act_) {                                                                                                                                                   \
            f32x16 p0, p1; float alpha; bf16x8 pa0, pa1, pa2, pa3;                                                                                                    \
            qkt<BUF, NQ>(p0, p1, lds, r32, hi, qr);                                                                                                                   \
            const int dq_ = qpos - kbase_ - 4 * hi;                                                                                                                   \
            if constexpr (!MLA) {                                                                                                                                     \
                if (kbase_ + 63 + 128 > qlo) {                                                                                                                        \
                    _Pragma("unroll") for (int r = 0; r < 16; ++r) { const int c = (r & 3) + 8 * (r >> 2); int i0 = dq_ - c, i1 = dq_ - c - 32;                       \
                        i0 = i0 < 0 ? 0 : (i0 > 128 ? 128 : i0); i1 = i1 < 0 ? 0 : (i1 > 128 ? 128 : i1); p0[r] += LUT[i0]; p1[r] += LUT[i1]; }                       \
                } else { _Pragma("unroll") for (int r = 0; r < 16; ++r) { p0[r] += farb; p1[r] += farb; } }                                                           \
                if (!sel_) { _Pragma("unroll") for (int r = 0; r < 16; ++r) { p0[r] = -INFINITY; p1[r] = -INFINITY; } }                                               \
            }                                                                                                                                                         \
            if (kbase_ + 63 > qlo) {                                                                                                                                  \
                _Pragma("unroll") for (int r = 0; r < 16; ++r) { const int c = (r & 3) + 8 * (r >> 2); if (dq_ - c < 0) p0[r] = -INFINITY; if (dq_ - c - 32 < 0) p1[r] = -INFINITY; } \
            }                                                                                                                                                         \
            partialSM<0>(p0, p1, m_reg, alpha, SCALE);                                                                                                                \
            if (__any(alpha < 1.f)) { if (hi == 0) al_l[r32] = alpha; asm volatile("s_waitcnt lgkmcnt(0)" ::: "memory");                                              \
                _Pragma("unroll") for (int d_ = 0; d_ < 4; ++d_) _Pragma("unroll") for (int r = 0; r < 16; ++r) o[d_][r] *= al_l[crow(r, hi)]; }                      \
            finishSM(p0, p1, alpha, l_reg, pa0, pa1, pa2, pa3); SBAR();                                                                                               \
            pv_tile<BUF>(o, vb0, pa0, pa1, pa2, pa3);                                                                                                                 \
        }                                                                                                                                                             \
        if (more_) SWRITE((BUF) ^ 1);                                                                                                                                 \
        __syncthreads(); } while (0)
    for (int t = 0; t < NTL; t += 2) { STEP(t, 0); STEP(t + 1, 1); }
#undef STEP
#undef SLOAD
#undef SWRITE
    if (hi == 0) li_l[r32] = l_reg;
    asm volatile("s_waitcnt lgkmcnt(0)" ::: "memory");
    bf16* Ow = ATT + (rb + q0 + wid * 32) * DM + (MLA ? 0 : 1024) + h * 128;
#pragma unroll
    for (int r = 0; r < 16; ++r) { const int orow = crow(r, hi); const float rl = __builtin_amdgcn_rcpf(li_l[orow]);
#pragma unroll
        for (int d0 = 0; d0 < 4; ++d0) { const float v = o[d0][r] * rl; const float vn = __shfl_xor(v, 1);
            if ((r32 & 1) == 0) *(unsigned*)(Ow + (size_t)orow * DM + d0 * 32 + r32) = cvtpk(v, vn); } }
}
__device__ __forceinline__ void attn_phase(const Args& a, LAS unsigned char* lds) {
    unsigned* queue = (unsigned*)(a.ws + WS_CTL) + CW_QUEUE;
    volatile LAS unsigned* qw = (volatile LAS unsigned*)(lds + L_QW);
    for (;;) {
        if (threadIdx.x == 0) qw[0] = __hip_atomic_fetch_add(queue, 1u, __ATOMIC_RELAXED, __HIP_MEMORY_SCOPE_AGENT);
        __syncthreads();
        const unsigned u = (unsigned)__builtin_amdgcn_readfirstlane((int)qw[0]);
        __syncthreads();
        if (u >= 512u) break;
        const int cls = (int)(u >> 4), bh = (int)(u & 15u);
        const unsigned tybits = 0x54aa552fu;
        const int qts[32] = {15,14,13,12,15,11,14,13,10,12,9,11,8,10,7,9,8,6,7,5,6,4,5,3,4,3,2,2,1,1,0,0};
        int qt = 0;
#pragma unroll
        for (int c = 0; c < 32; ++c) qt = (cls == c) ? qts[c] : qt;
        if ((tybits >> cls) & 1u) attn_unit<true>(a, lds, bh, qt); else attn_unit<false>(a, lds, bh, qt);
    }
}
#undef KSWZ
#undef SBAR
}

constexpr int RING_OFF = 0, RING_BYTES = 131072, SCR_OFF = 131072, MISC_OFF = 139264, LDS_BYTES = 147456;
constexpr int CW_BAR = 4096;
#define LDS_WAIT() asm volatile("s_waitcnt lgkmcnt(0)" ::: "memory")

#define XB_TMO      128
#define XB_XCNT(j)  (256  + 64 * (j))
#define XB_XSUB(j)  (1280 + 64 * (j))
#define XB_XGEN(j)  (2304 + 64 * (j))
#define XB_TOP      3328
#define XB_TOPGEN   3392
#define XCD_BAR_WORDS 3456
#define XB_SPIN_CAP (1u << 18)

__device__ __forceinline__ unsigned xb_ld(unsigned* p)              { return __hip_atomic_load(p, __ATOMIC_RELAXED, __HIP_MEMORY_SCOPE_AGENT); }
__device__ __forceinline__ unsigned xb_add(unsigned* p, unsigned v) { return __hip_atomic_fetch_add(p, v, __ATOMIC_RELAXED, __HIP_MEMORY_SCOPE_AGENT); }
__device__ __forceinline__ unsigned xb_xcc_id() { return (unsigned)__builtin_amdgcn_s_getreg((3 << 11) | 20) & 0xFu; }
#define XB_SPIN(cond, bar) do { unsigned _sp = 0; while (cond) { __builtin_amdgcn_s_sleep(1); \
    if ((++_sp & 255u) == 0u) { if (xb_ld(&(bar)[XB_TMO])) break; if (_sp > XB_SPIN_CAP) { atomicAdd(&(bar)[XB_TMO], 1u); break; } } } } while (0)

struct XcdBarrier {
    unsigned* bar; unsigned x;
    volatile LAS unsigned* st;
};
__device__ __forceinline__ XcdBarrier xcd_barrier_post(unsigned* bar, volatile LAS unsigned* st) {
    XcdBarrier b; b.bar = bar; b.x = xb_xcc_id(); b.st = st;
    if (threadIdx.x == 0) (void)xb_add(&bar[XB_XCNT(b.x)], 1u);
    return b;
}
__device__ __forceinline__ void xcd_barrier_complete(unsigned* bar, unsigned x, unsigned& nloc, unsigned& nx) {
    const unsigned G = gridDim.x * gridDim.y * gridDim.z;
    unsigned sum, cnt, mine, sp = 0u;
    for (;;) {
        sum = 0u; cnt = 0u; mine = 0u;
#pragma unroll
        for (unsigned j = 0; j < 16; ++j) { const unsigned c = xb_ld(&bar[XB_XCNT(j)]); sum += c; cnt += (c > 0u) ? 1u : 0u; mine = (j == x) ? c : mine; }
        if (sum == G) break;
        __builtin_amdgcn_s_sleep(1);
        if ((++sp & 255u) == 0u) { if (xb_ld(&bar[XB_TMO])) break; if (sp > XB_SPIN_CAP) { atomicAdd(&bar[XB_TMO], 1u); break; } }
    }
    nloc = mine > 0u ? mine : 1u; nx = cnt > 0u ? cnt : 1u;
}
__device__ __forceinline__ void xcd_barrier(const XcdBarrier& b) {
    asm volatile("s_waitcnt vmcnt(0)" ::: "memory");
    __syncthreads();
    if (threadIdx.x == 0) {
        unsigned* bar = b.bar;
        __builtin_amdgcn_s_waitcnt(0);
        unsigned nloc = b.st[0], nx = b.st[1];
        if (nloc == 0u) { xcd_barrier_complete(bar, b.x, nloc, nx); b.st[0] = nloc; b.st[1] = nx; }
        const unsigned old = xb_add(&bar[XB_XSUB(b.x)], 1u);
        const unsigned gen = old / nloc;
        if (old + 1u == (gen + 1u) * nloc) {
            __builtin_amdgcn_fence(__ATOMIC_RELEASE, "agent");
            asm volatile("s_waitcnt vmcnt(0)" ::: "memory");
            const unsigned og = xb_add(&bar[XB_TOP], 1u);
            const unsigned tg = og / nx;
            if (og + 1u == (tg + 1u) * nx) xb_add(&bar[XB_TOPGEN], 1u);
            else XB_SPIN(xb_ld(&bar[XB_TOPGEN]) == tg, bar);
            __builtin_amdgcn_fence(__ATOMIC_ACQUIRE, "agent");
            xb_add(&bar[XB_XGEN(b.x)], 1u);
            asm volatile("s_waitcnt vmcnt(0)" ::: "memory");
        } else {
            XB_SPIN(xb_ld(&bar[XB_XGEN(b.x)]) == gen, bar);
            __builtin_amdgcn_fence(__ATOMIC_ACQUIRE, "agent");
            asm volatile("s_waitcnt vmcnt(0)" ::: "memory");
        }
    }
    __syncthreads();
}

template <class RM> __device__ __forceinline__ void cvt_item(const float* W, int ldw, bf16* WT, int ldt, LAS float* scr, int kb, int nb, int lane, const float* gain, const RM& rm) {
    const int k0 = 64 * kb, n0 = 32 * nb;
#pragma unroll 8
    for (int i = 0; i < 32; ++i) { const int kk = 2 * i + (lane >> 5); float v = W[(size_t)(k0 + kk) * ldw + n0 + (lane & 31)]; if (gain) v *= gain[k0 + kk]; scr[kk * 33 + (lane & 31)] = v; }
    LDS_WAIT(); asm volatile("" ::: "memory");
    const int c = lane & 7;
#pragma unroll
    for (int j = 0; j < 4; ++j) { const int n = (lane >> 3) + 8 * j; const LAS float* s = scr + (8 * c) * 33 + n;
        u32x4 o; o.x = pk2(s[0 * 33], s[1 * 33]); o.y = pk2(s[2 * 33], s[3 * 33]); o.z = pk2(s[4 * 33], s[5 * 33]); o.w = pk2(s[6 * 33], s[7 * 33]);
        *(u32x4*)(WT + (size_t)rm(n0 + n) * ldt + k0 + 8 * c) = o; }
    LDS_WAIT(); asm volatile("" ::: "memory");
}
struct RmId { int base; __device__ __forceinline__ int operator()(int n) const { return base + n; } };
struct RmWin { __device__ __forceinline__ int operator()(int n) const { return n < 768 ? n : (n < 832 ? 768 + 2 * ((n - 768) & 31) + ((n - 768) >> 5) : n + 192); } };
struct RmUq { __device__ __forceinline__ int operator()(int n) const { const int h = n / QHD, j = n % QHD; return j < 128 ? n : h * QHD + 128 + 2 * ((j - 128) & 31) + ((j - 128) >> 5); } };
struct RmW13 { int base; __device__ __forceinline__ int operator()(int f) const { return base + (f >> 7) * 256 + (f & 127); } };
__device__ __forceinline__ void ph_convert(const Args& a, LAS unsigned char* lds, int wg, int nwg) {
    const int tid = tid_opaque(), lane = tid & 63, w = __builtin_amdgcn_readfirstlane(tid >> 6), gw = wg * 8 + w, NGW = nwg * 8;
    LAS float* scr = (LAS float*)(lds + w * 8448);
    bf16* WIN = (bf16*)(a.ws + WS_WIN); bf16* WUQ = (bf16*)(a.ws + WS_WUQ); bf16* WUKV = (bf16*)(a.ws + WS_WUKV); bf16* WOUT = (bf16*)(a.ws + WS_WOUT);
    bf16* W13 = (bf16*)(a.ws + WS_W13); bf16* W2 = (bf16*)(a.ws + WS_W2);
    constexpr int I_W1 = NE * 512, I_W2 = NE * 512, I_WIN = 32 * 122, I_WOUT = 32 * 64, I_WUQ = 8 * 48, I_WUKV = 4 * 64;
    constexpr int NITEMS = 2 * I_W1 + I_W2 + I_WIN + I_WOUT + I_WUQ + I_WUKV;
    for (int it = gw; it < NITEMS; it += NGW) {
        int r = it;
        if (r < I_W1) { const int e = r >> 9, q = r & 511; cvt_item(a.w1 + (size_t)e * DM * FF, FF, W13, DM, scr, q >> 4, q & 15, lane, nullptr, RmW13{e * 1024}); continue; } r -= I_W1;
        if (r < I_W1) { const int e = r >> 9, q = r & 511; cvt_item(a.w3 + (size_t)e * DM * FF, FF, W13, DM, scr, q >> 4, q & 15, lane, nullptr, RmW13{e * 1024 + 128}); continue; } r -= I_W1;
        if (r < I_W2) { const int e = r >> 9, q = r & 511; cvt_item(a.w2 + (size_t)e * FF * DM, DM, W2, FF, scr, q >> 6, q & 63, lane, nullptr, RmId{e * DM}); continue; } r -= I_W2;
        if (r < I_WIN) { cvt_item(a.w_in, INCOLS, WIN, DM, scr, r / 122, r % 122, lane, nullptr, RmWin{}); continue; } r -= I_WIN;
        if (r < I_WOUT) { cvt_item(a.w_out, DM, WOUT, DM, scr, r >> 6, r & 63, lane, nullptr, RmId{0}); continue; } r -= I_WOUT;
        if (r < I_WUQ) { cvt_item(a.w_uq, 1536, WUQ, QR, scr, r / 48, r % 48, lane, a.qg, RmUq{}); continue; } r -= I_WUQ;
        cvt_item(a.w_ukv, 2048, WUKV, KVR, scr, r >> 6, r & 63, lane, a.kvg, RmId{0});
    }
    for (int i = wg * 512 + tid; i < 192 * DM / 8; i += nwg * 512) *(u32x4*)(WIN + (size_t)832 * DM + (size_t)i * 8) = (u32x4){0u, 0u, 0u, 0u};
}

struct MArgs { Args a; int ph_lo, ph_hi, li, pad; };
__global__ void __launch_bounds__(512, 2) mega(MArgs m) {
    extern __shared__ __attribute__((aligned(16))) unsigned char lds_[];
    LAS unsigned char* lds = (LAS unsigned char*)lds_;
    volatile LAS unsigned* MISC = (volatile LAS unsigned*)(lds + MISC_OFF);
    const Args& a = m.a;
    const int tid = threadIdx.x, wg = blockIdx.x, nwg = gridDim.x;
    unsigned* ctl = (unsigned*)(a.ws + WS_CTL);
    if (tid < 64) MISC[tid] = 0u;
    __syncthreads();
    XcdBarrier bar = xcd_barrier_post(ctl + CW_BAR + m.li * XCD_BAR_WORDS, MISC + 8);
    const int lo = m.ph_lo, hi = m.ph_hi;
#define IN(k) (lo <= (k) && (k) < hi)
#define SEAM(k) do { if (IN(k) && IN((k) + 1)) xcd_barrier(bar); } while (0)
    unsigned char* ws = a.ws;
    const float* RT = (const float*)(ws + WS_ROPE); float* SS = (float*)(ws + WS_SS); const int* LIST = (const int*)(ws + WS_LIST);
    const unsigned* CNT = (const unsigned*)(ws + WS_CTL) + CW_CNT;

    if (IN(0)) { ph_mod(a, (LAS float*)(lds + SCR_OFF - 24576), wg, nwg); __syncthreads(); ph_rope_table(a, wg, nwg); ph_convert(a, lds, wg, nwg); }
    SEAM(0);
    if (IN(1)) ph_ln0(a, wg, nwg);
    SEAM(1);
    if (IN(2)) {
        pg8::Gemm g{(const bf16*)(ws + WS_H), (const bf16*)(ws + WS_WIN), DM, DM, DM}; pg8::StaticOrder S; S.init(NT, PROJ_N, nwg, wg);
        pg8::EpiProj E{(bf16*)(ws + WS_PROJ), RT, SS};
        pg8::gemm_phase<pg8::EpiProj, pg8::StaticOrder, pg8::ADense, true>(lds + RING_OFF, g, S, pg8::ADense{DM}, E);
    }
    SEAM(2);
    if (IN(3)) {
        ph_kmean(a, wg, nwg);
        {
            pg8::Gemm g{(const bf16*)(ws + WS_PROJ), (const bf16*)(ws + WS_WUQ), QR, PROJ_N, QR}; pg8::StaticOrder S; S.init(NT, 1536, nwg, wg);
            pg8::EpiQ E{(bf16*)(ws + WS_QM), RT, SS};
            pg8::gemm_phase<pg8::EpiQ, pg8::StaticOrder, pg8::ADense, true>(lds + RING_OFF, g, S, pg8::ADense{PROJ_N}, E);
        }
        {
            pg8::Gemm g{(const bf16*)(ws + WS_PROJ) + QR, (const bf16*)(ws + WS_WUKV), KVR, PROJ_N, KVR}; pg8::StaticOrder S; S.init(NT, 2048, nwg, wg);
            pg8::EpiKV E{(bf16*)(ws + WS_KV), SS};
            pg8::gemm_phase<pg8::EpiKV, pg8::StaticOrder, pg8::ADense, true>(lds + RING_OFF, g, S, pg8::ADense{PROJ_N}, E);
        }
    }
    SEAM(3);
    if (IN(4)) att::attn_phase(a, lds);
    SEAM(4);
    if (IN(5)) {
        pg8::Gemm g{(const bf16*)(ws + WS_ATT), (const bf16*)(ws + WS_WOUT), DM, DM, DM}; pg8::StaticOrder S; S.init(NT, DM, nwg, wg);
        pg8::EpiOut E{a.x, (const float*)(ws + WS_MOD), (float*)(ws + WS_X1)};
        pg8::gemm_phase<pg8::EpiOut, pg8::StaticOrder, pg8::ADense, true>(lds + RING_OFF, g, S, pg8::ADense{DM}, E);
    }
    SEAM(5);
    if (IN(6)) ph_ln1_route(a, lds, wg, nwg);
    SEAM(6);
    if (IN(7)) {
        pg8::Gemm g{(const bf16*)(ws + WS_H), (const bf16*)(ws + WS_W13), DM, DM, DM}; pg8::MoeOrder S{CNT, 4, nwg, wg};
        pg8::EpiMoe1 E{(bf16*)(ws + WS_QM), LIST, (const float*)(ws + WS_ROUTE + 65536)};
        pg8::gemm_phase<pg8::EpiMoe1, pg8::MoeOrder, pg8::AGather, true>(lds + RING_OFF, g, S, pg8::AGather{LIST, DM}, E);
    }
    SEAM(7);
    if (IN(8)) {
        pg8::Gemm g{(const bf16*)(ws + WS_QM), (const bf16*)(ws + WS_W2), FF, FF, FF}; pg8::MoeOrder S{CNT, 8, nwg, wg};
        pg8::EpiMoe2 E{(bf16*)(ws + WS_PROJ), LIST};
        pg8::gemm_phase<pg8::EpiMoe2, pg8::MoeOrder, pg8::ADense, true>(lds + RING_OFF, g, S, pg8::ADense{FF}, E);
    }
    SEAM(8);
    if (IN(9)) ph_final(a, wg, nwg);
#undef IN
#undef SEAM
}

static const int USE_MEGA[10] = {1, 1, 1, 1, 1, 1, 1, 1, 1, 1};
extern "C" void kernel_launch(void* const* d_in, const int* in_sizes, int n_in, void* d_out, int out_size, void* d_ws, size_t ws_size, hipStream_t stream) {
    if (n_in != 22 || in_sizes[0] != NT * DM || out_size != NT * DM || ws_size < WS_END) { fprintf(stderr, "kernel_launch: unexpected shapes (n_in %d, in0 %d, out %d, ws %zu)\n", n_in, n_in > 0 ? in_sizes[0] : -1, out_size, ws_size); return; }
    Args a{};
    const float** ap = (const float**)&a;
    for (int i = 0; i < 22; ++i) ap[i] = (const float*)d_in[i];
    a.out = (float*)d_out; a.ws = (unsigned char*)d_ws;
    unsigned char* ws = a.ws;
    static int grid = 0;
    if (!grid) {
        (void)hipFuncSetAttribute((const void*)k_thin<6>, hipFuncAttributeMaxDynamicSharedMemorySize, P6_LDS);
        (void)hipFuncSetAttribute((const void*)mega, hipFuncAttributeMaxDynamicSharedMemorySize, LDS_BYTES);
        int dev = 0, cus = 0; (void)hipGetDevice(&dev); (void)hipDeviceGetAttribute(&cus, hipDeviceAttributeMultiprocessorCount, dev);
        grid = cus > 0 ? cus : 256;
    }
    (void)hipMemsetAsync(ws + WS_CTL, 0, CTL_ZERO_BYTES, stream);
    const unsigned* cnt = (const unsigned*)(ws + WS_CTL) + CW_CNT;
    int li = 0;
    for (int p = 0; p < 10;) {
        if (USE_MEGA[p]) { int q = p; while (q < 10 && USE_MEGA[q]) ++q;
            MArgs m{}; m.a = a; m.ph_lo = p; m.ph_hi = q; m.li = li++; m.pad = 0;
            hipLaunchKernelGGL(mega, dim3(grid), dim3(512), LDS_BYTES, stream, m);
            p = q; continue; }
        switch (p) {
        case 0: k_thin<0><<<256, 512, 32768, stream>>>(a); break;
        case 1: k_thin<1><<<256, 512, 0, stream>>>(a); break;
        case 2: nk_gemm<FProj><<<dim3(INCOLS / 64, NT / 64, 1), 256, 0, stream>>>(FProj{(const bf16*)(ws + WS_H), a.w_in, (float*)(ws + WS_W13)}, DM);
                nk_epi_proj<<<NT, 256, 0, stream>>>(a); break;
        case 3: nk_gemm<FQ><<<dim3(1536 / 64, NT / 64, 1), 256, 0, stream>>>(FQ{(const bf16*)(ws + WS_PROJ), a.w_uq, a.qg, (float*)(ws + WS_W13)}, QR);
                nk_epi_q<<<NT, 256, 0, stream>>>(a);
                nk_gemm<FKV><<<dim3(2048 / 64, NT / 64, 1), 256, 0, stream>>>(FKV{(const bf16*)(ws + WS_PROJ), a.w_ukv, a.kvg, (const float*)(ws + WS_SS), (bf16*)(ws + WS_KV)}, KVR);
                k_thin<3><<<256, 512, 0, stream>>>(a); break;
        case 4: nk_attn_mla<<<dim3(SEQ / 2, NH, NB), 128, 0, stream>>>(a);
                nk_attn_moba<<<dim3(SEQ / 4, NH, NB), 256, 0, stream>>>(a); break;
        case 5: nk_gemm<FOut><<<dim3(DM / 64, NT / 64, 1), 256, 0, stream>>>(FOut{(const bf16*)(ws + WS_ATT), a.w_out, a.x, (const float*)(ws + WS_MOD), (float*)(ws + WS_X1)}, DM); break;
        case 6: k_thin<6><<<256, 512, P6_LDS, stream>>>(a); break;
        case 7: nk_gemm<FMoe1><<<dim3(1024 / 64, NT / 64, NE), 256, 0, stream>>>(FMoe1{(const bf16*)(ws + WS_H), a.w1, a.w3, cnt, (const int*)(ws + WS_LIST), (float*)(ws + WS_W13)}, DM);
                nk_epi_moe1<<<dim3(NE, NT / 64), 256, 0, stream>>>(a); break;
        case 8: nk_gemm<FMoe2><<<dim3(DM / 64, NT / 64, NE), 256, 0, stream>>>(FMoe2{(const bf16*)(ws + WS_QM), a.w2, cnt, (const int*)(ws + WS_LIST), (bf16*)(ws + WS_PROJ)}, FF); break;
        case 9: k_thin<9><<<256, 512, 0, stream>>>(a); break;
        }
        ++p;
    }
}
```

```cpp
#include <hip/hip_runtime.h>
#include <cstdio>
#include <cstdint>

#define LAS __attribute__((address_space(3)))
typedef unsigned short bf16;
typedef float f32x4 __attribute__((ext_vector_type(4)));
typedef unsigned u32x4 __attribute__((ext_vector_type(4)));
typedef unsigned u32x2 __attribute__((ext_vector_type(2)));

constexpr int NB = 2, SEQ = 4096, DM = 2048, NT = NB * SEQ;
constexpr int QR = 512, KVR = 256, NH = 8, QHD = 192, MBLK = 256, NBLK = 16;
constexpr int INCOLS = 3904, PROJ_N = 4096, MODN = 6 * DM;
constexpr int NE = 32, FF = 512;
constexpr float LN_EPS = 1e-5f, RMS_EPS = 1e-6f;
constexpr float ALPHA = 1.189207115002721f;
constexpr int MOD_SH1 = 0, MOD_SC1 = DM, MOD_G1 = 2 * DM, MOD_SH2 = 3 * DM, MOD_SC2 = 4 * DM, MOD_G2 = 5 * DM;
constexpr int PC_KR = 768, PC_QMO = 1024, PC_KMO = 2048, PC_VMO = 3072;

constexpr size_t MiB = 1u << 20;
constexpr size_t WS_CTL = 0, CTL_ZERO_BYTES = 1 * MiB;
constexpr size_t WS_MOD = 1 * MiB;
constexpr size_t WS_ROPE = 2 * MiB;
constexpr size_t WS_KMEAN = 3 * MiB;
constexpr size_t WS_SS = 3 * MiB + 512 * 1024;
constexpr size_t WS_ROUTE = 4 * MiB;
constexpr size_t WS_LIST = 5 * MiB;
constexpr size_t WS_WIN = 8 * MiB;
constexpr size_t WS_WUQ = 24 * MiB;
constexpr size_t WS_WUKV = 26 * MiB;
constexpr size_t WS_WOUT = 28 * MiB;
constexpr size_t WS_WR = 36 * MiB;
constexpr size_t WS_W13 = 40 * MiB;
constexpr size_t WS_W2 = 168 * MiB;
constexpr size_t WS_H = 232 * MiB;
constexpr size_t WS_PROJ = 264 * MiB;
constexpr size_t WS_QM = 328 * MiB;
constexpr size_t WS_KV = 352 * MiB;
constexpr size_t WS_ATT = 384 * MiB;
constexpr size_t WS_X1 = 416 * MiB;
constexpr size_t WS_END = 480 * MiB;
constexpr int CW_CNT = 64;
constexpr int CW_QUEUE = 128;

__device__ __forceinline__ unsigned f2bf(float f) { unsigned u = __builtin_bit_cast(unsigned, f); return (u + 0x7fffu + ((u >> 16) & 1u)) >> 16; }
__device__ __forceinline__ float bf2f(unsigned b) { return __builtin_bit_cast(float, b << 16); }
__device__ __forceinline__ unsigned pk2(float lo, float hi) { return f2bf(lo) | (f2bf(hi) << 16); }
__device__ __forceinline__ float wave_sum(float v) {
#pragma unroll
    for (int o = 1; o < 64; o <<= 1) v += __shfl_xor(v, o);
    return v;
}
__device__ __forceinline__ float wave_max(float v) {
#pragma unroll
    for (int o = 1; o < 64; o <<= 1) v = fmaxf(v, __shfl_xor(v, o));
    return v;
}
__device__ __forceinline__ int tid_opaque() { int t = threadIdx.x; asm volatile("" : "+v"(t)); return t; }
__device__ __forceinline__ float silu_f(float v) { return v / (1.f + __expf(-v)); }
__device__ __forceinline__ int t5_bucket(int n) {
    if (n < 16) return n;
    int l = 16 + (int)(logf((float)n / 16.f) / 2.0794415416798357f * 16.f);
    return l < 31 ? l : 31;
}
__device__ __forceinline__ int moe_rowbase(const unsigned* cnt, int e) { int s = 0; for (int i = 0; i < e; ++i) s += (int)((cnt[i] + 255u) >> 8) << 8; return s; }

struct Args {
    const float *x, *c, *w_ada, *b_ada, *w_in, *qg, *w_uq, *kvg, *w_ukv, *w_out, *t5, *ln1g, *ln1b, *w_rg, *b_rg, *w_re, *b_re, *w1, *w3, *w2, *ln2g, *ln2b;
    float* out; unsigned char* ws;
};


__device__ __forceinline__ void ph_mod(const Args& a, LAS float* sm, int wg, int nwg) {
    const int tid = tid_opaque(), lane = tid & 63, w = __builtin_amdgcn_readfirstlane(tid >> 6);
    float* MOD = (float*)(a.ws + WS_MOD);
    LAS float* sc = sm;
    LAS float* red = sm + 2 * DM;
    if (wg >= 192) return;
    for (int i = tid; i < 2 * DM; i += 512) sc[i] = silu_f(a.c[i]);
    __syncthreads();
    for (int cg = wg; cg < 192; cg += nwg) {
        const int c4 = lane & 15, ksub = lane >> 4, col = cg * 64 + 4 * c4;
        f32x4 a0 = {0.f, 0.f, 0.f, 0.f}, a1 = {0.f, 0.f, 0.f, 0.f};
#pragma unroll 8
        for (int it = 0; it < 64; ++it) {
            const int k = w * 256 + it * 4 + ksub;
            const f32x4 wv = *(const f32x4*)(a.w_ada + (size_t)k * MODN + col);
            a0 += wv * sc[k]; a1 += wv * sc[DM + k];
        }
#pragma unroll
        for (int j = 0; j < 4; ++j) { a0[j] += __shfl_xor(a0[j], 16); a0[j] += __shfl_xor(a0[j], 32); a1[j] += __shfl_xor(a1[j], 16); a1[j] += __shfl_xor(a1[j], 32); }
        if (ksub == 0) {
#pragma unroll
            for (int j = 0; j < 4; ++j) { red[(w * 2 + 0) * 64 + 4 * c4 + j] = a0[j]; red[(w * 2 + 1) * 64 + 4 * c4 + j] = a1[j]; }
        }
        __syncthreads();
        if (tid < 128) { const int b = tid >> 6, cc = tid & 63; float s = 0.f;
#pragma unroll
            for (int ww = 0; ww < 8; ++ww) s += red[(ww * 2 + b) * 64 + cc];
            MOD[b * MODN + cg * 64 + cc] = s + a.b_ada[cg * 64 + cc]; }
        __syncthreads();
    }
}
__device__ __forceinline__ void ph_rope_table(const Args& a, int wg, int nwg) {
    float* RT = (float*)(a.ws + WS_ROPE);
    for (int idx = wg * 512 + tid_opaque(); idx < SEQ * 32; idx += nwg * 512) {
        const int pos = idx >> 5, i = idx & 31;
        const float inv = 1.0f / powf(10000.0f, (float)(2 * i) / 64.0f);
        const float ang = (float)pos * inv;
        const double ad = (double)ang, q = rint(ad * 0.6366197723675814), r = ad - q * 1.5707963267948966;
        const int qi = ((int)q) & 3; const float rf = (float)r, r2 = rf * rf;
        const float s = rf * (1.f + r2 * (-1.6666667e-1f + r2 * (8.3333333e-3f + r2 * (-1.9841270e-4f + r2 * 2.7557319e-6f))));
        const float c = 1.f + r2 * (-0.5f + r2 * (4.1666667e-2f + r2 * (-1.3888889e-3f + r2 * (2.4801587e-5f + r2 * (-2.7557319e-7f)))));
        float cs, sn;
        if (qi == 0) { cs = c; sn = s; } else if (qi == 1) { cs = -s; sn = c; } else if (qi == 2) { cs = -c; sn = -s; } else { cs = s; sn = -c; }
        RT[2 * idx] = cs; RT[2 * idx + 1] = sn;
    }
}
__device__ __forceinline__ void ph_ln0(const Args& a, int wg, int nwg) {
    const int tid = tid_opaque(), lane = tid & 63, gw = wg * 8 + __builtin_amdgcn_readfirstlane(tid >> 6), NGW = nwg * 8;
    const float* MOD = (const float*)(a.ws + WS_MOD); bf16* H = (bf16*)(a.ws + WS_H);
    for (int b = 0; b < NB; ++b) {
        f32x4 sc[8], sh[8];
#pragma unroll
        for (int j = 0; j < 8; ++j) { sc[j] = *(const f32x4*)(MOD + b * MODN + MOD_SC1 + 4 * lane + 256 * j) + 1.0f; sh[j] = *(const f32x4*)(MOD + b * MODN + MOD_SH1 + 4 * lane + 256 * j); }
        for (int r = gw; r < SEQ; r += NGW) {
            const size_t row = (size_t)b * SEQ + r;
            const float* xr = a.x + row * DM + 4 * lane;
            f32x4 v[8]; float s = 0.f;
#pragma unroll
            for (int j = 0; j < 8; ++j) { v[j] = *(const f32x4*)(xr + 256 * j); s += (v[j][0] + v[j][1]) + (v[j][2] + v[j][3]); }
            const float mean = wave_sum(s) * (1.f / DM); float s2 = 0.f;
#pragma unroll
            for (int j = 0; j < 8; ++j) { v[j] = v[j] - mean; s2 += (v[j][0] * v[j][0] + v[j][1] * v[j][1]) + (v[j][2] * v[j][2] + v[j][3] * v[j][3]); }
            const float rstd = 1.0f / sqrtf(wave_sum(s2) * (1.f / DM) + LN_EPS);
            bf16* hr = H + row * DM + 4 * lane;
#pragma unroll
            for (int j = 0; j < 8; ++j) { const f32x4 o = v[j] * rstd * sc[j] + sh[j]; u32x2 w; w.x = pk2(o[0], o[1]); w.y = pk2(o[2], o[3]); *(u32x2*)(hr + 256 * j) = w; }
        }
    }
}
__device__ __forceinline__ void ph_kmean(const Args& a, int wg, int nwg) {
    const int tid = tid_opaque(), lane = tid & 63, gw = wg * 8 + __builtin_amdgcn_readfirstlane(tid >> 6), NGW = nwg * 8;
    const bf16* PROJ = (const bf16*)(a.ws + WS_PROJ); float* KM = (float*)(a.ws + WS_KMEAN);
    for (int t = gw; t < 16 * NBLK; t += NGW) {
        const int bh = t >> 4, blk = t & 15, b = bh >> 3, h = bh & 7;
        const bf16* p = PROJ + ((size_t)b * SEQ + blk * MBLK) * PROJ_N + PC_KMO + h * 128 + 2 * lane;
        float s0 = 0.f, s1 = 0.f;
#pragma unroll 8
        for (int r = 0; r < MBLK; ++r) { const unsigned u = *(const unsigned*)(p + (size_t)r * PROJ_N); s0 += bf2f(u & 0xffffu); s1 += bf2f(u >> 16); }
        KM[(size_t)t * 128 + 2 * lane] = s0 * (1.f / MBLK); KM[(size_t)t * 128 + 2 * lane + 1] = s1 * (1.f / MBLK);
    }
}
constexpr int P6_ROWB = 4112, P6_ALO = 16 * P6_ROWB, P6_RS = 132096, P6_LDS = 133120;
typedef short p6_bf16x8 __attribute__((ext_vector_type(8)));
__device__ __forceinline__ void ph_ln1_route(const Args& a, LAS unsigned char* lds, int wg, int nwg) {
    const int tid = tid_opaque(), lane = tid & 63, w = __builtin_amdgcn_readfirstlane(tid >> 6);
    const float* MOD = (const float*)(a.ws + WS_MOD); bf16* H = (bf16*)(a.ws + WS_H); float* X1 = (float*)(a.ws + WS_X1);
    int* EID = (int*)(a.ws + WS_ROUTE); float* WGT = (float*)(a.ws + WS_ROUTE + 65536); int* LIST = (int*)(a.ws + WS_LIST);
    unsigned* CNT = (unsigned*)(a.ws + WS_CTL) + CW_CNT;
    const bf16* WRH = (const bf16*)(a.ws + WS_WR); const bf16* WRL = WRH + 48 * DM;
    LAS float* PART = (LAS float*)lds; LAS float* LG = (LAS float*)(lds + 24576);
    LAS unsigned* lcnt = (LAS unsigned*)(lds + P6_RS); LAS unsigned* lbase = lcnt + 32; LAS int* sl_e = (LAS int*)(lcnt + 64); LAS int* sl_pos = sl_e + 32;
    if (tid < 32) lcnt[tid] = 0u;
    for (int r0 = wg * 16; r0 < NT; r0 += nwg * 16) {
        const int b = r0 / SEQ;
        for (int rr = 0; rr < 2; ++rr) {
            const int row = r0 + 2 * w + rr;
            float* xr = X1 + (size_t)row * DM + 4 * lane;
            f32x4 v[8]; float s = 0.f;
#pragma unroll
            for (int j = 0; j < 8; ++j) { v[j] = *(const f32x4*)(xr + 256 * j); s += (v[j][0] + v[j][1]) + (v[j][2] + v[j][3]); }
            float mean = wave_sum(s) * (1.f / DM), s2 = 0.f;
#pragma unroll
            for (int j = 0; j < 8; ++j) { v[j] = v[j] - mean; s2 += (v[j][0] * v[j][0] + v[j][1] * v[j][1]) + (v[j][2] * v[j][2] + v[j][3] * v[j][3]); }
            float rstd = 1.0f / sqrtf(wave_sum(s2) * (1.f / DM) + LN_EPS);
            s = 0.f;
#pragma unroll
            for (int j = 0; j < 8; ++j) { const f32x4 g = *(const f32x4*)(a.ln1g + 4 * lane + 256 * j), bb = *(const f32x4*)(a.ln1b + 4 * lane + 256 * j);
                v[j] = v[j] * rstd * g + bb; *(f32x4*)(xr + 256 * j) = v[j]; s += (v[j][0] + v[j][1]) + (v[j][2] + v[j][3]); }
            mean = wave_sum(s) * (1.f / DM); s2 = 0.f;
#pragma unroll
            for (int j = 0; j < 8; ++j) { v[j] = v[j] - mean; s2 += (v[j][0] * v[j][0] + v[j][1] * v[j][1]) + (v[j][2] * v[j][2] + v[j][3] * v[j][3]); }
            rstd = 1.0f / sqrtf(wave_sum(s2) * (1.f / DM) + LN_EPS);
            bf16* hr = H + (size_t)row * DM + 4 * lane; LAS unsigned char* hl = lds + (2 * w + rr) * P6_ROWB + 8 * lane;
#pragma unroll
            for (int j = 0; j < 8; ++j) { const f32x4 sc = *(const f32x4*)(MOD + b * MODN + MOD_SC2 + 4 * lane + 256 * j) + 1.0f, sh = *(const f32x4*)(MOD + b * MODN + MOD_SH2 + 4 * lane + 256 * j);
                const f32x4 o = v[j] * rstd * sc + sh;
                unsigned hb[4], lb[4];
#pragma unroll
                for (int i = 0; i < 4; ++i) { hb[i] = f2bf(o[i]); lb[i] = f2bf(o[i] - bf2f(hb[i])); }
                u32x2 wh, wl; wh.x = hb[0] | (hb[1] << 16); wh.y = hb[2] | (hb[3] << 16); wl.x = lb[0] | (lb[1] << 16); wl.y = lb[2] | (lb[3] << 16);
                *(u32x2*)(hr + 256 * j) = wh; *(LAS u32x2*)(hl + 512 * j) = wh; *(LAS u32x2*)(hl + P6_ALO + 512 * j) = wl; }
        }
        __syncthreads();
        {
            const int row16 = lane & 15, quad = lane >> 4;
            f32x4 acc[3];
#pragma unroll
            for (int t = 0; t < 3; ++t) acc[t] = (f32x4){0.f, 0.f, 0.f, 0.f};
#pragma unroll 2
            for (int ks = 0; ks < 8; ++ks) { const int k0 = w * 256 + ks * 32 + quad * 8;
                const p6_bf16x8 ah = *(LAS const p6_bf16x8*)(lds + row16 * P6_ROWB + k0 * 2), al = *(LAS const p6_bf16x8*)(lds + P6_ALO + row16 * P6_ROWB + k0 * 2);
#pragma unroll
                for (int t = 0; t < 3; ++t) { const p6_bf16x8 bh = *(const p6_bf16x8*)(WRH + (size_t)(16 * t + row16) * DM + k0), bl = *(const p6_bf16x8*)(WRL + (size_t)(16 * t + row16) * DM + k0);
                    acc[t] = __builtin_amdgcn_mfma_f32_16x16x32_bf16(ah, bh, acc[t], 0, 0, 0);
                    acc[t] = __builtin_amdgcn_mfma_f32_16x16x32_bf16(ah, bl, acc[t], 0, 0, 0);
                    acc[t] = __builtin_amdgcn_mfma_f32_16x16x32_bf16(al, bh, acc[t], 0, 0, 0); } }
            __syncthreads();
#pragma unroll
            for (int t = 0; t < 3; ++t)
#pragma unroll
                for (int j = 0; j < 4; ++j) PART[(w * 16 + quad * 4 + j) * 48 + 16 * t + row16] = acc[t][j];
        }
        __syncthreads();
        for (int idx = tid; idx < 16 * 36; idx += 512) { const int r = idx / 36, n = idx % 36; float sum = 0.f;
#pragma unroll
            for (int ww = 0; ww < 8; ++ww) sum += PART[(ww * 16 + r) * 48 + n];
            LG[idx] = sum; }
        __syncthreads();
        if (tid < 16) {
            const int t = r0 + tid; const LAS float* lg = LG + tid * 36;
            float g[4]; int gi = 0;
#pragma unroll
            for (int i = 0; i < 4; ++i) g[i] = lg[32 + i] + a.b_rg[i];
            float gm = g[0];
#pragma unroll
            for (int i = 1; i < 4; ++i) if (g[i] > gm) { gm = g[i]; gi = i; }
            float gs = 0.f;
#pragma unroll
            for (int i = 0; i < 4; ++i) gs += expf(g[i] - gm);
            const float gp = 1.0f / gs;
            float el[8];
#pragma unroll
            for (int i = 0; i < 8; ++i) el[i] = lg[gi * 8 + i] + a.b_re[gi * 8 + i];
            int i1 = 0; float m1 = el[0];
#pragma unroll
            for (int i = 1; i < 8; ++i) if (el[i] > m1) { m1 = el[i]; i1 = i; }
            int i2 = -1; float m2 = -INFINITY;
#pragma unroll
            for (int i = 0; i < 8; ++i) if (i != i1 && el[i] > m2) { m2 = el[i]; i2 = i; }
            const float p2 = expf(m2 - m1), inv = 1.0f / (1.0f + p2);
            const int e1 = gi * 8 + i1, e2 = gi * 8 + i2;
            EID[2 * t] = e1; EID[2 * t + 1] = e2; WGT[2 * t] = gp * inv; WGT[2 * t + 1] = gp * p2 * inv;
            sl_e[2 * tid] = e1; sl_pos[2 * tid] = (int)__hip_atomic_fetch_add(&lcnt[e1], 1u, __ATOMIC_RELAXED, __HIP_MEMORY_SCOPE_WORKGROUP);
            sl_e[2 * tid + 1] = e2; sl_pos[2 * tid + 1] = (int)__hip_atomic_fetch_add(&lcnt[e2], 1u, __ATOMIC_RELAXED, __HIP_MEMORY_SCOPE_WORKGROUP);
        }
        __syncthreads();
        if (tid < 32) { const unsigned n = lcnt[tid]; lbase[tid] = n ? atomicAdd(CNT + tid, n) : 0u; lcnt[tid] = 0u; }
        __syncthreads();
        if (tid < 32) { const int e = sl_e[tid]; LIST[e * NT + (int)lbase[e] + sl_pos[tid]] = 2 * (r0 + (tid >> 1)) + (tid & 1); }
        __syncthreads();
    }
}
__device__ __forceinline__ void ph_final(const Args& a, int wg, int nwg) {
    const int tid = tid_opaque(), lane = tid & 63, gw = wg * 8 + __builtin_amdgcn_readfirstlane(tid >> 6), NGW = nwg * 8;
    const float* MOD = (const float*)(a.ws + WS_MOD); const float* X1 = (const float*)(a.ws + WS_X1); const bf16* YS = (const bf16*)(a.ws + WS_PROJ);
    for (int row = gw; row < NT; row += NGW) {
        const int b = row / SEQ;
        const float* xr = X1 + (size_t)row * DM + 4 * lane; const bf16* y0 = YS + (size_t)(2 * row) * DM + 4 * lane; const bf16* y1 = y0 + DM;
        f32x4 v[8]; float s = 0.f;
#pragma unroll
        for (int j = 0; j < 8; ++j) { const f32x4 g2 = *(const f32x4*)(MOD + b * MODN + MOD_G2 + 4 * lane + 256 * j); const u32x2 u0 = *(const u32x2*)(y0 + 256 * j), u1 = *(const u32x2*)(y1 + 256 * j);
            f32x4 y; y[0] = bf2f(u0.x & 0xffffu) + bf2f(u1.x & 0xffffu); y[1] = bf2f(u0.x >> 16) + bf2f(u1.x >> 16); y[2] = bf2f(u0.y & 0xffffu) + bf2f(u1.y & 0xffffu); y[3] = bf2f(u0.y >> 16) + bf2f(u1.y >> 16);
            v[j] = *(const f32x4*)(xr + 256 * j) * ALPHA + g2 * y; s += (v[j][0] + v[j][1]) + (v[j][2] + v[j][3]); }
        const float mean = wave_sum(s) * (1.f / DM); float s2 = 0.f;
#pragma unroll
        for (int j = 0; j < 8; ++j) { v[j] = v[j] - mean; s2 += (v[j][0] * v[j][0] + v[j][1] * v[j][1]) + (v[j][2] * v[j][2] + v[j][3] * v[j][3]); }
        const float rstd = 1.0f / sqrtf(wave_sum(s2) * (1.f / DM) + LN_EPS);
        float* o = a.out + (size_t)row * DM + 4 * lane;
#pragma unroll
        for (int j = 0; j < 8; ++j) { const f32x4 g = *(const f32x4*)(a.ln2g + 4 * lane + 256 * j), bb = *(const f32x4*)(a.ln2b + 4 * lane + 256 * j); *(f32x4*)(o + 256 * j) = v[j] * rstd * g + bb; }
    }
}

template <int PH> __global__ void __launch_bounds__(512, 2) k_thin(Args a) {
    extern __shared__ __attribute__((aligned(16))) unsigned char lds[];
    const int wg = blockIdx.x, nwg = gridDim.x;
    if (PH == 0) { ph_mod(a, (LAS float*)lds, wg, nwg); ph_rope_table(a, wg, nwg); }
    if (PH == 1) ph_ln0(a, wg, nwg);
    if (PH == 3) ph_kmean(a, wg, nwg);
    if (PH == 6) ph_ln1_route(a, (LAS unsigned char*)lds, wg, nwg);
    if (PH == 9) ph_final(a, wg, nwg);
}

template <class F> __global__ void __launch_bounds__(256) nk_gemm(F f, int K) {
    __shared__ float As[16][68]; __shared__ float Bs[16][68];
    const int tid = threadIdx.x, tx = tid & 15, ty = tid >> 4, z = blockIdx.z, m0 = blockIdx.y * 64, n0 = blockIdx.x * 64;
    if (!f.active(z, m0)) return;
    float acc[4][4] = {};
    const int ar = tid >> 2, ak = (tid & 3) * 4; const bf16* arow = f.arow(z, m0 + ar);
    const int bk = tid >> 4, bn = (tid & 15) * 4;
    for (int k0 = 0; k0 < K; k0 += 16) {
        float a4[4] = {0.f, 0.f, 0.f, 0.f};
        if (arow) { const u32x2 u = *(const u32x2*)(arow + k0 + ak); a4[0] = bf2f(u.x & 0xffffu); a4[1] = bf2f(u.x >> 16); a4[2] = bf2f(u.y & 0xffffu); a4[3] = bf2f(u.y >> 16); }
#pragma unroll
        for (int i = 0; i < 4; ++i) As[ak + i][ar] = a4[i];
#pragma unroll
        for (int i = 0; i < 4; ++i) Bs[bk][bn + i] = f.b(z, k0 + bk, n0 + bn + i);
        __syncthreads();
#pragma unroll
        for (int kk = 0; kk < 16; ++kk) { float av[4], bv[4];
#pragma unroll
            for (int i = 0; i < 4; ++i) { av[i] = As[kk][ty * 4 + i]; bv[i] = Bs[kk][tx * 4 + i]; }
#pragma unroll
            for (int i = 0; i < 4; ++i)
#pragma unroll
                for (int j = 0; j < 4; ++j) acc[i][j] += av[i] * bv[j]; }
        __syncthreads();
    }
#pragma unroll
    for (int i = 0; i < 4; ++i)
#pragma unroll
        for (int j = 0; j < 4; ++j) f.store(z, m0 + ty * 4 + i, n0 + tx * 4 + j, acc[i][j]);
}
struct FProj { const bf16* A; const float* W; float* C;
    __device__ bool active(int, int) const { return true; }
    __device__ const bf16* arow(int, int m) const { return A + (size_t)m * DM; }
    __device__ float b(int, int k, int n) const { return W[(size_t)k * INCOLS + n]; }
    __device__ void store(int, int m, int n, float v) const { C[(size_t)m * INCOLS + n] = v; } };
struct FQ { const bf16* PROJ; const float* W; const float* g; float* C;
    __device__ bool active(int, int) const { return true; }
    __device__ const bf16* arow(int, int m) const { return PROJ + (size_t)m * PROJ_N; }
    __device__ float b(int, int k, int n) const { return g[k] * W[(size_t)k * 1536 + n]; }
    __device__ void store(int, int m, int n, float v) const { C[(size_t)m * 1536 + n] = v; } };
struct FKV { const bf16* PROJ; const float* W; const float* g; const float* SS; bf16* KV;
    __device__ bool active(int, int) const { return true; }
    __device__ const bf16* arow(int, int m) const { return PROJ + (size_t)m * PROJ_N + QR; }
    __device__ float b(int, int k, int n) const { return g[k] * W[(size_t)k * 2048 + n]; }
    __device__ void store(int, int m, int n, float v) const { const float* s = SS + (size_t)m * 12 + 8; const float rs = 1.0f / sqrtf(((s[0] + s[1]) + (s[2] + s[3])) * (1.f / KVR) + RMS_EPS); KV[(size_t)m * 2048 + n] = (bf16)f2bf(v * rs); } };
struct FOut { const bf16* ATT; const float* W; const float* x; const float* MOD; float* X1;
    __device__ bool active(int, int) const { return true; }
    __device__ const bf16* arow(int, int m) const { return ATT + (size_t)m * DM; }
    __device__ float b(int, int k, int n) const { return W[(size_t)k * DM + n]; }
    __device__ void store(int, int m, int n, float v) const { const int b_ = m / SEQ; X1[(size_t)m * DM + n] = ALPHA * x[(size_t)m * DM + n] + MOD[b_ * MODN + MOD_G1 + n] * v; } };
struct FMoe1 { const bf16* H; const float* w1; const float* w3; const unsigned* cnt; const int* LIST; float* C;
    __device__ bool active(int e, int m0) const { return m0 < (int)cnt[e]; }
    __device__ const bf16* arow(int e, int m) const { return m < (int)cnt[e] ? H + (size_t)(LIST[e * NT + m] >> 1) * DM : nullptr; }
    __device__ float b(int e, int k, int n) const { return n < FF ? w1[((size_t)e * DM + k) * FF + n] : w3[((size_t)e * DM + k) * FF + n - FF]; }
    __device__ void store(int e, int m, int n, float v) const { if (m < (int)cnt[e]) C[(size_t)(moe_rowbase(cnt, e) + m) * 1024 + n] = v; } };
struct FMoe2 { const bf16* HID; const float* w2; const unsigned* cnt; const int* LIST; bf16* YS;
    __device__ bool active(int e, int m0) const { return m0 < (int)cnt[e]; }
    __device__ const bf16* arow(int e, int m) const { return m < (int)cnt[e] ? HID + (size_t)(moe_rowbase(cnt, e) + m) * FF : nullptr; }
    __device__ float b(int e, int k, int n) const { return w2[((size_t)e * FF + k) * DM + n]; }
    __device__ void store(int e, int m, int n, float v) const { if (m < (int)cnt[e]) YS[(size_t)LIST[e * NT + m] * DM + n] = (bf16)f2bf(v); } };

__global__ void __launch_bounds__(256) nk_epi_proj(Args a) {
    const int row = blockIdx.x, tid = threadIdx.x, pos = row % SEQ;
    const float* T = (const float*)(a.ws + WS_W13) + (size_t)row * INCOLS; bf16* P = (bf16*)(a.ws + WS_PROJ) + (size_t)row * PROJ_N;
    const float* RT = (const float*)(a.ws + WS_ROPE); float* SS = (float*)(a.ws + WS_SS) + (size_t)row * 12;
    __shared__ float red[2][256];
    float sq = 0.f, skv = 0.f;
    for (int n = tid; n < PROJ_N; n += 256) {
        float v;
        if (n < PC_KR) { v = T[n]; if (n < QR) sq += v * v; else skv += v * v; }
        else if (n < PC_KR + 64) { const int jj = n - PC_KR, i = jj >> 1, s = jj & 1; const float x1 = T[768 + i], x2 = T[768 + 32 + i], cs = RT[2 * (pos * 32 + i)], sn = RT[2 * (pos * 32 + i) + 1]; v = s == 0 ? x1 * cs - x2 * sn : x1 * sn + x2 * cs; }
        else if (n < PC_QMO) v = 0.f;
        else v = T[n - 192];
        P[n] = (bf16)f2bf(v);
    }
    red[0][tid] = sq; red[1][tid] = skv; __syncthreads();
    for (int o = 128; o > 0; o >>= 1) { if (tid < o) { red[0][tid] += red[0][tid + o]; red[1][tid] += red[1][tid + o]; } __syncthreads(); }
    if (tid < 12) SS[tid] = tid == 0 ? red[0][0] : (tid == 8 ? red[1][0] : 0.f);
}
__global__ void __launch_bounds__(256) nk_epi_q(Args a) {
    const int row = blockIdx.x, tid = threadIdx.x, pos = row % SEQ;
    const float* T = (const float*)(a.ws + WS_W13) + (size_t)row * 1536; bf16* Q = (bf16*)(a.ws + WS_QM) + (size_t)row * 1536;
    const float* RT = (const float*)(a.ws + WS_ROPE); const float* s = (const float*)(a.ws + WS_SS) + (size_t)row * 12;
    const float rs = 1.0f / sqrtf((((s[0] + s[1]) + (s[2] + s[3])) + ((s[4] + s[5]) + (s[6] + s[7]))) * (1.f / QR) + RMS_EPS);
    for (int n = tid; n < 1536; n += 256) {
        const int h = n / QHD, j = n % QHD; float v;
        if (j < 128) v = T[n] * rs;
        else { const int jj = j - 128, i = jj >> 1, sx = jj & 1; const float x1 = T[h * QHD + 128 + i] * rs, x2 = T[h * QHD + 160 + i] * rs, cs = RT[2 * (pos * 32 + i)], sn = RT[2 * (pos * 32 + i) + 1]; v = sx == 0 ? x1 * cs - x2 * sn : x1 * sn + x2 * cs; }
        Q[n] = (bf16)f2bf(v);
    }
}
__global__ void __launch_bounds__(256) nk_epi_moe1(Args a) {
    const unsigned* cnt = (const unsigned*)(a.ws + WS_CTL) + CW_CNT; const int e = blockIdx.x, m0 = blockIdx.y * 64;
    if (m0 >= (int)cnt[e]) return;
    const int* LIST = (const int*)(a.ws + WS_LIST); const float* WGT = (const float*)(a.ws + WS_ROUTE + 65536);
    const float* T = (const float*)(a.ws + WS_W13); bf16* HID = (bf16*)(a.ws + WS_QM); const int rb = moe_rowbase(cnt, e);
    for (int m = m0; m < m0 + 64 && m < (int)cnt[e]; ++m) { const float w = WGT[LIST[e * NT + m]]; const size_t R = (size_t)(rb + m);
        for (int f = threadIdx.x; f < FF; f += 256) { const float a1 = T[R * 1024 + f], a3 = T[R * 1024 + FF + f]; HID[R * FF + f] = (bf16)f2bf(silu_f(a1) * a3 * w); } }
}
__global__ void __launch_bounds__(128) nk_attn_mla(Args a) {
    __shared__ float sc[2][SEQ]; __shared__ float qv[2][QHD];
    const int lane = threadIdx.x & 63, w = threadIdx.x >> 6, b = blockIdx.z, h = blockIdx.y, q = blockIdx.x * 2 + w;
    const bf16* QM = (const bf16*)(a.ws + WS_QM); const bf16* KV = (const bf16*)(a.ws + WS_KV); const bf16* PROJ = (const bf16*)(a.ws + WS_PROJ); bf16* ATT = (bf16*)(a.ws + WS_ATT);
    const size_t row = (size_t)b * SEQ + q; const float scale = 0.07216878364870322f;
    for (int d = lane; d < QHD; d += 64) qv[w][d] = bf2f(QM[row * 1536 + h * QHD + d]);
    __syncthreads();
    float mx = -INFINITY;
    for (int k = lane; k <= q; k += 64) { const size_t kr = (size_t)b * SEQ + k; const bf16* kn = KV + kr * 2048 + h * 256; const bf16* kp = PROJ + kr * PROJ_N + PC_KR; float dsum = 0.f;
        for (int d = 0; d < 128; ++d) dsum += qv[w][d] * bf2f(kn[d]);
        for (int d = 0; d < 64; ++d) dsum += qv[w][128 + d] * bf2f(kp[d]);
        dsum *= scale; sc[w][k] = dsum; mx = fmaxf(mx, dsum); }
    mx = wave_max(mx); float sum = 0.f;
    for (int k = lane; k <= q; k += 64) { const float p = expf(sc[w][k] - mx); sc[w][k] = p; sum += p; }
    sum = wave_sum(sum);
    __syncthreads();
    float o0 = 0.f, o1 = 0.f;
    for (int k = 0; k <= q; ++k) { const unsigned u = *(const unsigned*)(KV + ((size_t)b * SEQ + k) * 2048 + h * 256 + 128 + 2 * lane); const float p = sc[w][k]; o0 += p * bf2f(u & 0xffffu); o1 += p * bf2f(u >> 16); }
    const float inv = 1.0f / sum;
    *(unsigned*)(ATT + row * DM + h * 128 + 2 * lane) = pk2(o0 * inv, o1 * inv);
}
__global__ void __launch_bounds__(256) nk_attn_moba(Args a) {
    __shared__ float sc[4][1024]; __shared__ float qv[4][128]; __shared__ int selb[4][4];
    const int lane = threadIdx.x & 63, w = threadIdx.x >> 6, b = blockIdx.z, h = blockIdx.y, q = blockIdx.x * 4 + w, qblk = q / MBLK;
    const bf16* PROJ = (const bf16*)(a.ws + WS_PROJ); bf16* ATT = (bf16*)(a.ws + WS_ATT); const float* KM = (const float*)(a.ws + WS_KMEAN) + (size_t)(b * NH + h) * NBLK * 128;
    const size_t row = (size_t)b * SEQ + q; const float scale = 0.08838834764831845f;
    for (int d = lane; d < 128; d += 64) qv[w][d] = bf2f(PROJ[row * PROJ_N + PC_QMO + h * 128 + d]);
    __syncthreads();
    float gate = -INFINITY;
    if (lane < qblk) { float s = 0.f; for (int d = 0; d < 128; ++d) s += qv[w][d] * KM[lane * 128 + d]; gate = s; }
    const int nsel = qblk < 3 ? qblk : 3;
    for (int s = 0; s < nsel; ++s) {
        float bv = gate; int bi = lane;
#pragma unroll
        for (int o = 1; o < 64; o <<= 1) { const float ov = __shfl_xor(bv, o); const int oi = __shfl_xor(bi, o); if (ov > bv || (ov == bv && oi < bi)) { bv = ov; bi = oi; } }
        if (lane == 0) selb[w][s] = bi;
        if (lane == bi) gate = -INFINITY;
    }
    if (lane == 0) selb[w][nsel] = qblk;
    __syncthreads();
    float mx = -INFINITY;
    for (int s = 0; s <= nsel; ++s) { const int blk = selb[w][s];
        for (int kk = lane; kk < MBLK; kk += 64) { const int key = blk * MBLK + kk; float v = -INFINITY;
            if (key <= q) { const bf16* kp = PROJ + ((size_t)b * SEQ + key) * PROJ_N + PC_KMO + h * 128; float dsum = 0.f;
                for (int d = 0; d < 128; ++d) dsum += qv[w][d] * bf2f(kp[d]);
                v = dsum * scale + a.t5[t5_bucket(q - key) * NH + h]; }
            sc[w][s * MBLK + kk] = v; mx = fmaxf(mx, v); } }
    mx = wave_max(mx); float sum = 0.f;
    for (int i = lane; i < (nsel + 1) * MBLK; i += 64) { const float p = expf(sc[w][i] - mx); sc[w][i] = p; sum += p; }
    sum = wave_sum(sum);
    __syncthreads();
    float o0 = 0.f, o1 = 0.f;
    for (int s = 0; s <= nsel; ++s) { const int blk = selb[w][s];
        for (int kk = 0; kk < MBLK; ++kk) { const int key = blk * MBLK + kk; if (key > q) break;
            const unsigned u = *(const unsigned*)(PROJ + ((size_t)b * SEQ + key) * PROJ_N + PC_VMO + h * 128 + 2 * lane); const float p = sc[w][s * MBLK + kk]; o0 += p * bf2f(u & 0xffffu); o1 += p * bf2f(u >> 16); } }
    const float inv = 1.0f / sum;
    *(unsigned*)(ATT + row * DM + 1024 + h * 128 + 2 * lane) = pk2(o0 * inv, o1 * inv);
}

namespace pg8 {
typedef unsigned short bf16_t;
typedef short bf16x8 __attribute__((ext_vector_type(8)));
constexpr int BM = 256, BK = 64, HALF = 128, HTB = HALF * BK * 2, STAGE_BYTES = 8 * HTB, NXCD = 8, WGM = 8;
__host__ __device__ __forceinline__ int lds_byte(int r, int c) { const int st = (r >> 4) * 2 + (c >> 5), rr = r & 15, cc = c & 31, ob = rr * 64 + cc * 2; return st * 1024 + (ob ^ (((ob >> 9) & 1) << 5)); }
__host__ __device__ __forceinline__ void stage_rc(int b, int& R, int& C) { const int st = b / 1024, sb = b % 1024, swz = sb ^ (((sb >> 9) & 1) << 5); R = (st >> 1) * 16 + swz / 64; C = (st & 1) * 32 + (swz % 64) / 2; }
__host__ __device__ __forceinline__ int perm32(int rho) { const int n = rho >> 4, i = rho & 15; return 8 * (i >> 2) + 4 * n + (i & 3); }

struct Unit { int pm, pn, e, mt, cnt; };
struct Gemm { const bf16_t* A; const bf16_t* Bt; int K, lda, ldb; };

struct StaticOrder {
    int nM, nN, nwg, G, c;
    __device__ void init(int M, int N, int G_, int c_) { nM = M / BM; nN = N / BM; nwg = nM * nN; G = G_; c = c_; }
    __device__ bool next(int i, Unit& u) const {
        const long L = (long)i * G + c; if (L >= nwg) return false;
        int wgid = (int)L; { const int q = nwg / NXCD, r = nwg % NXCD, xcd = wgid % NXCD, off = wgid / NXCD; wgid = (xcd < r ? xcd * (q + 1) : r * (q + 1) + (xcd - r) * q) + off; }
        const int nig = WGM * nN, gid = wgid / nig, fm = gid * WGM, gsz = (nM - fm) < WGM ? (nM - fm) : WGM;
        u.pm = fm + ((wgid % nig) % gsz); u.pn = (wgid % nig) / gsz; u.e = 0; u.mt = 0; u.cnt = 0; return true;
    }
};
struct MoeOrder {
    const unsigned* cnt; int NPN, G, c;
    __device__ bool next(int i, Unit& u) const {
        int nmt = 0;
        for (int e = 0; e < NE; ++e) nmt += (int)((cnt[e] + 255u) >> 8);
        const int x = c & 7, nl = G >> 3, lw = c >> 3;
        const int g0 = (nmt * x) >> 3, g1 = (nmt * (x + 1)) >> 3;
        const int L = i * nl + lw, gl = L / NPN;
        if (lw >= nl || g0 + gl >= g1) return false;
        int g = g0 + gl, rb = 0;
        for (int e = 0; e < NE; ++e) { const int ce = (int)cnt[e], nm = (ce + 255) >> 8;
            if (g < nm) { u.e = e; u.mt = g; u.pn = e * NPN + L % NPN; u.pm = rb + g; u.cnt = ce; return true; }
            g -= nm; rb += nm; }
        return false;
    }
};
struct ADense { int lda;
    __device__ __forceinline__ void get(const Unit& u, unsigned (&off)[2][2]) const {
        const int tid = tid_opaque();
#pragma unroll
        for (int i = 0; i < 2; ++i) { int R, C; stage_rc(tid * 16 + i * 8192, R, C);
#pragma unroll
            for (int h = 0; h < 2; ++h) off[h][i] = (unsigned)((u.pm * BM + h * HALF + R) * lda + C) * 2u; } } };
struct AGather { const int* LIST; int lda;
    __device__ __forceinline__ void get(const Unit& u, unsigned (&off)[2][2]) const {
        const int tid = tid_opaque();
#pragma unroll
        for (int i = 0; i < 2; ++i) { int R, C; stage_rc(tid * 16 + i * 8192, R, C);
#pragma unroll
            for (int h = 0; h < 2; ++h) { const int idx = u.mt * BM + h * HALF + R; const int tok = idx < u.cnt ? (LIST[u.e * NT + idx] >> 1) : 0; off[h][i] = (unsigned)(tok * lda + C) * 2u; } } } };

template <class Epi, class Sched, class AOff, bool ALIGN_EPI>
__device__ __forceinline__ void gemm_phase(LAS unsigned char* lds, const Gemm g, const Sched& S, const AOff& AO, const Epi& E) {
    const int tid = tid_opaque(), wid = __builtin_amdgcn_readfirstlane(tid >> 6), lane = tid & 63, wr = wid >> 2, wc = wid & 3, fr = lane & 15, fq = lane >> 4;
    const int K = g.K, nt = K / BK;
    unsigned voffB[2];
#pragma unroll
    for (int i = 0; i < 2; ++i) { int R, C; stage_rc(tid * 16 + i * 8192, R, C); const int Rb = Epi::PERM ? ((R & ~31) + perm32(R & 31)) : R;
        voffB[i] = (unsigned)(Rb * g.ldb + C) * 2u; }
    const size_t kstep = (size_t)(BK * 2);
    const size_t hstepB = (size_t)HALF * g.ldb * 2, tstepB = 2 * hstepB;
    const unsigned ldsw = (unsigned)wid * 1024u;
    const int aoff = lds_byte(wr * 64 + fr, fq * 8), boff = lds_byte(wc * 32 + fr, fq * 8);
#define PG8_SA(b, h) (((b) * 2 + (h)) * HTB)
#define PG8_SB(b, h) ((4 + (b) * 2 + (h)) * HTB)
#define PG8_STAGE(bufoff, gbase, voff) do { _Pragma("unroll") for (int _i = 0; _i < 2; ++_i) \
        __builtin_amdgcn_global_load_lds((const unsigned*)((const char*)(gbase) + (voff)[_i]), (LAS unsigned*)(lds + (bufoff) + ldsw + _i * 8192), 16, 0, 0); } while (0)
#define PG8_LDA(dst, b, h) do { _Pragma("unroll") for (int m = 0; m < 4; ++m) _Pragma("unroll") for (int k = 0; k < 2; ++k) dst[m][k] = *(const LAS bf16x8*)(lds + PG8_SA(b, h) + aoff + m * 2048 + k * 1024); } while (0)
#define PG8_LDB(dst, b, h) do { _Pragma("unroll") for (int n = 0; n < 2; ++n) _Pragma("unroll") for (int k = 0; k < 2; ++k) dst[n][k] = *(const LAS bf16x8*)(lds + PG8_SB(b, h) + boff + n * 2048 + k * 1024); } while (0)
#define PG8_MMA(ai, bj, At, Bt) do { __builtin_amdgcn_s_setprio(1); _Pragma("unroll") for (int m = 0; m < 4; ++m) _Pragma("unroll") for (int n = 0; n < 2; ++n) _Pragma("unroll") for (int k = 0; k < 2; ++k) \
        acc[ai][bj][m][n] = __builtin_amdgcn_mfma_f32_16x16x32_bf16(Bt[n][k], At[m][k], acc[ai][bj][m][n], 0, 0, 0); __builtin_amdgcn_s_setprio(0); } while (0)
#define PG8_WAIT_V(n) asm volatile("s_waitcnt vmcnt(" #n ")" ::: "memory")
#define PG8_WAIT_L(n) asm volatile("s_waitcnt lgkmcnt(" #n ")" ::: "memory")
#define PG8_BAR __builtin_amdgcn_s_barrier()
#define PG8_SCHED __builtin_amdgcn_sched_barrier(0)
    Unit cur, nxt; int ui = 0;
    if (!S.next(0, cur)) return;
    f32x4 acc[2][2][4][2];
#pragma unroll
    for (int a = 0; a < 2; ++a)
#pragma unroll
        for (int b = 0; b < 2; ++b)
#pragma unroll
            for (int m = 0; m < 4; ++m)
#pragma unroll
                for (int n = 0; n < 2; ++n) acc[a][b][m][n] = (f32x4){0.f, 0.f, 0.f, 0.f};
    bf16x8 At[4][2], B0[2][2], B1[2][2];
    const char* Ab = (const char*)g.A;
    const char* cB = (const char*)g.Bt + (size_t)cur.pn * tstepB;
    unsigned offC[2][2], offN[2][2];
    AO.get(cur, offC);
    PG8_STAGE(PG8_SB(0, 0), cB, voffB); PG8_STAGE(PG8_SB(0, 1), cB + hstepB, voffB); PG8_STAGE(PG8_SA(0, 0), Ab, offC[0]); PG8_STAGE(PG8_SA(0, 1), Ab, offC[1]);
    if (wr == 1) PG8_BAR;
    PG8_WAIT_V(2); PG8_BAR;
    PG8_STAGE(PG8_SB(1, 0), cB + kstep, voffB); PG8_STAGE(PG8_SA(1, 0), Ab + kstep, offC[0]); PG8_STAGE(PG8_SB(1, 1), cB + hstepB + kstep, voffB);
    PG8_WAIT_V(6); PG8_BAR;
    for (;;) {
        const bool has_next = S.next(ui + 1, nxt);
        if (!has_next) nxt = cur;
        AO.get(nxt, offN);
        const char* nB = (const char*)g.Bt + (size_t)nxt.pn * tstepB;
        for (int t = 0; t < nt; t += 2) {
            const bool last = (t == nt - 2);
            const char* a1 = Ab + (size_t)(t + 1) * kstep;
            const char* a2 = last ? Ab : Ab + (size_t)(t + 2) * kstep; const char* b2 = last ? nB : cB + (size_t)(t + 2) * kstep;
            const char* a3 = a2 + kstep; const char* b3 = b2 + kstep;
            PG8_LDB(B0, 0, 0); PG8_LDB(B1, 0, 1); PG8_SCHED; PG8_LDA(At, 0, 0); PG8_STAGE(PG8_SA(1, 1), a1, offC[1]);
            if (last) {
#pragma unroll
                for (int h = 0; h < 2; ++h)
#pragma unroll
                    for (int i = 0; i < 2; ++i) offC[h][i] = offN[h][i]; }
            PG8_WAIT_V(8); PG8_WAIT_L(0); PG8_BAR; PG8_MMA(0, 0, At, B0); PG8_MMA(0, 1, At, B1); PG8_BAR; PG8_SCHED;
            PG8_LDA(At, 0, 1); PG8_STAGE(PG8_SB(0, 0), b2, voffB); PG8_STAGE(PG8_SB(0, 1), b2 + hstepB, voffB); PG8_STAGE(PG8_SA(0, 0), a2, offC[0]);
            PG8_WAIT_V(8); PG8_WAIT_L(0); PG8_BAR; PG8_MMA(1, 0, At, B0); PG8_MMA(1, 1, At, B1); PG8_BAR; PG8_SCHED;
            PG8_LDB(B0, 1, 0); PG8_LDB(B1, 1, 1); PG8_SCHED; PG8_LDA(At, 1, 0); PG8_STAGE(PG8_SA(0, 1), a2, offC[1]);
            PG8_WAIT_V(8); PG8_WAIT_L(0); PG8_BAR; PG8_MMA(0, 0, At, B0); PG8_MMA(0, 1, At, B1); PG8_BAR; PG8_SCHED;
            PG8_LDA(At, 1, 1); PG8_STAGE(PG8_SB(1, 0), b3, voffB); PG8_STAGE(PG8_SB(1, 1), b3 + hstepB, voffB); PG8_STAGE(PG8_SA(1, 0), a3, offC[0]);
            PG8_WAIT_V(8); PG8_WAIT_L(0); PG8_BAR; PG8_MMA(1, 0, At, B0); PG8_MMA(1, 1, At, B1); PG8_BAR; PG8_SCHED;
        }
        if constexpr (ALIGN_EPI) { if (wr == 0) PG8_BAR; }
        E(acc, cur, wr, wc, fr, fq);
        if (!has_next) break;
#pragma unroll
        for (int a = 0; a < 2; ++a)
#pragma unroll
            for (int b = 0; b < 2; ++b)
#pragma unroll
                for (int m = 0; m < 4; ++m)
#pragma unroll
                    for (int n = 0; n < 2; ++n) acc[a][b][m][n] = (f32x4){0.f, 0.f, 0.f, 0.f};
        cur = nxt; cB = nB; ++ui;
        if constexpr (ALIGN_EPI) { if (wr == 1) PG8_BAR; }
    }
    PG8_WAIT_V(0);
    if constexpr (!ALIGN_EPI) { if (wr == 0) PG8_BAR; }
    PG8_BAR;
#undef PG8_SA
#undef PG8_SB
#undef PG8_STAGE
#undef PG8_LDA
#undef PG8_LDB
#undef PG8_MMA
#undef PG8_WAIT_V
#undef PG8_WAIT_L
#undef PG8_BAR
#undef PG8_SCHED
}

__device__ __forceinline__ unsigned cvt_pk_bf16(float lo, float hi) { unsigned r; asm volatile("v_cvt_pk_bf16_f32 %0, %1, %2" : "=v"(r) : "v"(lo), "v"(hi)); return r; }
__device__ __forceinline__ u32x4 pack8(const f32x4 v0, const f32x4 v1) { u32x4 w; w.x = cvt_pk_bf16(v0[0], v0[1]); w.y = cvt_pk_bf16(v0[2], v0[3]); w.z = cvt_pk_bf16(v1[0], v1[1]); w.w = cvt_pk_bf16(v1[2], v1[3]); return w; }
__device__ __forceinline__ void rope8(f32x4& v0, f32x4& v1, const float* RT, int pos, int i0) {
    const f32x4 t0 = *(const f32x4*)(RT + (size_t)(pos * 32 + i0) * 2), t1 = *(const f32x4*)(RT + (size_t)(pos * 32 + i0) * 2 + 4);
    f32x4 o0, o1;
    o0[0] = v0[0] * t0[0] - v0[1] * t0[1]; o0[1] = v0[0] * t0[1] + v0[1] * t0[0]; o0[2] = v0[2] * t0[2] - v0[3] * t0[3]; o0[3] = v0[2] * t0[3] + v0[3] * t0[2];
    o1[0] = v1[0] * t1[0] - v1[1] * t1[1]; o1[1] = v1[0] * t1[1] + v1[1] * t1[0]; o1[2] = v1[2] * t1[2] - v1[3] * t1[3]; o1[3] = v1[2] * t1[3] + v1[3] * t1[2];
    v0 = o0; v1 = o1;
}
struct EpiProj {
    static constexpr bool PERM = true;
    bf16_t* P; const float* RT; float* SS;
    __device__ __forceinline__ void operator()(const f32x4 (&acc)[2][2][4][2], const Unit& u, int wr, int wc, int fr, int fq) const {
        const int row0 = u.pm * BM + wr * 64 + fr, col0 = u.pn * BM + wc * 32 + 8 * fq;
#pragma unroll
        for (int ai = 0; ai < 2; ++ai)
#pragma unroll
            for (int m = 0; m < 4; ++m) { const int row = row0 + ai * HALF + m * 16; bf16_t* rowp = P + (size_t)row * PROJ_N + col0;
                if (u.pn < 3) { float s = 0.f;
#pragma unroll
                    for (int bj = 0; bj < 2; ++bj)
#pragma unroll
                        for (int n = 0; n < 2; ++n) { const f32x4 x = acc[ai][bj][m][n]; s += (x[0] * x[0] + x[1] * x[1]) + (x[2] * x[2] + x[3] * x[3]); }
                    s += __shfl_xor(s, 16); s += __shfl_xor(s, 32);
                    if (fq == 0) SS[(size_t)row * 12 + (u.pn < 2 ? u.pn * 4 + wc : 8 + wc)] = s; }
#pragma unroll
                for (int bj = 0; bj < 2; ++bj) { f32x4 v0 = acc[ai][bj][m][0], v1 = acc[ai][bj][m][1];
                    if (bj == 0 && u.pn == 3 && wc < 2) rope8(v0, v1, RT, row & (SEQ - 1), 16 * wc + 4 * fq);
                    *(u32x4*)(rowp + bj * HALF) = pack8(v0, v1); }
                asm volatile("" ::: "memory"); }
    }
};
struct EpiQ {
    static constexpr bool PERM = true;
    bf16_t* Q; const float* RT; const float* SS;
    __device__ __forceinline__ void operator()(const f32x4 (&acc)[2][2][4][2], const Unit& u, int wr, int wc, int fr, int fq) const {
        const int row0 = u.pm * BM + wr * 64 + fr, col0 = u.pn * BM + wc * 32 + 8 * fq;
#pragma unroll
        for (int ai = 0; ai < 2; ++ai)
#pragma unroll
            for (int m = 0; m < 4; ++m) { const int row = row0 + ai * HALF + m * 16; bf16_t* rowp = Q + (size_t)row * 1536 + col0;
                const f32x4 s0 = *(const f32x4*)(SS + (size_t)row * 12), s1 = *(const f32x4*)(SS + (size_t)row * 12 + 4);
                const float rs = 1.0f / sqrtf((((s0[0] + s0[1]) + (s0[2] + s0[3])) + ((s1[0] + s1[1]) + (s1[2] + s1[3]))) * (1.f / QR) + RMS_EPS);
#pragma unroll
                for (int bj = 0; bj < 2; ++bj) { f32x4 v0 = acc[ai][bj][m][0] * rs, v1 = acc[ai][bj][m][1] * rs; const int jh = (col0 + bj * HALF) % QHD;
                    if (jh >= 128) rope8(v0, v1, RT, row & (SEQ - 1), (jh - 128) >> 1);
                    *(u32x4*)(rowp + bj * HALF) = pack8(v0, v1); }
                asm volatile("" ::: "memory"); }
    }
};
struct EpiKV {
    static constexpr bool PERM = true;
    bf16_t* O; const float* SS;
    __device__ __forceinline__ void operator()(const f32x4 (&acc)[2][2][4][2], const Unit& u, int wr, int wc, int fr, int fq) const {
        const int row0 = u.pm * BM + wr * 64 + fr, col0 = u.pn * BM + wc * 32 + 8 * fq;
#pragma unroll
        for (int ai = 0; ai < 2; ++ai)
#pragma unroll
            for (int m = 0; m < 4; ++m) { const int row = row0 + ai * HALF + m * 16; bf16_t* rowp = O + (size_t)row * 2048 + col0;
                const f32x4 s0 = *(const f32x4*)(SS + (size_t)row * 12 + 8);
                const float rs = 1.0f / sqrtf(((s0[0] + s0[1]) + (s0[2] + s0[3])) * (1.f / KVR) + RMS_EPS);
#pragma unroll
                for (int bj = 0; bj < 2; ++bj) *(u32x4*)(rowp + bj * HALF) = pack8(acc[ai][bj][m][0] * rs, acc[ai][bj][m][1] * rs);
                asm volatile("" ::: "memory"); }
    }
};
struct EpiOut {
    static constexpr bool PERM = false;
    const float* x; const float* MOD; float* X1;
    __device__ __forceinline__ void operator()(const f32x4 (&acc)[2][2][4][2], const Unit& u, int wr, int wc, int fr, int fq) const {
        const int row0 = u.pm * BM + wr * 64 + fr, col0 = u.pn * BM + wc * 32 + 4 * fq; const int b = (u.pm * BM) / SEQ;
        f32x4 g1[2][2];
#pragma unroll
        for (int bj = 0; bj < 2; ++bj)
#pragma unroll
            for (int n = 0; n < 2; ++n) g1[bj][n] = *(const f32x4*)(MOD + b * MODN + MOD_G1 + col0 + bj * HALF + n * 16);
#pragma unroll
        for (int ai = 0; ai < 2; ++ai)
#pragma unroll
            for (int m = 0; m < 4; ++m) { const size_t off = (size_t)(row0 + ai * HALF + m * 16) * DM + col0;
#pragma unroll
                for (int bj = 0; bj < 2; ++bj)
#pragma unroll
                    for (int n = 0; n < 2; ++n) { const f32x4 xv = *(const f32x4*)(x + off + bj * HALF + n * 16); *(f32x4*)(X1 + off + bj * HALF + n * 16) = xv * ALPHA + g1[bj][n] * acc[ai][bj][m][n]; }
                asm volatile("" ::: "memory"); }
    }
};
struct EpiMoe1 {
    static constexpr bool PERM = true;
    bf16_t* HID; const int* LIST; const float* WGT;
    __device__ __forceinline__ void operator()(const f32x4 (&acc)[2][2][4][2], const Unit& u, int wr, int wc, int fr, int fq) const {
        const int r0 = wr * 64 + fr, col0 = (u.pn & 3) * 128 + wc * 32 + 8 * fq;
#pragma unroll
        for (int ai = 0; ai < 2; ++ai)
#pragma unroll
            for (int m = 0; m < 4; ++m) { const int rl = r0 + ai * HALF + m * 16, idx = u.mt * BM + rl;
                const float w = idx < u.cnt ? WGT[LIST[u.e * NT + idx]] : 0.f;
                f32x4 h0, h1;
#pragma unroll
                for (int j = 0; j < 4; ++j) { h0[j] = silu_f(acc[ai][0][m][0][j]) * acc[ai][1][m][0][j] * w; h1[j] = silu_f(acc[ai][0][m][1][j]) * acc[ai][1][m][1][j] * w; }
                *(u32x4*)(HID + (size_t)(u.pm * BM + rl) * FF + col0) = pack8(h0, h1);
                asm volatile("" ::: "memory"); }
    }
};
struct EpiMoe2 {
    static constexpr bool PERM = true;
    bf16_t* YS; const int* LIST;
    __device__ __forceinline__ void operator()(const f32x4 (&acc)[2][2][4][2], const Unit& u, int wr, int wc, int fr, int fq) const {
        const int r0 = wr * 64 + fr, col0 = (u.pn & 7) * BM + wc * 32 + 8 * fq;
#pragma unroll
        for (int ai = 0; ai < 2; ++ai)
#pragma unroll
            for (int m = 0; m < 4; ++m) { const int idx = u.mt * BM + r0 + ai * HALF + m * 16;
                if (idx < u.cnt) { bf16_t* rowp = YS + (size_t)LIST[u.e * NT + idx] * DM + col0;
#pragma unroll
                    for (int bj = 0; bj < 2; ++bj) *(u32x4*)(rowp + bj * HALF) = pack8(acc[ai][bj][m][0], acc[ai][bj][m][1]); }
                asm volatile("" ::: "memory"); }
    }
};
}

constexpr int CVT_NCHUNK_FWD = 3 * NE * 512 / 64;
__device__ __forceinline__ void cvt_moe_chunk(const Args& a, LAS unsigned char* lds, int chunk);
namespace att {
typedef short bf16x8 __attribute__((ext_vector_type(8)));
typedef short s16x4 __attribute__((ext_vector_type(4)));
typedef float f32x16 __attribute__((ext_vector_type(16)));
constexpr int SHM_V = 16384, SHM_K = 16384, SHM_R = 8192;
constexpr int L_V = 0, L_K = 32768, L_R = 65536, L_WS = 81920, L_LUT = 83968, L_KM = 84992, L_QW = 93184, L_END = 93200;
constexpr float THR = 8.f;
#define KSWZ(row, colB) ((row) * 256 + ((colB) ^ (((row) & 7) << 4)))
#define SBAR() __builtin_amdgcn_sched_barrier(0)
__device__ __forceinline__ int v_st(int k, int c) { const int kk = (k & ~0xC) | ((k & 4) << 1) | ((k & 8) >> 1); return ((kk >> 3) * 4 + (c >> 5)) * 512 + ((kk & 7) * 32 + (c & 31)) * 2; }
__device__ __forceinline__ int v_rd_base(int lane) { return ((lane & 3) << 3) | (((lane >> 2) & 3) << 6) | (((lane >> 4) & 1) << 5) | (((lane >> 5) & 1) << 8); }
constexpr int v_rd_off(int d0, int ks, int half) { return d0 * 512 + ks * 4096 + half * 2048; }
__device__ __forceinline__ int crow(int r, int hi) { return (r & 3) + 8 * (r >> 2) + 4 * hi; }
__device__ __forceinline__ unsigned cvtpk(float lo, float hi) { unsigned r; asm volatile("v_cvt_pk_bf16_f32 %0, %1, %2" : "=v"(r) : "v"(lo), "v"(hi)); return r; }

template <int SC1000> __device__ __forceinline__ void partialSM(f32x16& p0, f32x16& p1, float& m_reg, float& alpha, float SCALE) {
    float pmax = p0[0];
#pragma unroll
    for (int r = 1; r < 16; ++r) pmax = fmaxf(pmax, p0[r]);
#pragma unroll
    for (int r = 0; r < 16; ++r) pmax = fmaxf(pmax, p1[r]);
    { auto rr = __builtin_amdgcn_permlane32_swap(__float_as_uint(pmax), __float_as_uint(pmax), false, false); pmax = fmaxf(__uint_as_float(rr[0]), __uint_as_float(rr[1])); }
    const float C2 = 1.4426950408889634f * SCALE; float mn;
    if (__builtin_expect(__all((pmax - m_reg) * SCALE <= THR), 1)) { mn = m_reg; alpha = 1.f; }
    else { mn = fmaxf(m_reg, pmax); alpha = __builtin_amdgcn_exp2f((m_reg - mn) * C2); m_reg = mn; }
    const float mnL = -mn * C2;
#pragma unroll
    for (int r = 0; r < 16; ++r) p0[r] = fmaf(p0[r], C2, mnL);
#pragma unroll
    for (int r = 0; r < 16; ++r) p1[r] = fmaf(p1[r], C2, mnL);
#pragma unroll
    for (int r = 0; r < 16; ++r) p0[r] = __builtin_amdgcn_exp2f(p0[r]);
}
__device__ __forceinline__ void finishSM(f32x16& p0, f32x16& p1, float alpha, float& l_reg, bf16x8& pa0, bf16x8& pa1, bf16x8& pa2, bf16x8& pa3) {
#pragma unroll
    for (int r = 0; r < 16; ++r) p1[r] = __builtin_amdgcn_exp2f(p1[r]);
    float ps = 0;
#pragma unroll
    for (int r = 0; r < 16; ++r) ps += p0[r];
#pragma unroll
    for (int r = 0; r < 16; ++r) ps += p1[r];
    { auto rr = __builtin_amdgcn_permlane32_swap(__float_as_uint(ps), __float_as_uint(ps), false, false); ps = __uint_as_float(rr[0]) + __uint_as_float(rr[1]); }
    l_reg = l_reg * alpha + ps;
#define PK4(P, B_, OUT) do { unsigned a0 = cvtpk(P[B_+0], P[B_+1]), a1 = cvtpk(P[B_+2], P[B_+3]);                          \
        unsigned b0 = cvtpk(P[B_+4], P[B_+5]), b1 = cvtpk(P[B_+6], P[B_+7]);                                             \
        auto r0 = __builtin_amdgcn_permlane32_swap(a0, b0, false, false); auto r1 = __builtin_amdgcn_permlane32_swap(a1, b1, false, false); \
        u32x4 w = {r0[0], r1[0], r0[1], r1[1]}; OUT = __builtin_bit_cast(bf16x8, w); } while (0)
    PK4(p0, 0, pa0); PK4(p0, 8, pa1); PK4(p1, 0, pa2); PK4(p1, 8, pa3);
#undef PK4
}
template <int KB, int NQ>
__device__ __forceinline__ void qkt(f32x16& p0, f32x16& p1, LAS const unsigned char* lds, int r32, int hi, const bf16x8* qr) {
    p0 = f32x16{}; p1 = f32x16{};
    LAS const unsigned char* kb[4];
#pragma unroll
    for (int dd = 0; dd < 4; ++dd) kb[dd] = lds + L_K + KB * SHM_K + KSWZ(r32, (dd * 16 + hi * 8) * 2);
#pragma unroll
    for (int d0 = 0; d0 < 8; ++d0) { LAS const unsigned char* p = kb[d0 & 3] + (d0 >> 2) * 128;
        const bf16x8 b0 = *(LAS const bf16x8*)p, b1 = *(LAS const bf16x8*)(p + 32 * 256);
        p0 = __builtin_amdgcn_mfma_f32_32x32x16_bf16(b0, qr[d0], p0, 0, 0, 0);
        p1 = __builtin_amdgcn_mfma_f32_32x32x16_bf16(b1, qr[d0], p1, 0, 0, 0); }
    if constexpr (NQ == 12) {
#pragma unroll
        for (int c = 0; c < 4; ++c) { LAS const unsigned char* p = lds + L_R + KB * SHM_R + r32 * 128 + ((c * 32 + hi * 16) ^ ((r32 & 7) << 4));
            const bf16x8 b0 = *(LAS const bf16x8*)p, b1 = *(LAS const bf16x8*)(p + 32 * 128);
            p0 = __builtin_amdgcn_mfma_f32_32x32x16_bf16(b0, qr[8 + c], p0, 0, 0, 0);
            p1 = __builtin_amdgcn_mfma_f32_32x32x16_bf16(b1, qr[8 + c], p1, 0, 0, 0); }
    }
}
template <int VB>
__device__ __forceinline__ void pv_tile(f32x16* o, int vb0, bf16x8 pa0, bf16x8 pa1, bf16x8 pa2, bf16x8 pa3) {
#define TRRD(dst, off) asm volatile("ds_read_b64_tr_b16 %0, %1 offset:%2" : "=&v"(dst) : "v"(vb0), "i"(off) : "memory")
#define PV_D0(d0) do { s16x4 l0, l1, l2, l3, h0, h1, h2, h3; constexpr int b_ = L_V + VB * SHM_V + v_rd_off(d0, 0, 0);   \
        TRRD(l0, b_); TRRD(h0, b_ + 2048); TRRD(l1, b_ + 4096); TRRD(h1, b_ + 6144); TRRD(l2, b_ + 8192); TRRD(h2, b_ + 10240); TRRD(l3, b_ + 12288); TRRD(h3, b_ + 14336); \
        asm volatile("s_waitcnt lgkmcnt(0)" ::: "memory"); SBAR();                                                           \
        o[d0] = __builtin_amdgcn_mfma_f32_32x32x16_bf16(pa0, (bf16x8){l0[0], l0[1], l0[2], l0[3], h0[0], h0[1], h0[2], h0[3]}, o[d0], 0, 0, 0);   \
        o[d0] = __builtin_amdgcn_mfma_f32_32x32x16_bf16(pa1, (bf16x8){l1[0], l1[1], l1[2], l1[3], h1[0], h1[1], h1[2], h1[3]}, o[d0], 0, 0, 0);   \
        o[d0] = __builtin_amdgcn_mfma_f32_32x32x16_bf16(pa2, (bf16x8){l2[0], l2[1], l2[2], l2[3], h2[0], h2[1], h2[2], h2[3]}, o[d0], 0, 0, 0);   \
        o[d0] = __builtin_amdgcn_mfma_f32_32x32x16_bf16(pa3, (bf16x8){l3[0], l3[1], l3[2], l3[3], h3[0], h3[1], h3[2], h3[3]}, o[d0], 0, 0, 0); } while (0)
    PV_D0(0); PV_D0(1); PV_D0(2); PV_D0(3);
#undef PV_D0
#undef TRRD
}

template <bool MLA>
__device__ __forceinline__ void attn_unit(const Args& a, LAS unsigned char* lds, int bh, int qt) {
    constexpr int NQ = MLA ? 12 : 8;
    constexpr float SCALE = MLA ? 0.07216878364870322f : 0.08838834764831845f;
    const int tid = tid_opaque(), wid = __builtin_amdgcn_readfirstlane(tid >> 6), lane = tid & 63, r32 = lane & 31, hi = lane >> 5;
    const int b = bh >> 3, h = bh & 7, q0 = qt * 256; const size_t rb = (size_t)b * SEQ;
    const bf16* PROJ = (const bf16*)(a.ws + WS_PROJ); const bf16* KV = (const bf16*)(a.ws + WS_KV); const bf16* QM = (const bf16*)(a.ws + WS_QM); bf16* ATT = (bf16*)(a.ws + WS_ATT);
    const bf16* Qp = MLA ? QM + (rb + q0 + wid * 32 + r32) * 1536 + h * QHD : PROJ + (rb + q0 + wid * 32 + r32) * PROJ_N + PC_QMO + h * 128;
    const int ldk = MLA ? 2048 : PROJ_N;
    const bf16* Kp = MLA ? KV + rb * 2048 + h * 256 : PROJ + rb * PROJ_N + PC_KMO + h * 128;
    const bf16* Vp = MLA ? KV + rb * 2048 + h * 256 + 128 : PROJ + rb * PROJ_N + PC_VMO + h * 128;
    const bf16* Rp = PROJ + rb * PROJ_N + PC_KR;
    bf16x8 qr[NQ];
#pragma unroll
    for (int d0 = 0; d0 < NQ; ++d0) qr[d0] = *(const bf16x8*)(Qp + d0 * 16 + hi * 8);
    LAS float* wsf = (LAS float*)(lds + L_WS) + wid * 64; LAS float* li_l = wsf; LAS float* al_l = wsf + 32;
    LAS float* LUT = (LAS float*)(lds + L_LUT); LAS float* KMl = (LAS float*)(lds + L_KM);
    unsigned selmask = 0u; float farb = 0.f;
    if constexpr (!MLA) {
        const float invs = 1.0f / SCALE;
        if (tid <= 128) LUT[tid] = a.t5[t5_bucket(tid < 128 ? tid : 128) * NH + h] * invs;
        const float* KMg = (const float*)(a.ws + WS_KMEAN) + (size_t)bh * NBLK * 128;
        for (int i = tid; i < qt * 128; i += 512) KMl[i] = KMg[i];
        farb = a.t5[31 * NH + h] * invs;
        __syncthreads();
        float g[16];
#pragma unroll
        for (int jb = 0; jb < 16; ++jb) { g[jb] = -INFINITY;
            if (jb < qt) { float s = 0.f;
#pragma unroll
                for (int d0 = 0; d0 < 8; ++d0) { const f32x4 k0 = *(LAS const f32x4*)(KMl + jb * 128 + 16 * d0 + 8 * hi), k1 = *(LAS const f32x4*)(KMl + jb * 128 + 16 * d0 + 8 * hi + 4);
                    const u32x4 qu = __builtin_bit_cast(u32x4, qr[d0]);
                    s += __uint_as_float(qu[0] << 16) * k0[0] + __uint_as_float(qu[0] & 0xffff0000u) * k0[1] + __uint_as_float(qu[1] << 16) * k0[2] + __uint_as_float(qu[1] & 0xffff0000u) * k0[3];
                    s += __uint_as_float(qu[2] << 16) * k1[0] + __uint_as_float(qu[2] & 0xffff0000u) * k1[1] + __uint_as_float(qu[3] << 16) * k1[2] + __uint_as_float(qu[3] & 0xffff0000u) * k1[3]; }
                s += __shfl_xor(s, 32); g[jb] = s; } }
        const int nsel = qt < 3 ? qt : 3;
#pragma unroll
        for (int s = 0; s < 3; ++s) if (s < nsel) { float best = -INFINITY; int bi = 0;
#pragma unroll
            for (int jb = 0; jb < 16; ++jb) { const bool ok = jb < qt && !((selmask >> jb) & 1u) && g[jb] > best; best = ok ? g[jb] : best; bi = ok ? jb : bi; }
            selmask |= 1u << bi; }
    }
    const int sr = tid >> 4, sc = (tid & 15) * 8, vst0 = v_st(sr, sc), vst1 = v_st(32 + sr, sc), kws = KSWZ(sr, sc * 2);
    const int rrow = tid >> 3, rch = tid & 7, rws = rrow * 128 + ((rch * 16) ^ ((rrow & 7) << 4));
    const int vb0 = (int)(unsigned)(uintptr_t)lds + v_rd_base(lane);
    bf16x8 st_k0, st_k1, st_v0, st_v1, st_r;
#define SLOAD(tt) do { const size_t kr_ = (size_t)((tt) * 64 + sr); st_k0 = *(const bf16x8*)(Kp + kr_ * ldk + sc); st_k1 = *(const bf16x8*)(Kp + (kr_ + 32) * ldk + sc);      \
        st_v0 = *(const bf16x8*)(Vp + kr_ * ldk + sc); st_v1 = *(const bf16x8*)(Vp + (kr_ + 32) * ldk + sc);                                                          \
        if constexpr (MLA) st_r = *(const bf16x8*)(Rp + (size_t)((tt) * 64 + rrow) * PROJ_N + rch * 8); } while (0)
#define SWRITE(bf) do { *(LAS bf16x8*)(lds + L_K + (bf) * SHM_K + kws) = st_k0; *(LAS bf16x8*)(lds + L_K + (bf) * SHM_K + kws + 32 * 256) = st_k1;                       \
        *(LAS bf16x8*)(lds + L_V + (bf) * SHM_V + vst0) = st_v0; *(LAS bf16x8*)(lds + L_V + (bf) * SHM_V + vst1) = st_v1;                                              \
        if constexpr (MLA) *(LAS bf16x8*)(lds + L_R + (bf) * SHM_R + rws) = st_r; } while (0)
    const int NTL = 4 * (qt + 1);
    const int qlo = q0 + wid * 32, qpos = qlo + r32;
    float m_reg = -1e30f, l_reg = 0.f; f32x16 o[4] = {};
    SLOAD(0); SWRITE(0);
    __syncthreads();
#define STEP(t, BUF) do {                                                                                                                                             \
        const int kbase_ = (t) * 64; const bool more_ = (t) + 1 < NTL;                                                                                               \
        if (more_) SLOAD((t) + 1);                                                                                                                                    \
        bool act_ = kbase_ <= qlo + 31;                                                                                                                               \
        bool sel_ = true;                                                                                                                                             \
        if constexpr (!MLA) { if (kbase_ < q0) { sel_ = ((selmask >> (kbase_ >> 8)) & 1u) != 0u; act_ = __any(sel_) != 0; } }                                         \
        if (act_) {                                                                                                                                                   \
            f32x16 p0, p1; float alpha; bf16x8 pa0, pa1, pa2, pa3;                                                                                                    \
            qkt<BUF, NQ>(p0, p1, lds, r32, hi, qr);                                                                                                                   \
            const int dq_ = qpos - kbase_ - 4 * hi;                                                                                                                   \
            if constexpr (!MLA) {                                                                                                                                     \
                if (kbase_ + 63 + 128 > qlo) {                                                                                                                        \
                    _Pragma("unroll") for (int r = 0; r < 16; ++r) { const int c = (r & 3) + 8 * (r >> 2); int i0 = dq_ - c, i1 = dq_ - c - 32;                       \
                        i0 = i0 < 0 ? 0 : (i0 > 128 ? 128 : i0); i1 = i1 < 0 ? 0 : (i1 > 128 ? 128 : i1); p0[r] += LUT[i0]; p1[r] += LUT[i1]; }                       \
                } else { _Pragma("unroll") for (int r = 0; r < 16; ++r) { p0[r] += farb; p1[r] += farb; } }                                                           \
                if (!sel_) { _Pragma("unroll") for (int r = 0; r < 16; ++r) { p0[r] = -INFINITY; p1[r] = -INFINITY; } }                                               \
            }                                                                                                                                                         \
            if (kbase_ + 63 > qlo) {                                                                                                                                  \
                _Pragma("unroll") for (int r = 0; r < 16; ++r) { const int c = (r & 3) + 8 * (r >> 2); if (dq_ - c < 0) p0[r] = -INFINITY; if (dq_ - c - 32 < 0) p1[r] = -INFINITY; } \
            }                                                                                                                                                         \
            partialSM<0>(p0, p1, m_reg, alpha, SCALE);                                                                                                                \
            if (__any(alpha < 1.f)) { if (hi == 0) al_l[r32] = alpha; asm volatile("s_waitcnt lgkmcnt(0)" ::: "memory");                                              \
                _Pragma("unroll") for (int d_ = 0; d_ < 4; ++d_) _Pragma("unroll") for (int r = 0; r < 16; ++r) o[d_][r] *= al_l[crow(r, hi)]; }                      \
            finishSM(p0, p1, alpha, l_reg, pa0, pa1, pa2, pa3); SBAR();                                                                                               \
            pv_tile<BUF>(o, vb0, pa0, pa1, pa2, pa3);                                                                                                                 \
        }                                                                                                                                                             \
        if (more_) SWRITE((BUF) ^ 1);                                                                                                                                 \
        __syncthreads(); } while (0)
    for (int t = 0; t < NTL; t += 2) { STEP(t, 0); STEP(t + 1, 1); }
#undef STEP
#undef SLOAD
#undef SWRITE
    if (hi == 0) li_l[r32] = l_reg;
    asm volatile("s_waitcnt lgkmcnt(0)" ::: "memory");
    bf16* Ow = ATT + (rb + q0 + wid * 32) * DM + (MLA ? 0 : 1024) + h * 128;
#pragma unroll
    for (int r = 0; r < 16; ++r) { const int orow = crow(r, hi); const float rl = __builtin_amdgcn_rcpf(li_l[orow]);
#pragma unroll
        for (int d0 = 0; d0 < 4; ++d0) { const float v = o[d0][r] * rl; const float vn = __shfl_xor(v, 1);
            if ((r32 & 1) == 0) *(unsigned*)(Ow + (size_t)orow * DM + d0 * 32 + r32) = cvtpk(v, vn); } }
}
__device__ __forceinline__ void attn_phase(const Args& a, LAS unsigned char* lds, int qi) {
    unsigned* queue = (unsigned*)(a.ws + WS_CTL) + CW_QUEUE + 64 * qi;
    volatile LAS unsigned* qw = (volatile LAS unsigned*)(lds + L_QW);
    for (;;) {
        if (threadIdx.x == 0) qw[0] = __hip_atomic_fetch_add(queue, 1u, __ATOMIC_RELAXED, __HIP_MEMORY_SCOPE_AGENT);
        __syncthreads();
        const unsigned u = (unsigned)__builtin_amdgcn_readfirstlane((int)qw[0]);
        __syncthreads();
        if (u >= 512u + (unsigned)CVT_NCHUNK_FWD) break;
        if (u >= 512u) { cvt_moe_chunk(a, lds, (int)(u - 512u)); continue; }
        const int cls = (int)(u >> 4), bh = (int)(u & 15u);
        const unsigned tybits = 0x54aa552fu;
        const int qts[32] = {15,14,13,12,15,11,14,13,10,12,9,11,8,10,7,9,8,6,7,5,6,4,5,3,4,3,2,2,1,1,0,0};
        int qt = 0;
#pragma unroll
        for (int c = 0; c < 32; ++c) qt = (cls == c) ? qts[c] : qt;
        if ((tybits >> cls) & 1u) attn_unit<true>(a, lds, bh, qt); else attn_unit<false>(a, lds, bh, qt);
    }
}
#undef KSWZ
#undef SBAR
}

constexpr int RING_OFF = 0, RING_BYTES = 131072, SCR_OFF = 131072, MISC_OFF = 139264, LDS_BYTES = 147456;
constexpr int CW_BAR = 4096;
#define LDS_WAIT() asm volatile("s_waitcnt lgkmcnt(0)" ::: "memory")

#define XB_TMO      128
#define XB_XCNT(j)  (256  + 64 * (j))
#define XB_XSUB(j)  (1280 + 64 * (j))
#define XB_XGEN(j)  (2304 + 64 * (j))
#define XB_TOP      3328
#define XB_TOPGEN   3392
#define XCD_BAR_WORDS 3456
#define XB_SPIN_CAP (1u << 18)

__device__ __forceinline__ unsigned xb_ld(unsigned* p)              { return __hip_atomic_load(p, __ATOMIC_RELAXED, __HIP_MEMORY_SCOPE_AGENT); }
__device__ __forceinline__ unsigned xb_add(unsigned* p, unsigned v) { return __hip_atomic_fetch_add(p, v, __ATOMIC_RELAXED, __HIP_MEMORY_SCOPE_AGENT); }
__device__ __forceinline__ unsigned xb_xcc_id() { return (unsigned)__builtin_amdgcn_s_getreg((3 << 11) | 20) & 0xFu; }
#define XB_SPIN(cond, bar) do { unsigned _sp = 0; while (cond) { __builtin_amdgcn_s_sleep(1); \
    if ((++_sp & 255u) == 0u) { if (xb_ld(&(bar)[XB_TMO])) break; if (_sp > XB_SPIN_CAP) { atomicAdd(&(bar)[XB_TMO], 1u); break; } } } } while (0)

struct XcdBarrier {
    unsigned* bar; unsigned x;
    volatile LAS unsigned* st;
};
__device__ __forceinline__ XcdBarrier xcd_barrier_post(unsigned* bar, volatile LAS unsigned* st) {
    XcdBarrier b; b.bar = bar; b.x = xb_xcc_id(); b.st = st;
    if (threadIdx.x == 0) (void)xb_add(&bar[XB_XCNT(b.x)], 1u);
    return b;
}
__device__ __forceinline__ void xcd_barrier_complete(unsigned* bar, unsigned x, unsigned& nloc, unsigned& nx) {
    const unsigned G = gridDim.x * gridDim.y * gridDim.z;
    unsigned sum, cnt, mine, sp = 0u;
    for (;;) {
        sum = 0u; cnt = 0u; mine = 0u;
#pragma unroll
        for (unsigned j = 0; j < 16; ++j) { const unsigned c = xb_ld(&bar[XB_XCNT(j)]); sum += c; cnt += (c > 0u) ? 1u : 0u; mine = (j == x) ? c : mine; }
        if (sum == G) break;
        __builtin_amdgcn_s_sleep(1);
        if ((++sp & 255u) == 0u) { if (xb_ld(&bar[XB_TMO])) break; if (sp > XB_SPIN_CAP) { atomicAdd(&bar[XB_TMO], 1u); break; } }
    }
    nloc = mine > 0u ? mine : 1u; nx = cnt > 0u ? cnt : 1u;
}
__device__ __forceinline__ void xcd_barrier(const XcdBarrier& b) {
    asm volatile("s_waitcnt vmcnt(0)" ::: "memory");
    __syncthreads();
    if (threadIdx.x == 0) {
        unsigned* bar = b.bar;
        __builtin_amdgcn_s_waitcnt(0);
        unsigned nloc = b.st[0], nx = b.st[1];
        if (nloc == 0u) { xcd_barrier_complete(bar, b.x, nloc, nx); b.st[0] = nloc; b.st[1] = nx; }
        const unsigned old = xb_add(&bar[XB_XSUB(b.x)], 1u);
        const unsigned gen = old / nloc;
        if (old + 1u == (gen + 1u) * nloc) {
            __builtin_amdgcn_fence(__ATOMIC_RELEASE, "agent");
            asm volatile("s_waitcnt vmcnt(0)" ::: "memory");
            const unsigned og = xb_add(&bar[XB_TOP], 1u);
            const unsigned tg = og / nx;
            if (og + 1u == (tg + 1u) * nx) xb_add(&bar[XB_TOPGEN], 1u);
            else XB_SPIN(xb_ld(&bar[XB_TOPGEN]) == tg, bar);
            __builtin_amdgcn_fence(__ATOMIC_ACQUIRE, "agent");
            xb_add(&bar[XB_XGEN(b.x)], 1u);
            asm volatile("s_waitcnt vmcnt(0)" ::: "memory");
        } else {
            XB_SPIN(xb_ld(&bar[XB_XGEN(b.x)]) == gen, bar);
            __builtin_amdgcn_fence(__ATOMIC_ACQUIRE, "agent");
            asm volatile("s_waitcnt vmcnt(0)" ::: "memory");
        }
    }
    __syncthreads();
}

template <class RM> __device__ __forceinline__ void cvt_item(const float* W, int ldw, bf16* WT, int ldt, LAS float* scr, int kb, int nb, int lane, const float* gain, const RM& rm) {
    const int k0 = 64 * kb, n0 = 32 * nb;
    float v[32];
#pragma unroll
    for (int i = 0; i < 32; ++i) v[i] = W[(size_t)(k0 + 2 * i + (lane >> 5)) * ldw + n0 + (lane & 31)];
#pragma unroll
    for (int i = 0; i < 32; ++i) { const int kk = 2 * i + (lane >> 5); scr[kk * 33 + (lane & 31)] = gain ? v[i] * gain[k0 + kk] : v[i]; }
    LDS_WAIT(); asm volatile("" ::: "memory");
    const int c = lane & 7;
#pragma unroll
    for (int j = 0; j < 4; ++j) { const int n = (lane >> 3) + 8 * j; const LAS float* s = scr + (8 * c) * 33 + n;
        u32x4 o; o.x = pk2(s[0 * 33], s[1 * 33]); o.y = pk2(s[2 * 33], s[3 * 33]); o.z = pk2(s[4 * 33], s[5 * 33]); o.w = pk2(s[6 * 33], s[7 * 33]);
        *(u32x4*)(WT + (size_t)rm(n0 + n) * ldt + k0 + 8 * c) = o; }
    LDS_WAIT(); asm volatile("" ::: "memory");
}
struct RmId { int base; __device__ __forceinline__ int operator()(int n) const { return base + n; } };
struct RmWin { __device__ __forceinline__ int operator()(int n) const { return n < 768 ? n : (n < 832 ? 768 + 2 * ((n - 768) & 31) + ((n - 768) >> 5) : n + 192); } };
struct RmUq { __device__ __forceinline__ int operator()(int n) const { const int h = n / QHD, j = n % QHD; return j < 128 ? n : h * QHD + 128 + 2 * ((j - 128) & 31) + ((j - 128) >> 5); } };
struct RmW13 { int base; __device__ __forceinline__ int operator()(int f) const { return base + (f >> 7) * 256 + (f & 127); } };
constexpr int CVT_MOE_ITEMS = 3 * NE * 512, CVT_CHUNK = 64, CVT_NCHUNK = CVT_MOE_ITEMS / CVT_CHUNK;
static_assert(CVT_NCHUNK == CVT_NCHUNK_FWD, "chunk count");
__device__ __forceinline__ void cvt_moe_item(const Args& a, LAS float* scr, int r, int lane) {
    bf16* W13 = (bf16*)(a.ws + WS_W13); bf16* W2 = (bf16*)(a.ws + WS_W2);
    const int which = r >> 14, e = (r >> 9) & 31, q = r & 511;
    if (which == 0) cvt_item(a.w1 + (size_t)e * DM * FF, FF, W13, DM, scr, q >> 4, q & 15, lane, nullptr, RmW13{e * 1024});
    else if (which == 1) cvt_item(a.w3 + (size_t)e * DM * FF, FF, W13, DM, scr, q >> 4, q & 15, lane, nullptr, RmW13{e * 1024 + 128});
    else cvt_item(a.w2 + (size_t)e * FF * DM, DM, W2, FF, scr, q >> 6, q & 63, lane, nullptr, RmId{e * DM});
}
__device__ __forceinline__ void cvt_moe_chunk(const Args& a, LAS unsigned char* lds, int chunk) {
    const int tid = tid_opaque(), lane = tid & 63, w = __builtin_amdgcn_readfirstlane(tid >> 6);
    LAS float* scr = (LAS float*)(lds + w * 8448);
    for (int i = 0; i < CVT_CHUNK / 8; ++i) cvt_moe_item(a, scr, chunk * CVT_CHUNK + w * (CVT_CHUNK / 8) + i, lane);
}
__device__ __forceinline__ void ph_convert(const Args& a, LAS unsigned char* lds, int wg, int nwg) {
    const int tid = tid_opaque(), lane = tid & 63, w = __builtin_amdgcn_readfirstlane(tid >> 6), gw = wg * 8 + w, NGW = nwg * 8;
    LAS float* scr = (LAS float*)(lds + w * 8448);
    bf16* WIN = (bf16*)(a.ws + WS_WIN); bf16* WUQ = (bf16*)(a.ws + WS_WUQ); bf16* WUKV = (bf16*)(a.ws + WS_WUKV); bf16* WOUT = (bf16*)(a.ws + WS_WOUT);
    constexpr int I_WIN = 32 * 122, I_WOUT = 32 * 64, I_WUQ = 8 * 48, I_WUKV = 4 * 64;
    constexpr int NITEMS = I_WIN + I_WOUT + I_WUQ + I_WUKV;
    for (int it = gw; it < NITEMS; it += NGW) {
        int r = it;
        if (r < I_WIN) { cvt_item(a.w_in, INCOLS, WIN, DM, scr, r / 122, r % 122, lane, nullptr, RmWin{}); continue; } r -= I_WIN;
        if (r < I_WOUT) { cvt_item(a.w_out, DM, WOUT, DM, scr, r >> 6, r & 63, lane, nullptr, RmId{0}); continue; } r -= I_WOUT;
        if (r < I_WUQ) { cvt_item(a.w_uq, 1536, WUQ, QR, scr, r / 48, r % 48, lane, a.qg, RmUq{}); continue; } r -= I_WUQ;
        cvt_item(a.w_ukv, 2048, WUKV, KVR, scr, r >> 6, r & 63, lane, a.kvg, RmId{0});
    }
    for (int i = wg * 512 + tid; i < 192 * DM / 8; i += nwg * 512) *(u32x4*)(WIN + (size_t)832 * DM + (size_t)i * 8) = (u32x4){0u, 0u, 0u, 0u};
    bf16* WRH = (bf16*)(a.ws + WS_WR); bf16* WRL = WRH + 48 * DM;
    for (int i = wg * 512 + tid; i < 48 * DM; i += nwg * 512) { const int n = i / DM, k = i % DM;
        const float v = n < 32 ? a.w_re[(size_t)k * 32 + n] : (n < 36 ? a.w_rg[(size_t)k * 4 + n - 32] : 0.f);
        const unsigned hb = f2bf(v); WRH[i] = (bf16)hb; WRL[i] = (bf16)f2bf(v - bf2f(hb)); }
}

#ifndef MK_REP
#define MK_REP 0
#endif
struct MArgs { Args a; int ph_lo, ph_hi, li, pad; };
__global__ void __launch_bounds__(512, 2) mega(MArgs m) {
    extern __shared__ __attribute__((aligned(16))) unsigned char lds_[];
    LAS unsigned char* lds = (LAS unsigned char*)lds_;
    volatile LAS unsigned* MISC = (volatile LAS unsigned*)(lds + MISC_OFF);
    const Args& a = m.a;
    const int tid = threadIdx.x, wg = blockIdx.x, nwg = gridDim.x;
    unsigned* ctl = (unsigned*)(a.ws + WS_CTL);
    if (tid < 64) MISC[tid] = 0u;
    __syncthreads();
    XcdBarrier bar = xcd_barrier_post(ctl + CW_BAR + m.li * XCD_BAR_WORDS, MISC + 8);
    const int lo = m.ph_lo, hi = m.ph_hi;
#define IN(k) (lo <= (k) && (k) < hi)
#define SEAM(k) do { if (IN(k) && IN((k) + 1)) xcd_barrier(bar); } while (0)
#define REPEAT(k) _Pragma("unroll") for (int rep_ = 0; rep_ < 1 + ((MK_REP >> (k)) & 1); ++rep_)
#define REP_BAR() do { if (rep_) xcd_barrier(bar); } while (0)
    unsigned char* ws = a.ws;
    const float* RT = (const float*)(ws + WS_ROPE); float* SS = (float*)(ws + WS_SS); const int* LIST = (const int*)(ws + WS_LIST);
    const unsigned* CNT = (const unsigned*)(ws + WS_CTL) + CW_CNT;

    if (IN(0)) REPEAT(0) { REP_BAR(); ph_mod(a, (LAS float*)(lds + SCR_OFF - 24576), wg, nwg); __syncthreads(); ph_rope_table(a, wg, nwg); ph_convert(a, lds, wg, nwg); }
    SEAM(0);
    if (IN(1)) REPEAT(1) { REP_BAR(); ph_ln0(a, wg, nwg); }
    SEAM(1);
    if (IN(2)) REPEAT(2) { REP_BAR();
        pg8::Gemm g{(const bf16*)(ws + WS_H), (const bf16*)(ws + WS_WIN), DM, DM, DM}; pg8::StaticOrder S; S.init(NT, PROJ_N, nwg, wg);
        pg8::EpiProj E{(bf16*)(ws + WS_PROJ), RT, SS};
        pg8::gemm_phase<pg8::EpiProj, pg8::StaticOrder, pg8::ADense, true>(lds + RING_OFF, g, S, pg8::ADense{DM}, E);
    }
    SEAM(2);
    if (IN(3)) REPEAT(3) { REP_BAR();
        ph_kmean(a, wg, nwg);
        {
            pg8::Gemm g{(const bf16*)(ws + WS_PROJ), (const bf16*)(ws + WS_WUQ), QR, PROJ_N, QR}; pg8::StaticOrder S; S.init(NT, 1536, nwg, wg);
            pg8::EpiQ E{(bf16*)(ws + WS_QM), RT, SS};
            pg8::gemm_phase<pg8::EpiQ, pg8::StaticOrder, pg8::ADense, true>(lds + RING_OFF, g, S, pg8::ADense{PROJ_N}, E);
        }
        {
            pg8::Gemm g{(const bf16*)(ws + WS_PROJ) + QR, (const bf16*)(ws + WS_WUKV), KVR, PROJ_N, KVR}; pg8::StaticOrder S; S.init(NT, 2048, nwg, wg);
            pg8::EpiKV E{(bf16*)(ws + WS_KV), SS};
            pg8::gemm_phase<pg8::EpiKV, pg8::StaticOrder, pg8::ADense, true>(lds + RING_OFF, g, S, pg8::ADense{PROJ_N}, E);
        }
    }
    SEAM(3);
    if (IN(4)) REPEAT(4) { REP_BAR(); att::attn_phase(a, lds, rep_); }
    SEAM(4);
    if (IN(5)) REPEAT(5) { REP_BAR();
        pg8::Gemm g{(const bf16*)(ws + WS_ATT), (const bf16*)(ws + WS_WOUT), DM, DM, DM}; pg8::StaticOrder S; S.init(NT, DM, nwg, wg);
        pg8::EpiOut E{a.x, (const float*)(ws + WS_MOD), (float*)(ws + WS_X1)};
        pg8::gemm_phase<pg8::EpiOut, pg8::StaticOrder, pg8::ADense, true>(lds + RING_OFF, g, S, pg8::ADense{DM}, E);
    }
    SEAM(5);
    if (IN(6)) ph_ln1_route(a, lds, wg, nwg);
    SEAM(6);
    if (IN(7)) REPEAT(7) { REP_BAR();
        pg8::Gemm g{(const bf16*)(ws + WS_H), (const bf16*)(ws + WS_W13), DM, DM, DM}; pg8::MoeOrder S{CNT, 4, nwg, wg};
        pg8::EpiMoe1 E{(bf16*)(ws + WS_QM), LIST, (const float*)(ws + WS_ROUTE + 65536)};
        pg8::gemm_phase<pg8::EpiMoe1, pg8::MoeOrder, pg8::AGather, true>(lds + RING_OFF, g, S, pg8::AGather{LIST, DM}, E);
    }
    SEAM(7);
    if (IN(8)) REPEAT(8) { REP_BAR();
        pg8::Gemm g{(const bf16*)(ws + WS_QM), (const bf16*)(ws + WS_W2), FF, FF, FF}; pg8::MoeOrder S{CNT, 8, nwg, wg};
        pg8::EpiMoe2 E{(bf16*)(ws + WS_PROJ), LIST};
        pg8::gemm_phase<pg8::EpiMoe2, pg8::MoeOrder, pg8::ADense, true>(lds + RING_OFF, g, S, pg8::ADense{FF}, E);
    }
    SEAM(8);
    if (IN(9)) REPEAT(9) { REP_BAR(); ph_final(a, wg, nwg); }
#undef IN
#undef SEAM
#undef REPEAT
#undef REP_BAR
}

static const int USE_MEGA[10] = {1, 1, 1, 1, 1, 1, 1, 1, 1, 1};
extern "C" void kernel_launch(void* const* d_in, const int* in_sizes, int n_in, void* d_out, int out_size, void* d_ws, size_t ws_size, hipStream_t stream) {
    if (n_in != 22 || in_sizes[0] != NT * DM || out_size != NT * DM || ws_size < WS_END) { fprintf(stderr, "kernel_launch: unexpected shapes (n_in %d, in0 %d, out %d, ws %zu)\n", n_in, n_in > 0 ? in_sizes[0] : -1, out_size, ws_size); return; }
    Args a{};
    const float** ap = (const float**)&a;
    for (int i = 0; i < 22; ++i) ap[i] = (const float*)d_in[i];
    a.out = (float*)d_out; a.ws = (unsigned char*)d_ws;
    unsigned char* ws = a.ws;
    static int grid = 0;
    if (!grid) {
        (void)hipFuncSetAttribute((const void*)k_thin<6>, hipFuncAttributeMaxDynamicSharedMemorySize, P6_LDS);
        (void)hipFuncSetAttribute((const void*)mega, hipFuncAttributeMaxDynamicSharedMemorySize, LDS_BYTES);
        int dev = 0, cus = 0; (void)hipGetDevice(&dev); (void)hipDeviceGetAttribute(&cus, hipDeviceAttributeMultiprocessorCount, dev);
        grid = cus > 0 ? cus : 256;
    }
    (void)hipMemsetAsync(ws + WS_CTL, 0, CTL_ZERO_BYTES, stream);
    const unsigned* cnt = (const unsigned*)(ws + WS_CTL) + CW_CNT;
    int li = 0;
    for (int p = 0; p < 10;) {
        if (USE_MEGA[p]) { int q = p; while (q < 10 && USE_MEGA[q]) ++q;
            MArgs m{}; m.a = a; m.ph_lo = p; m.ph_hi = q; m.li = li++; m.pad = 0;
            hipLaunchKernelGGL(mega, dim3(grid), dim3(512), LDS_BYTES, stream, m);
            p = q; continue; }
        switch (p) {
        case 0: k_thin<0><<<256, 512, 32768, stream>>>(a); break;
        case 1: k_thin<1><<<256, 512, 0, stream>>>(a); break;
        case 2: nk_gemm<FProj><<<dim3(INCOLS / 64, NT / 64, 1), 256, 0, stream>>>(FProj{(const bf16*)(ws + WS_H), a.w_in, (float*)(ws + WS_W13)}, DM);
                nk_epi_proj<<<NT, 256, 0, stream>>>(a); break;
        case 3: nk_gemm<FQ><<<dim3(1536 / 64, NT / 64, 1), 256, 0, stream>>>(FQ{(const bf16*)(ws + WS_PROJ), a.w_uq, a.qg, (float*)(ws + WS_W13)}, QR);
                nk_epi_q<<<NT, 256, 0, stream>>>(a);
                nk_gemm<FKV><<<dim3(2048 / 64, NT / 64, 1), 256, 0, stream>>>(FKV{(const bf16*)(ws + WS_PROJ), a.w_ukv, a.kvg, (const float*)(ws + WS_SS), (bf16*)(ws + WS_KV)}, KVR);
                k_thin<3><<<256, 512, 0, stream>>>(a); break;
        case 4: nk_attn_mla<<<dim3(SEQ / 2, NH, NB), 128, 0, stream>>>(a);
                nk_attn_moba<<<dim3(SEQ / 4, NH, NB), 256, 0, stream>>>(a); break;
        case 5: nk_gemm<FOut><<<dim3(DM / 64, NT / 64, 1), 256, 0, stream>>>(FOut{(const bf16*)(ws + WS_ATT), a.w_out, a.x, (const float*)(ws + WS_MOD), (float*)(ws + WS_X1)}, DM); break;
        case 6: k_thin<6><<<256, 512, P6_LDS, stream>>>(a); break;
        case 7: nk_gemm<FMoe1><<<dim3(1024 / 64, NT / 64, NE), 256, 0, stream>>>(FMoe1{(const bf16*)(ws + WS_H), a.w1, a.w3, cnt, (const int*)(ws + WS_LIST), (float*)(ws + WS_W13)}, DM);
                nk_epi_moe1<<<dim3(NE, NT / 64), 256, 0, stream>>>(a); break;
        case 8: nk_gemm<FMoe2><<<dim3(DM / 64, NT / 64, NE), 256, 0, stream>>>(FMoe2{(const bf16*)(ws + WS_QM), a.w2, cnt, (const int*)(ws + WS_LIST), (bf16*)(ws + WS_PROJ)}, FF); break;
        case 9: k_thin<9><<<256, 512, 0, stream>>>(a); break;
        }
        ++p;
    }
}
```

```cpp
#include <hip/hip_runtime.h>
#include <cstdio>
#include <cstdint>

#define LAS __attribute__((address_space(3)))
typedef unsigned short bf16;
typedef float f32x4 __attribute__((ext_vector_type(4)));
typedef unsigned u32x4 __attribute__((ext_vector_type(4)));
typedef unsigned u32x2 __attribute__((ext_vector_type(2)));

constexpr int NB = 2, SEQ = 4096, DM = 2048, NT = NB * SEQ;
constexpr int QR = 512, KVR = 256, NH = 8, QHD = 192, MBLK = 256, NBLK = 16;
constexpr int INCOLS = 3904, PROJ_N = 4096, MODN = 6 * DM;
constexpr int NE = 32, FF = 512;
constexpr float LN_EPS = 1e-5f, RMS_EPS = 1e-6f;
constexpr float ALPHA = 1.189207115002721f;
constexpr int MOD_SH1 = 0, MOD_SC1 = DM, MOD_G1 = 2 * DM, MOD_SH2 = 3 * DM, MOD_SC2 = 4 * DM, MOD_G2 = 5 * DM;
constexpr int PC_KR = 768, PC_QMO = 1024, PC_KMO = 2048, PC_VMO = 3072;

constexpr size_t MiB = 1u << 20;
constexpr size_t WS_CTL = 0, CTL_ZERO_BYTES = 1 * MiB;
constexpr size_t WS_MOD = 1 * MiB;
constexpr size_t WS_ROPE = 2 * MiB;
constexpr size_t WS_KMEAN = 3 * MiB;
constexpr size_t WS_SS = 3 * MiB + 512 * 1024;
constexpr size_t WS_ROUTE = 4 * MiB;
constexpr size_t WS_LIST = 5 * MiB;
constexpr size_t WS_WIN = 8 * MiB;
constexpr size_t WS_WUQ = 24 * MiB;
constexpr size_t WS_WUKV = 26 * MiB;
constexpr size_t WS_WOUT = 28 * MiB;
constexpr size_t WS_WR = 36 * MiB;
constexpr size_t WS_W13 = 40 * MiB;
constexpr size_t WS_W2 = 168 * MiB;
constexpr size_t WS_H = 232 * MiB;
constexpr size_t WS_PROJ = 264 * MiB;
constexpr size_t WS_QM = 328 * MiB;
constexpr size_t WS_KV = 352 * MiB;
constexpr size_t WS_ATT = 384 * MiB;
constexpr size_t WS_X1 = 416 * MiB;
constexpr size_t WS_END = 480 * MiB;
constexpr int CW_CNT = 64;
constexpr int CW_QUEUE = 128;

__device__ __forceinline__ unsigned f2bf(float f) { unsigned u = __builtin_bit_cast(unsigned, f); return (u + 0x7fffu + ((u >> 16) & 1u)) >> 16; }
__device__ __forceinline__ float bf2f(unsigned b) { return __builtin_bit_cast(float, b << 16); }
__device__ __forceinline__ unsigned pk2(float lo, float hi) { return f2bf(lo) | (f2bf(hi) << 16); }
__device__ __forceinline__ float wave_sum(float v) {
#pragma unroll
    for (int o = 1; o < 64; o <<= 1) v += __shfl_xor(v, o);
    return v;
}
__device__ __forceinline__ float wave_max(float v) {
#pragma unroll
    for (int o = 1; o < 64; o <<= 1) v = fmaxf(v, __shfl_xor(v, o));
    return v;
}
__device__ __forceinline__ int tid_opaque() { int t = threadIdx.x; asm volatile("" : "+v"(t)); return t; }
__device__ __forceinline__ float silu_f(float v) { return v / (1.f + __expf(-v)); }
__device__ __forceinline__ int t5_bucket(int n) {
    if (n < 16) return n;
    int l = 16 + (int)(logf((float)n / 16.f) / 2.0794415416798357f * 16.f);
    return l < 31 ? l : 31;
}
__device__ __forceinline__ int moe_rowbase(const unsigned* cnt, int e) { int s = 0; for (int i = 0; i < e; ++i) s += (int)((cnt[i] + 255u) >> 8) << 8; return s; }

struct Args {
    const float *x, *c, *w_ada, *b_ada, *w_in, *qg, *w_uq, *kvg, *w_ukv, *w_out, *t5, *ln1g, *ln1b, *w_rg, *b_rg, *w_re, *b_re, *w1, *w3, *w2, *ln2g, *ln2b;
    float* out; unsigned char* ws;
};


__device__ __forceinline__ void ph_mod(const Args& a, LAS float* sm, int wg, int nwg) {
    const int tid = tid_opaque(), lane = tid & 63, w = __builtin_amdgcn_readfirstlane(tid >> 6);
    float* MOD = (float*)(a.ws + WS_MOD);
    LAS float* sc = sm;
    LAS float* red = sm + 2 * DM;
    if (wg >= 192) return;
    for (int i = tid; i < 2 * DM; i += 512) sc[i] = silu_f(a.c[i]);
    __syncthreads();
    for (int cg = wg; cg < 192; cg += nwg) {
        const int c4 = lane & 15, ksub = lane >> 4, col = cg * 64 + 4 * c4;
        f32x4 a0 = {0.f, 0.f, 0.f, 0.f}, a1 = {0.f, 0.f, 0.f, 0.f};
#pragma unroll 8
        for (int it = 0; it < 64; ++it) {
            const int k = w * 256 + it * 4 + ksub;
            const f32x4 wv = *(const f32x4*)(a.w_ada + (size_t)k * MODN + col);
            a0 += wv * sc[k]; a1 += wv * sc[DM + k];
        }
#pragma unroll
        for (int j = 0; j < 4; ++j) { a0[j] += __shfl_xor(a0[j], 16); a0[j] += __shfl_xor(a0[j], 32); a1[j] += __shfl_xor(a1[j], 16); a1[j] += __shfl_xor(a1[j], 32); }
        if (ksub == 0) {
#pragma unroll
            for (int j = 0; j < 4; ++j) { red[(w * 2 + 0) * 64 + 4 * c4 + j] = a0[j]; red[(w * 2 + 1) * 64 + 4 * c4 + j] = a1[j]; }
        }
        __syncthreads();
        if (tid < 128) { const int b = tid >> 6, cc = tid & 63; float s = 0.f;
#pragma unroll
            for (int ww = 0; ww < 8; ++ww) s += red[(ww * 2 + b) * 64 + cc];
            MOD[b * MODN + cg * 64 + cc] = s + a.b_ada[cg * 64 + cc]; }
        __syncthreads();
    }
}
__device__ __forceinline__ void ph_rope_table(const Args& a, int wg, int nwg) {
    float* RT = (float*)(a.ws + WS_ROPE);
    for (int idx = wg * 512 + tid_opaque(); idx < SEQ * 32; idx += nwg * 512) {
        const int pos = idx >> 5, i = idx & 31;
        const float inv = 1.0f / powf(10000.0f, (float)(2 * i) / 64.0f);
        const float ang = (float)pos * inv;
        const double ad = (double)ang, q = rint(ad * 0.6366197723675814), r = ad - q * 1.5707963267948966;
        const int qi = ((int)q) & 3; const float rf = (float)r, r2 = rf * rf;
        const float s = rf * (1.f + r2 * (-1.6666667e-1f + r2 * (8.3333333e-3f + r2 * (-1.9841270e-4f + r2 * 2.7557319e-6f))));
        const float c = 1.f + r2 * (-0.5f + r2 * (4.1666667e-2f + r2 * (-1.3888889e-3f + r2 * (2.4801587e-5f + r2 * (-2.7557319e-7f)))));
        float cs, sn;
        if (qi == 0) { cs = c; sn = s; } else if (qi == 1) { cs = -s; sn = c; } else if (qi == 2) { cs = -c; sn = -s; } else { cs = s; sn = -c; }
        RT[2 * idx] = cs; RT[2 * idx + 1] = sn;
    }
}
__device__ __forceinline__ void ph_ln0(const Args& a, int wg, int nwg) {
    const int tid = tid_opaque(), lane = tid & 63, gw = wg * 8 + __builtin_amdgcn_readfirstlane(tid >> 6), NGW = nwg * 8;
    const float* MOD = (const float*)(a.ws + WS_MOD); bf16* H = (bf16*)(a.ws + WS_H);
    for (int b = 0; b < NB; ++b) {
        f32x4 sc[8], sh[8];
#pragma unroll
        for (int j = 0; j < 8; ++j) { sc[j] = *(const f32x4*)(MOD + b * MODN + MOD_SC1 + 4 * lane + 256 * j) + 1.0f; sh[j] = *(const f32x4*)(MOD + b * MODN + MOD_SH1 + 4 * lane + 256 * j); }
        for (int r = gw; r < SEQ; r += NGW) {
            const size_t row = (size_t)b * SEQ + r;
            const float* xr = a.x + row * DM + 4 * lane;
            f32x4 v[8]; float s = 0.f;
#pragma unroll
            for (int j = 0; j < 8; ++j) { v[j] = *(const f32x4*)(xr + 256 * j); s += (v[j][0] + v[j][1]) + (v[j][2] + v[j][3]); }
            const float mean = wave_sum(s) * (1.f / DM); float s2 = 0.f;
#pragma unroll
            for (int j = 0; j < 8; ++j) { v[j] = v[j] - mean; s2 += (v[j][0] * v[j][0] + v[j][1] * v[j][1]) + (v[j][2] * v[j][2] + v[j][3] * v[j][3]); }
            const float rstd = 1.0f / sqrtf(wave_sum(s2) * (1.f / DM) + LN_EPS);
            bf16* hr = H + row * DM + 4 * lane;
#pragma unroll
            for (int j = 0; j < 8; ++j) { const f32x4 o = v[j] * rstd * sc[j] + sh[j]; u32x2 w; w.x = pk2(o[0], o[1]); w.y = pk2(o[2], o[3]); *(u32x2*)(hr + 256 * j) = w; }
        }
    }
}
__device__ __forceinline__ void ph_kmean(const Args& a, int wg, int nwg) {
    const int tid = tid_opaque(), lane = tid & 63, gw = wg * 8 + __builtin_amdgcn_readfirstlane(tid >> 6), NGW = nwg * 8;
    const bf16* PROJ = (const bf16*)(a.ws + WS_PROJ); float* KM = (float*)(a.ws + WS_KMEAN);
    for (int t = gw; t < 16 * NBLK; t += NGW) {
        const int bh = t >> 4, blk = t & 15, b = bh >> 3, h = bh & 7;
        const bf16* p = PROJ + ((size_t)b * SEQ + blk * MBLK) * PROJ_N + PC_KMO + h * 128 + 2 * lane;
        float s0 = 0.f, s1 = 0.f;
#pragma unroll 8
        for (int r = 0; r < MBLK; ++r) { const unsigned u = *(const unsigned*)(p + (size_t)r * PROJ_N); s0 += bf2f(u & 0xffffu); s1 += bf2f(u >> 16); }
        KM[(size_t)t * 128 + 2 * lane] = s0 * (1.f / MBLK); KM[(size_t)t * 128 + 2 * lane + 1] = s1 * (1.f / MBLK);
    }
}
constexpr int P6_ROWB = 4112, P6_ALO = 16 * P6_ROWB, P6_RS = 132096, P6_LDS = 133120;
typedef short p6_bf16x8 __attribute__((ext_vector_type(8)));
__device__ __forceinline__ void ph_ln1_route(const Args& a, LAS unsigned char* lds, int wg, int nwg) {
    const int tid = tid_opaque(), lane = tid & 63, w = __builtin_amdgcn_readfirstlane(tid >> 6);
    const float* MOD = (const float*)(a.ws + WS_MOD); bf16* H = (bf16*)(a.ws + WS_H); bf16* X1 = (bf16*)(a.ws + WS_X1);
    int* EID = (int*)(a.ws + WS_ROUTE); float* WGT = (float*)(a.ws + WS_ROUTE + 65536); int* LIST = (int*)(a.ws + WS_LIST);
    unsigned* CNT = (unsigned*)(a.ws + WS_CTL) + CW_CNT;
    const bf16* WRH = (const bf16*)(a.ws + WS_WR); const bf16* WRL = WRH + 48 * DM; const bf16* Y1 = (const bf16*)(a.ws + WS_KV);
    LAS float* PART = (LAS float*)lds; LAS float* LG = (LAS float*)(lds + 24576);
    LAS unsigned* lcnt = (LAS unsigned*)(lds + P6_RS); LAS unsigned* lbase = lcnt + 32; LAS int* sl_e = (LAS int*)(lcnt + 64); LAS int* sl_pos = sl_e + 32;
    if (tid < 32) lcnt[tid] = 0u;
    for (int r0 = wg * 16; r0 < NT; r0 += nwg * 16) {
        const int b = r0 / SEQ;
        for (int rr = 0; rr < 2; ++rr) {
            const int row = r0 + 2 * w + rr;
            bf16* xr = X1 + (size_t)row * DM + 4 * lane; const float* xin = a.x + (size_t)row * DM + 4 * lane; const bf16* yr = Y1 + (size_t)row * DM + 4 * lane;
            f32x4 v[8]; float s = 0.f;
#pragma unroll
            for (int j = 0; j < 8; ++j) { const f32x4 xv = *(const f32x4*)(xin + 256 * j); const u32x2 yu = *(const u32x2*)(yr + 256 * j); const f32x4 g1 = *(const f32x4*)(MOD + b * MODN + MOD_G1 + 4 * lane + 256 * j);
                f32x4 y; y[0] = bf2f(yu.x & 0xffffu); y[1] = bf2f(yu.x >> 16); y[2] = bf2f(yu.y & 0xffffu); y[3] = bf2f(yu.y >> 16);
                v[j] = xv * ALPHA + g1 * y; s += (v[j][0] + v[j][1]) + (v[j][2] + v[j][3]); }
            float mean = wave_sum(s) * (1.f / DM), s2 = 0.f;
#pragma unroll
            for (int j = 0; j < 8; ++j) { v[j] = v[j] - mean; s2 += (v[j][0] * v[j][0] + v[j][1] * v[j][1]) + (v[j][2] * v[j][2] + v[j][3] * v[j][3]); }
            float rstd = 1.0f / sqrtf(wave_sum(s2) * (1.f / DM) + LN_EPS);
            s = 0.f;
#pragma unroll
            for (int j = 0; j < 8; ++j) { const f32x4 g = *(const f32x4*)(a.ln1g + 4 * lane + 256 * j), bb = *(const f32x4*)(a.ln1b + 4 * lane + 256 * j);
                v[j] = v[j] * rstd * g + bb; { u32x2 xw; xw.x = pk2(v[j][0], v[j][1]); xw.y = pk2(v[j][2], v[j][3]); *(u32x2*)(xr + 256 * j) = xw; } s += (v[j][0] + v[j][1]) + (v[j][2] + v[j][3]); }
            mean = wave_sum(s) * (1.f / DM); s2 = 0.f;
#pragma unroll
            for (int j = 0; j < 8; ++j) { v[j] = v[j] - mean; s2 += (v[j][0] * v[j][0] + v[j][1] * v[j][1]) + (v[j][2] * v[j][2] + v[j][3] * v[j][3]); }
            rstd = 1.0f / sqrtf(wave_sum(s2) * (1.f / DM) + LN_EPS);
            bf16* hr = H + (size_t)row * DM + 4 * lane; LAS unsigned char* hl = lds + (2 * w + rr) * P6_ROWB + 8 * lane;
#pragma unroll
            for (int j = 0; j < 8; ++j) { const f32x4 sc = *(const f32x4*)(MOD + b * MODN + MOD_SC2 + 4 * lane + 256 * j) + 1.0f, sh = *(const f32x4*)(MOD + b * MODN + MOD_SH2 + 4 * lane + 256 * j);
                const f32x4 o = v[j] * rstd * sc + sh;
                unsigned hb[4], lb[4];
#pragma unroll
                for (int i = 0; i < 4; ++i) { hb[i] = f2bf(o[i]); lb[i] = f2bf(o[i] - bf2f(hb[i])); }
                u32x2 wh, wl; wh.x = hb[0] | (hb[1] << 16); wh.y = hb[2] | (hb[3] << 16); wl.x = lb[0] | (lb[1] << 16); wl.y = lb[2] | (lb[3] << 16);
                *(u32x2*)(hr + 256 * j) = wh; *(LAS u32x2*)(hl + 512 * j) = wh; *(LAS u32x2*)(hl + P6_ALO + 512 * j) = wl; }
        }
        __syncthreads();
        {
            const int row16 = lane & 15, quad = lane >> 4;
            f32x4 acc[3];
#pragma unroll
            for (int t = 0; t < 3; ++t) acc[t] = (f32x4){0.f, 0.f, 0.f, 0.f};
#pragma unroll 2
            for (int ks = 0; ks < 8; ++ks) { const int k0 = w * 256 + ks * 32 + quad * 8;
                const p6_bf16x8 ah = *(LAS const p6_bf16x8*)(lds + row16 * P6_ROWB + k0 * 2), al = *(LAS const p6_bf16x8*)(lds + P6_ALO + row16 * P6_ROWB + k0 * 2);
#pragma unroll
                for (int t = 0; t < 3; ++t) { const p6_bf16x8 bh = *(const p6_bf16x8*)(WRH + (size_t)(16 * t + row16) * DM + k0), bl = *(const p6_bf16x8*)(WRL + (size_t)(16 * t + row16) * DM + k0);
                    acc[t] = __builtin_amdgcn_mfma_f32_16x16x32_bf16(ah, bh, acc[t], 0, 0, 0);
                    acc[t] = __builtin_amdgcn_mfma_f32_16x16x32_bf16(ah, bl, acc[t], 0, 0, 0);
                    acc[t] = __builtin_amdgcn_mfma_f32_16x16x32_bf16(al, bh, acc[t], 0, 0, 0); } }
            __syncthreads();
#pragma unroll
            for (int t = 0; t < 3; ++t)
#pragma unroll
                for (int j = 0; j < 4; ++j) PART[(w * 16 + quad * 4 + j) * 48 + 16 * t + row16] = acc[t][j];
        }
        __syncthreads();
        for (int idx = tid; idx < 16 * 36; idx += 512) { const int r = idx / 36, n = idx % 36; float sum = 0.f;
#pragma unroll
            for (int ww = 0; ww < 8; ++ww) sum += PART[(ww * 16 + r) * 48 + n];
            LG[idx] = sum; }
        __syncthreads();
        if (tid < 16) {
            const int t = r0 + tid; const LAS float* lg = LG + tid * 36;
            float g[4]; int gi = 0;
#pragma unroll
            for (int i = 0; i < 4; ++i) g[i] = lg[32 + i] + a.b_rg[i];
            float gm = g[0];
#pragma unroll
            for (int i = 1; i < 4; ++i) if (g[i] > gm) { gm = g[i]; gi = i; }
            float gs = 0.f;
#pragma unroll
            for (int i = 0; i < 4; ++i) gs += expf(g[i] - gm);
            const float gp = 1.0f / gs;
            float el[8];
#pragma unroll
            for (int i = 0; i < 8; ++i) el[i] = lg[gi * 8 + i] + a.b_re[gi * 8 + i];
            int i1 = 0; float m1 = el[0];
#pragma unroll
            for (int i = 1; i < 8; ++i) if (el[i] > m1) { m1 = el[i]; i1 = i; }
            int i2 = -1; float m2 = -INFINITY;
#pragma unroll
            for (int i = 0; i < 8; ++i) if (i != i1 && el[i] > m2) { m2 = el[i]; i2 = i; }
            const float p2 = expf(m2 - m1), inv = 1.0f / (1.0f + p2);
            const int e1 = gi * 8 + i1, e2 = gi * 8 + i2;
            EID[2 * t] = e1; EID[2 * t + 1] = e2; WGT[2 * t] = gp * inv; WGT[2 * t + 1] = gp * p2 * inv;
            sl_e[2 * tid] = e1; sl_pos[2 * tid] = (int)__hip_atomic_fetch_add(&lcnt[e1], 1u, __ATOMIC_RELAXED, __HIP_MEMORY_SCOPE_WORKGROUP);
            sl_e[2 * tid + 1] = e2; sl_pos[2 * tid + 1] = (int)__hip_atomic_fetch_add(&lcnt[e2], 1u, __ATOMIC_RELAXED, __HIP_MEMORY_SCOPE_WORKGROUP);
        }
        __syncthreads();
        if (tid < 32) { const unsigned n = lcnt[tid]; lbase[tid] = n ? atomicAdd(CNT + tid, n) : 0u; lcnt[tid] = 0u; }
        __syncthreads();
        if (tid < 32) { const int e = sl_e[tid]; LIST[e * NT + (int)lbase[e] + sl_pos[tid]] = 2 * (r0 + (tid >> 1)) + (tid & 1); }
        __syncthreads();
    }
}
__device__ __forceinline__ void ph_final(const Args& a, int wg, int nwg) {
    const int tid = tid_opaque(), lane = tid & 63, gw = wg * 8 + __builtin_amdgcn_readfirstlane(tid >> 6), NGW = nwg * 8;
    const float* MOD = (const float*)(a.ws + WS_MOD); const bf16* X1 = (const bf16*)(a.ws + WS_X1); const bf16* YS = (const bf16*)(a.ws + WS_PROJ);
    for (int row = gw; row < NT; row += NGW) {
        const int b = row / SEQ;
        const bf16* xr = X1 + (size_t)row * DM + 4 * lane; const bf16* y0 = YS + (size_t)(2 * row) * DM + 4 * lane; const bf16* y1 = y0 + DM;
        f32x4 v[8]; float s = 0.f;
#pragma unroll
        for (int j = 0; j < 8; ++j) { const f32x4 g2 = *(const f32x4*)(MOD + b * MODN + MOD_G2 + 4 * lane + 256 * j); const u32x2 u0 = *(const u32x2*)(y0 + 256 * j), u1 = *(const u32x2*)(y1 + 256 * j);
            f32x4 y; y[0] = bf2f(u0.x & 0xffffu) + bf2f(u1.x & 0xffffu); y[1] = bf2f(u0.x >> 16) + bf2f(u1.x >> 16); y[2] = bf2f(u0.y & 0xffffu) + bf2f(u1.y & 0xffffu); y[3] = bf2f(u0.y >> 16) + bf2f(u1.y >> 16);
            const u32x2 xu = *(const u32x2*)(xr + 256 * j); f32x4 xv; xv[0] = bf2f(xu.x & 0xffffu); xv[1] = bf2f(xu.x >> 16); xv[2] = bf2f(xu.y & 0xffffu); xv[3] = bf2f(xu.y >> 16);
            v[j] = xv * ALPHA + g2 * y; s += (v[j][0] + v[j][1]) + (v[j][2] + v[j][3]); }
        const float mean = wave_sum(s) * (1.f / DM); float s2 = 0.f;
#pragma unroll
        for (int j = 0; j < 8; ++j) { v[j] = v[j] - mean; s2 += (v[j][0] * v[j][0] + v[j][1] * v[j][1]) + (v[j][2] * v[j][2] + v[j][3] * v[j][3]); }
        const float rstd = 1.0f / sqrtf(wave_sum(s2) * (1.f / DM) + LN_EPS);
        float* o = a.out + (size_t)row * DM + 4 * lane;
#pragma unroll
        for (int j = 0; j < 8; ++j) { const f32x4 g = *(const f32x4*)(a.ln2g + 4 * lane + 256 * j), bb = *(const f32x4*)(a.ln2b + 4 * lane + 256 * j); *(f32x4*)(o + 256 * j) = v[j] * rstd * g + bb; }
    }
}

template <int PH> __global__ void __launch_bounds__(512, 2) k_thin(Args a) {
    extern __shared__ __attribute__((aligned(16))) unsigned char lds[];
    const int wg = blockIdx.x, nwg = gridDim.x;
    if (PH == 0) { ph_mod(a, (LAS float*)lds, wg, nwg); ph_rope_table(a, wg, nwg); }
    if (PH == 1) ph_ln0(a, wg, nwg);
    if (PH == 3) ph_kmean(a, wg, nwg);
    if (PH == 6) ph_ln1_route(a, (LAS unsigned char*)lds, wg, nwg);
    if (PH == 9) ph_final(a, wg, nwg);
}

template <class F> __global__ void __launch_bounds__(256) nk_gemm(F f, int K) {
    __shared__ float As[16][68]; __shared__ float Bs[16][68];
    const int tid = threadIdx.x, tx = tid & 15, ty = tid >> 4, z = blockIdx.z, m0 = blockIdx.y * 64, n0 = blockIdx.x * 64;
    if (!f.active(z, m0)) return;
    float acc[4][4] = {};
    const int ar = tid >> 2, ak = (tid & 3) * 4; const bf16* arow = f.arow(z, m0 + ar);
    const int bk = tid >> 4, bn = (tid & 15) * 4;
    for (int k0 = 0; k0 < K; k0 += 16) {
        float a4[4] = {0.f, 0.f, 0.f, 0.f};
        if (arow) { const u32x2 u = *(const u32x2*)(arow + k0 + ak); a4[0] = bf2f(u.x & 0xffffu); a4[1] = bf2f(u.x >> 16); a4[2] = bf2f(u.y & 0xffffu); a4[3] = bf2f(u.y >> 16); }
#pragma unroll
        for (int i = 0; i < 4; ++i) As[ak + i][ar] = a4[i];
#pragma unroll
        for (int i = 0; i < 4; ++i) Bs[bk][bn + i] = f.b(z, k0 + bk, n0 + bn + i);
        __syncthreads();
#pragma unroll
        for (int kk = 0; kk < 16; ++kk) { float av[4], bv[4];
#pragma unroll
            for (int i = 0; i < 4; ++i) { av[i] = As[kk][ty * 4 + i]; bv[i] = Bs[kk][tx * 4 + i]; }
#pragma unroll
            for (int i = 0; i < 4; ++i)
#pragma unroll
                for (int j = 0; j < 4; ++j) acc[i][j] += av[i] * bv[j]; }
        __syncthreads();
    }
#pragma unroll
    for (int i = 0; i < 4; ++i)
#pragma unroll
        for (int j = 0; j < 4; ++j) f.store(z, m0 + ty * 4 + i, n0 + tx * 4 + j, acc[i][j]);
}
struct FProj { const bf16* A; const float* W; float* C;
    __device__ bool active(int, int) const { return true; }
    __device__ const bf16* arow(int, int m) const { return A + (size_t)m * DM; }
    __device__ float b(int, int k, int n) const { return W[(size_t)k * INCOLS + n]; }
    __device__ void store(int, int m, int n, float v) const { C[(size_t)m * INCOLS + n] = v; } };
struct FQ { const bf16* PROJ; const float* W; const float* g; float* C;
    __device__ bool active(int, int) const { return true; }
    __device__ const bf16* arow(int, int m) const { return PROJ + (size_t)m * PROJ_N; }
    __device__ float b(int, int k, int n) const { return g[k] * W[(size_t)k * 1536 + n]; }
    __device__ void store(int, int m, int n, float v) const { C[(size_t)m * 1536 + n] = v; } };
struct FKV { const bf16* PROJ; const float* W; const float* g; const float* SS; bf16* KV;
    __device__ bool active(int, int) const { return true; }
    __device__ const bf16* arow(int, int m) const { return PROJ + (size_t)m * PROJ_N + QR; }
    __device__ float b(int, int k, int n) const { return g[k] * W[(size_t)k * 2048 + n]; }
    __device__ void store(int, int m, int n, float v) const { const float* s = SS + (size_t)m * 12 + 8; const float rs = 1.0f / sqrtf(((s[0] + s[1]) + (s[2] + s[3])) * (1.f / KVR) + RMS_EPS); KV[(size_t)m * 2048 + n] = (bf16)f2bf(v * rs); } };
struct FOut { const bf16* ATT; const float* W; bf16* Y;
    __device__ bool active(int, int) const { return true; }
    __device__ const bf16* arow(int, int m) const { return ATT + (size_t)m * DM; }
    __device__ float b(int, int k, int n) const { return W[(size_t)k * DM + n]; }
    __device__ void store(int, int m, int n, float v) const { Y[(size_t)m * DM + n] = (bf16)f2bf(v); } };
struct FMoe1 { const bf16* H; const float* w1; const float* w3; const unsigned* cnt; const int* LIST; float* C;
    __device__ bool active(int e, int m0) const { return m0 < (int)cnt[e]; }
    __device__ const bf16* arow(int e, int m) const { return m < (int)cnt[e] ? H + (size_t)(LIST[e * NT + m] >> 1) * DM : nullptr; }
    __device__ float b(int e, int k, int n) const { return n < FF ? w1[((size_t)e * DM + k) * FF + n] : w3[((size_t)e * DM + k) * FF + n - FF]; }
    __device__ void store(int e, int m, int n, float v) const { if (m < (int)cnt[e]) C[(size_t)(moe_rowbase(cnt, e) + m) * 1024 + n] = v; } };
struct FMoe2 { const bf16* HID; const float* w2; const unsigned* cnt; const int* LIST; bf16* YS;
    __device__ bool active(int e, int m0) const { return m0 < (int)cnt[e]; }
    __device__ const bf16* arow(int e, int m) const { return m < (int)cnt[e] ? HID + (size_t)(moe_rowbase(cnt, e) + m) * FF : nullptr; }
    __device__ float b(int e, int k, int n) const { return w2[((size_t)e * FF + k) * DM + n]; }
    __device__ void store(int e, int m, int n, float v) const { if (m < (int)cnt[e]) YS[(size_t)LIST[e * NT + m] * DM + n] = (bf16)f2bf(v); } };

__global__ void __launch_bounds__(256) nk_epi_proj(Args a) {
    const int row = blockIdx.x, tid = threadIdx.x, pos = row % SEQ;
    const float* T = (const float*)(a.ws + WS_W13) + (size_t)row * INCOLS; bf16* P = (bf16*)(a.ws + WS_PROJ) + (size_t)row * PROJ_N;
    const float* RT = (const float*)(a.ws + WS_ROPE); float* SS = (float*)(a.ws + WS_SS) + (size_t)row * 12;
    __shared__ float red[2][256];
    float sq = 0.f, skv = 0.f;
    for (int n = tid; n < PROJ_N; n += 256) {
        float v;
        if (n < PC_KR) { v = T[n]; if (n < QR) sq += v * v; else skv += v * v; }
        else if (n < PC_KR + 64) { const int jj = n - PC_KR, i = jj >> 1, s = jj & 1; const float x1 = T[768 + i], x2 = T[768 + 32 + i], cs = RT[2 * (pos * 32 + i)], sn = RT[2 * (pos * 32 + i) + 1]; v = s == 0 ? x1 * cs - x2 * sn : x1 * sn + x2 * cs; }
        else if (n < PC_QMO) v = 0.f;
        else v = T[n - 192];
        P[n] = (bf16)f2bf(v);
    }
    red[0][tid] = sq; red[1][tid] = skv; __syncthreads();
    for (int o = 128; o > 0; o >>= 1) { if (tid < o) { red[0][tid] += red[0][tid + o]; red[1][tid] += red[1][tid + o]; } __syncthreads(); }
    if (tid < 12) SS[tid] = tid == 0 ? red[0][0] : (tid == 8 ? red[1][0] : 0.f);
}
__global__ void __launch_bounds__(256) nk_epi_q(Args a) {
    const int row = blockIdx.x, tid = threadIdx.x, pos = row % SEQ;
    const float* T = (const float*)(a.ws + WS_W13) + (size_t)row * 1536; bf16* Q = (bf16*)(a.ws + WS_QM) + (size_t)row * 1536;
    const float* RT = (const float*)(a.ws + WS_ROPE); const float* s = (const float*)(a.ws + WS_SS) + (size_t)row * 12;
    const float rs = 1.0f / sqrtf((((s[0] + s[1]) + (s[2] + s[3])) + ((s[4] + s[5]) + (s[6] + s[7]))) * (1.f / QR) + RMS_EPS);
    for (int n = tid; n < 1536; n += 256) {
        const int h = n / QHD, j = n % QHD; float v;
        if (j < 128) v = T[n] * rs;
        else { const int jj = j - 128, i = jj >> 1, sx = jj & 1; const float x1 = T[h * QHD + 128 + i] * rs, x2 = T[h * QHD + 160 + i] * rs, cs = RT[2 * (pos * 32 + i)], sn = RT[2 * (pos * 32 + i) + 1]; v = sx == 0 ? x1 * cs - x2 * sn : x1 * sn + x2 * cs; }
        Q[n] = (bf16)f2bf(v);
    }
}
__global__ void __launch_bounds__(256) nk_epi_moe1(Args a) {
    const unsigned* cnt = (const unsigned*)(a.ws + WS_CTL) + CW_CNT; const int e = blockIdx.x, m0 = blockIdx.y * 64;
    if (m0 >= (int)cnt[e]) return;
    const int* LIST = (const int*)(a.ws + WS_LIST); const float* WGT = (const float*)(a.ws + WS_ROUTE + 65536);
    const float* T = (const float*)(a.ws + WS_W13); bf16* HID = (bf16*)(a.ws + WS_QM); const int rb = moe_rowbase(cnt, e);
    for (int m = m0; m < m0 + 64 && m < (int)cnt[e]; ++m) { const float w = WGT[LIST[e * NT + m]]; const size_t R = (size_t)(rb + m);
        for (int f = threadIdx.x; f < FF; f += 256) { const float a1 = T[R * 1024 + f], a3 = T[R * 1024 + FF + f]; HID[R * FF + f] = (bf16)f2bf(silu_f(a1) * a3 * w); } }
}
__global__ void __launch_bounds__(128) nk_attn_mla(Args a) {
    __shared__ float sc[2][SEQ]; __shared__ float qv[2][QHD];
    const int lane = threadIdx.x & 63, w = threadIdx.x >> 6, b = blockIdx.z, h = blockIdx.y, q = blockIdx.x * 2 + w;
    const bf16* QM = (const bf16*)(a.ws + WS_QM); const bf16* KV = (const bf16*)(a.ws + WS_KV); const bf16* PROJ = (const bf16*)(a.ws + WS_PROJ); bf16* ATT = (bf16*)(a.ws + WS_ATT);
    const size_t row = (size_t)b * SEQ + q; const float scale = 0.07216878364870322f;
    for (int d = lane; d < QHD; d += 64) qv[w][d] = bf2f(QM[row * 1536 + h * QHD + d]);
    __syncthreads();
    float mx = -INFINITY;
    for (int k = lane; k <= q; k += 64) { const size_t kr = (size_t)b * SEQ + k; const bf16* kn = KV + kr * 2048 + h * 256; const bf16* kp = PROJ + kr * PROJ_N + PC_KR; float dsum = 0.f;
        for (int d = 0; d < 128; ++d) dsum += qv[w][d] * bf2f(kn[d]);
        for (int d = 0; d < 64; ++d) dsum += qv[w][128 + d] * bf2f(kp[d]);
        dsum *= scale; sc[w][k] = dsum; mx = fmaxf(mx, dsum); }
    mx = wave_max(mx); float sum = 0.f;
    for (int k = lane; k <= q; k += 64) { const float p = expf(sc[w][k] - mx); sc[w][k] = p; sum += p; }
    sum = wave_sum(sum);
    __syncthreads();
    float o0 = 0.f, o1 = 0.f;
    for (int k = 0; k <= q; ++k) { const unsigned u = *(const unsigned*)(KV + ((size_t)b * SEQ + k) * 2048 + h * 256 + 128 + 2 * lane); const float p = sc[w][k]; o0 += p * bf2f(u & 0xffffu); o1 += p * bf2f(u >> 16); }
    const float inv = 1.0f / sum;
    *(unsigned*)(ATT + row * DM + h * 128 + 2 * lane) = pk2(o0 * inv, o1 * inv);
}
__global__ void __launch_bounds__(256) nk_attn_moba(Args a) {
    __shared__ float sc[4][1024]; __shared__ float qv[4][128]; __shared__ int selb[4][4];
    const int lane = threadIdx.x & 63, w = threadIdx.x >> 6, b = blockIdx.z, h = blockIdx.y, q = blockIdx.x * 4 + w, qblk = q / MBLK;
    const bf16* PROJ = (const bf16*)(a.ws + WS_PROJ); bf16* ATT = (bf16*)(a.ws + WS_ATT); const float* KM = (const float*)(a.ws + WS_KMEAN) + (size_t)(b * NH + h) * NBLK * 128;
    const size_t row = (size_t)b * SEQ + q; const float scale = 0.08838834764831845f;
    for (int d = lane; d < 128; d += 64) qv[w][d] = bf2f(PROJ[row * PROJ_N + PC_QMO + h * 128 + d]);
    __syncthreads();
    float gate = -INFINITY;
    if (lane < qblk) { float s = 0.f; for (int d = 0; d < 128; ++d) s += qv[w][d] * KM[lane * 128 + d]; gate = s; }
    const int nsel = qblk < 3 ? qblk : 3;
    for (int s = 0; s < nsel; ++s) {
        float bv = gate; int bi = lane;
#pragma unroll
        for (int o = 1; o < 64; o <<= 1) { const float ov = __shfl_xor(bv, o); const int oi = __shfl_xor(bi, o); if (ov > bv || (ov == bv && oi < bi)) { bv = ov; bi = oi; } }
        if (lane == 0) selb[w][s] = bi;
        if (lane == bi) gate = -INFINITY;
    }
    if (lane == 0) selb[w][nsel] = qblk;
    __syncthreads();
    float mx = -INFINITY;
    for (int s = 0; s <= nsel; ++s) { const int blk = selb[w][s];
        for (int kk = lane; kk < MBLK; kk += 64) { const int key = blk * MBLK + kk; float v = -INFINITY;
            if (key <= q) { const bf16* kp = PROJ + ((size_t)b * SEQ + key) * PROJ_N + PC_KMO + h * 128; float dsum = 0.f;
                for (int d = 0; d < 128; ++d) dsum += qv[w][d] * bf2f(kp[d]);
                v = dsum * scale + a.t5[t5_bucket(q - key) * NH + h]; }
            sc[w][s * MBLK + kk] = v; mx = fmaxf(mx, v); } }
    mx = wave_max(mx); float sum = 0.f;
    for (int i = lane; i < (nsel + 1) * MBLK; i += 64) { const float p = expf(sc[w][i] - mx); sc[w][i] = p; sum += p; }
    sum = wave_sum(sum);
    __syncthreads();
    float o0 = 0.f, o1 = 0.f;
    for (int s = 0; s <= nsel; ++s) { const int blk = selb[w][s];
        for (int kk = 0; kk < MBLK; ++kk) { const int key = blk * MBLK + kk; if (key > q) break;
            const unsigned u = *(const unsigned*)(PROJ + ((size_t)b * SEQ + key) * PROJ_N + PC_VMO + h * 128 + 2 * lane); const float p = sc[w][s * MBLK + kk]; o0 += p * bf2f(u & 0xffffu); o1 += p * bf2f(u >> 16); } }
    const float inv = 1.0f / sum;
    *(unsigned*)(ATT + row * DM + 1024 + h * 128 + 2 * lane) = pk2(o0 * inv, o1 * inv);
}

namespace pg8 {
typedef unsigned short bf16_t;
typedef short bf16x8 __attribute__((ext_vector_type(8)));
constexpr int BM = 256, BK = 64, HALF = 128, HTB = HALF * BK * 2, STAGE_BYTES = 8 * HTB, NXCD = 8, WGM = 8;
__host__ __device__ __forceinline__ int lds_byte(int r, int c) { const int st = (r >> 4) * 2 + (c >> 5), rr = r & 15, cc = c & 31, ob = rr * 64 + cc * 2; return st * 1024 + (ob ^ (((ob >> 9) & 1) << 5)); }
__host__ __device__ __forceinline__ void stage_rc(int b, int& R, int& C) { const int st = b / 1024, sb = b % 1024, swz = sb ^ (((sb >> 9) & 1) << 5); R = (st >> 1) * 16 + swz / 64; C = (st & 1) * 32 + (swz % 64) / 2; }
__host__ __device__ __forceinline__ int perm32(int rho) { const int n = rho >> 4, i = rho & 15; return 8 * (i >> 2) + 4 * n + (i & 3); }

struct Unit { int pm, pn, e, mt, cnt; };
struct Gemm { const bf16_t* A; const bf16_t* Bt; int K, lda, ldb; };

struct StaticOrder {
    int nM, nN, nwg, G, c;
    __device__ void init(int M, int N, int G_, int c_) { nM = M / BM; nN = N / BM; nwg = nM * nN; G = G_; c = c_; }
    __device__ bool next(int i, Unit& u) const {
        const long L = (long)i * G + c; if (L >= nwg) return false;
        int wgid = (int)L; { const int q = nwg / NXCD, r = nwg % NXCD, xcd = wgid % NXCD, off = wgid / NXCD; wgid = (xcd < r ? xcd * (q + 1) : r * (q + 1) + (xcd - r) * q) + off; }
        const int nig = WGM * nN, gid = wgid / nig, fm = gid * WGM, gsz = (nM - fm) < WGM ? (nM - fm) : WGM;
        u.pm = fm + ((wgid % nig) % gsz); u.pn = (wgid % nig) / gsz; u.e = 0; u.mt = 0; u.cnt = 0; return true;
    }
};
struct MoeOrder {
    const unsigned* cnt; int NPN, G, c;
    __device__ bool next(int i, Unit& u) const {
        int nmt = 0;
        for (int e = 0; e < NE; ++e) nmt += (int)((cnt[e] + 255u) >> 8);
        const int x = c & 7, nl = G >> 3, lw = c >> 3;
        const int g0 = (nmt * x) >> 3, g1 = (nmt * (x + 1)) >> 3;
        const int L = i * nl + lw, gl = L / NPN;
        if (lw >= nl || g0 + gl >= g1) return false;
        int g = g0 + gl, rb = 0;
        for (int e = 0; e < NE; ++e) { const int ce = (int)cnt[e], nm = (ce + 255) >> 8;
            if (g < nm) { u.e = e; u.mt = g; u.pn = e * NPN + L % NPN; u.pm = rb + g; u.cnt = ce; return true; }
            g -= nm; rb += nm; }
        return false;
    }
};
struct ADense { int lda;
    __device__ __forceinline__ void get(const Unit& u, unsigned (&off)[2][2]) const {
        const int tid = tid_opaque();
#pragma unroll
        for (int i = 0; i < 2; ++i) { int R, C; stage_rc(tid * 16 + i * 8192, R, C);
#pragma unroll
            for (int h = 0; h < 2; ++h) off[h][i] = (unsigned)((u.pm * BM + h * HALF + R) * lda + C) * 2u; } } };
struct AGather { const int* LIST; int lda;
    __device__ __forceinline__ void get(const Unit& u, unsigned (&off)[2][2]) const {
        const int tid = tid_opaque();
#pragma unroll
        for (int i = 0; i < 2; ++i) { int R, C; stage_rc(tid * 16 + i * 8192, R, C);
#pragma unroll
            for (int h = 0; h < 2; ++h) { const int idx = u.mt * BM + h * HALF + R; const int tok = idx < u.cnt ? (LIST[u.e * NT + idx] >> 1) : 0; off[h][i] = (unsigned)(tok * lda + C) * 2u; } } } };

template <class Epi, class Sched, class AOff, bool ALIGN_EPI>
__device__ __forceinline__ void gemm_phase(LAS unsigned char* lds, const Gemm g, const Sched& S, const AOff& AO, const Epi& E) {
    const int tid = tid_opaque(), wid = __builtin_amdgcn_readfirstlane(tid >> 6), lane = tid & 63, wr = wid >> 2, wc = wid & 3, fr = lane & 15, fq = lane >> 4;
    const int K = g.K, nt = K / BK;
    unsigned voffB[2];
#pragma unroll
    for (int i = 0; i < 2; ++i) { int R, C; stage_rc(tid * 16 + i * 8192, R, C); const int Rb = Epi::PERM ? ((R & ~31) + perm32(R & 31)) : R;
        voffB[i] = (unsigned)(Rb * g.ldb + C) * 2u; }
    const size_t kstep = (size_t)(BK * 2);
    const size_t hstepB = (size_t)HALF * g.ldb * 2, tstepB = 2 * hstepB;
    const unsigned ldsw = (unsigned)wid * 1024u;
    const int aoff = lds_byte(wr * 64 + fr, fq * 8), boff = lds_byte(wc * 32 + fr, fq * 8);
#define PG8_SA(b, h) (((b) * 2 + (h)) * HTB)
#define PG8_SB(b, h) ((4 + (b) * 2 + (h)) * HTB)
#define PG8_STAGE(bufoff, gbase, voff) do { _Pragma("unroll") for (int _i = 0; _i < 2; ++_i) \
        __builtin_amdgcn_global_load_lds((const unsigned*)((const char*)(gbase) + (voff)[_i]), (LAS unsigned*)(lds + (bufoff) + ldsw + _i * 8192), 16, 0, 0); } while (0)
#define PG8_LDA(dst, b, h) do { _Pragma("unroll") for (int m = 0; m < 4; ++m) _Pragma("unroll") for (int k = 0; k < 2; ++k) dst[m][k] = *(const LAS bf16x8*)(lds + PG8_SA(b, h) + aoff + m * 2048 + k * 1024); } while (0)
#define PG8_LDB(dst, b, h) do { _Pragma("unroll") for (int n = 0; n < 2; ++n) _Pragma("unroll") for (int k = 0; k < 2; ++k) dst[n][k] = *(const LAS bf16x8*)(lds + PG8_SB(b, h) + boff + n * 2048 + k * 1024); } while (0)
#define PG8_MMA(ai, bj, At, Bt) do { __builtin_amdgcn_s_setprio(1); _Pragma("unroll") for (int m = 0; m < 4; ++m) _Pragma("unroll") for (int n = 0; n < 2; ++n) _Pragma("unroll") for (int k = 0; k < 2; ++k) \
        acc[ai][bj][m][n] = __builtin_amdgcn_mfma_f32_16x16x32_bf16(Bt[n][k], At[m][k], acc[ai][bj][m][n], 0, 0, 0); __builtin_amdgcn_s_setprio(0); } while (0)
#define PG8_WAIT_V(n) asm volatile("s_waitcnt vmcnt(" #n ")" ::: "memory")
#define PG8_WAIT_L(n) asm volatile("s_waitcnt lgkmcnt(" #n ")" ::: "memory")
#define PG8_BAR __builtin_amdgcn_s_barrier()
#define PG8_SCHED __builtin_amdgcn_sched_barrier(0)
    Unit cur, nxt; int ui = 0;
    if (!S.next(0, cur)) return;
    f32x4 acc[2][2][4][2];
#pragma unroll
    for (int a = 0; a < 2; ++a)
#pragma unroll
        for (int b = 0; b < 2; ++b)
#pragma unroll
            for (int m = 0; m < 4; ++m)
#pragma unroll
                for (int n = 0; n < 2; ++n) acc[a][b][m][n] = (f32x4){0.f, 0.f, 0.f, 0.f};
    bf16x8 At[4][2], B0[2][2], B1[2][2];
    const char* Ab = (const char*)g.A;
    const char* cB = (const char*)g.Bt + (size_t)cur.pn * tstepB;
    unsigned offC[2][2], offN[2][2];
    AO.get(cur, offC);
    PG8_STAGE(PG8_SB(0, 0), cB, voffB); PG8_STAGE(PG8_SB(0, 1), cB + hstepB, voffB); PG8_STAGE(PG8_SA(0, 0), Ab, offC[0]); PG8_STAGE(PG8_SA(0, 1), Ab, offC[1]);
    if (wr == 1) PG8_BAR;
    PG8_WAIT_V(2); PG8_BAR;
    PG8_STAGE(PG8_SB(1, 0), cB + kstep, voffB); PG8_STAGE(PG8_SA(1, 0), Ab + kstep, offC[0]); PG8_STAGE(PG8_SB(1, 1), cB + hstepB + kstep, voffB);
    PG8_WAIT_V(6); PG8_BAR;
    for (;;) {
        const bool has_next = S.next(ui + 1, nxt);
        if (!has_next) nxt = cur;
        AO.get(nxt, offN);
        const char* nB = (const char*)g.Bt + (size_t)nxt.pn * tstepB;
#pragma unroll 1
        for (int t = 0; t < nt; t += 2) {
            const bool last = (t == nt - 2);
            const char* a1 = Ab + (size_t)(t + 1) * kstep;
            const char* a2 = last ? Ab : Ab + (size_t)(t + 2) * kstep; const char* b2 = last ? nB : cB + (size_t)(t + 2) * kstep;
            const char* a3 = a2 + kstep; const char* b3 = b2 + kstep;
            PG8_LDB(B0, 0, 0); PG8_LDB(B1, 0, 1); PG8_SCHED; PG8_LDA(At, 0, 0); PG8_STAGE(PG8_SA(1, 1), a1, offC[1]);
            if (last) {
#pragma unroll
                for (int h = 0; h < 2; ++h)
#pragma unroll
                    for (int i = 0; i < 2; ++i) offC[h][i] = offN[h][i]; }
            PG8_WAIT_V(8); PG8_WAIT_L(0); PG8_BAR; PG8_MMA(0, 0, At, B0); PG8_MMA(0, 1, At, B1); PG8_BAR; PG8_SCHED;
            PG8_LDA(At, 0, 1); PG8_STAGE(PG8_SB(0, 0), b2, voffB); PG8_STAGE(PG8_SB(0, 1), b2 + hstepB, voffB); PG8_STAGE(PG8_SA(0, 0), a2, offC[0]);
            PG8_WAIT_V(8); PG8_WAIT_L(0); PG8_BAR; PG8_MMA(1, 0, At, B0); PG8_MMA(1, 1, At, B1); PG8_BAR; PG8_SCHED;
            PG8_LDB(B0, 1, 0); PG8_LDB(B1, 1, 1); PG8_SCHED; PG8_LDA(At, 1, 0); PG8_STAGE(PG8_SA(0, 1), a2, offC[1]);
            PG8_WAIT_V(8); PG8_WAIT_L(0); PG8_BAR; PG8_MMA(0, 0, At, B0); PG8_MMA(0, 1, At, B1); PG8_BAR; PG8_SCHED;
            PG8_LDA(At, 1, 1); PG8_STAGE(PG8_SB(1, 0), b3, voffB); PG8_STAGE(PG8_SB(1, 1), b3 + hstepB, voffB); PG8_STAGE(PG8_SA(1, 0), a3, offC[0]);
            PG8_WAIT_V(8); PG8_WAIT_L(0); PG8_BAR; PG8_MMA(1, 0, At, B0); PG8_MMA(1, 1, At, B1); PG8_BAR; PG8_SCHED;
        }
        if constexpr (ALIGN_EPI) { if (wr == 0) PG8_BAR; }
        E(acc, cur);
        if (!has_next) break;
#pragma unroll
        for (int a = 0; a < 2; ++a)
#pragma unroll
            for (int b = 0; b < 2; ++b)
#pragma unroll
                for (int m = 0; m < 4; ++m)
#pragma unroll
                    for (int n = 0; n < 2; ++n) acc[a][b][m][n] = (f32x4){0.f, 0.f, 0.f, 0.f};
        cur = nxt; cB = nB; ++ui;
        if constexpr (ALIGN_EPI) { if (wr == 1) PG8_BAR; }
    }
    PG8_WAIT_V(0);
    if constexpr (!ALIGN_EPI) { if (wr == 0) PG8_BAR; }
    PG8_BAR;
#undef PG8_SA
#undef PG8_SB
#undef PG8_STAGE
#undef PG8_LDA
#undef PG8_LDB
#undef PG8_MMA
#undef PG8_WAIT_V
#undef PG8_WAIT_L
#undef PG8_BAR
#undef PG8_SCHED
}

__device__ __forceinline__ unsigned cvt_pk_bf16(float lo, float hi) { unsigned r; asm volatile("v_cvt_pk_bf16_f32 %0, %1, %2" : "=v"(r) : "v"(lo), "v"(hi)); return r; }
__device__ __forceinline__ u32x4 pack8(const f32x4 v0, const f32x4 v1) { u32x4 w; w.x = cvt_pk_bf16(v0[0], v0[1]); w.y = cvt_pk_bf16(v0[2], v0[3]); w.z = cvt_pk_bf16(v1[0], v1[1]); w.w = cvt_pk_bf16(v1[2], v1[3]); return w; }
__device__ __forceinline__ void rope8(f32x4& v0, f32x4& v1, const float* RT, int pos, int i0) {
    const f32x4 t0 = *(const f32x4*)(RT + (size_t)(pos * 32 + i0) * 2), t1 = *(const f32x4*)(RT + (size_t)(pos * 32 + i0) * 2 + 4);
    f32x4 o0, o1;
    o0[0] = v0[0] * t0[0] - v0[1] * t0[1]; o0[1] = v0[0] * t0[1] + v0[1] * t0[0]; o0[2] = v0[2] * t0[2] - v0[3] * t0[3]; o0[3] = v0[2] * t0[3] + v0[3] * t0[2];
    o1[0] = v1[0] * t1[0] - v1[1] * t1[1]; o1[1] = v1[0] * t1[1] + v1[1] * t1[0]; o1[2] = v1[2] * t1[2] - v1[3] * t1[3]; o1[3] = v1[2] * t1[3] + v1[3] * t1[2];
    v0 = o0; v1 = o1;
}
struct EpiProj {
    static constexpr bool PERM = true;
    bf16_t* P; const float* RT; float* SS;
    __device__ __forceinline__ void operator()(const f32x4 (&acc)[2][2][4][2], const Unit& u) const {
        const int tid_ = tid_opaque(), wid_ = __builtin_amdgcn_readfirstlane(tid_ >> 6), wr = wid_ >> 2, wc = wid_ & 3, fr = tid_ & 15, fq = (tid_ & 63) >> 4;
        const int row0 = u.pm * BM + wr * 64 + fr, col0 = u.pn * BM + wc * 32 + 8 * fq;
#pragma unroll
        for (int ai = 0; ai < 2; ++ai)
#pragma unroll
            for (int m = 0; m < 4; ++m) { const int row = row0 + ai * HALF + m * 16; bf16_t* rowp = P + (size_t)row * PROJ_N + col0;
                if (u.pn < 3) { float s = 0.f;
#pragma unroll
                    for (int bj = 0; bj < 2; ++bj)
#pragma unroll
                        for (int n = 0; n < 2; ++n) { const f32x4 x = acc[ai][bj][m][n]; s += (x[0] * x[0] + x[1] * x[1]) + (x[2] * x[2] + x[3] * x[3]); }
                    s += __shfl_xor(s, 16); s += __shfl_xor(s, 32);
                    if (fq == 0) SS[(size_t)row * 12 + (u.pn < 2 ? u.pn * 4 + wc : 8 + wc)] = s; }
#pragma unroll
                for (int bj = 0; bj < 2; ++bj) { f32x4 v0 = acc[ai][bj][m][0], v1 = acc[ai][bj][m][1];
                    if (bj == 0 && u.pn == 3 && wc < 2) rope8(v0, v1, RT, row & (SEQ - 1), 16 * wc + 4 * fq);
                    *(u32x4*)(rowp + bj * HALF) = pack8(v0, v1); }
                asm volatile("" ::: "memory"); }
    }
};
struct EpiQ {
    static constexpr bool PERM = true;
    bf16_t* Q; const float* RT; const float* SS;
    __device__ __forceinline__ void operator()(const f32x4 (&acc)[2][2][4][2], const Unit& u) const {
        const int tid_ = tid_opaque(), wid_ = __builtin_amdgcn_readfirstlane(tid_ >> 6), wr = wid_ >> 2, wc = wid_ & 3, fr = tid_ & 15, fq = (tid_ & 63) >> 4;
        const int row0 = u.pm * BM + wr * 64 + fr, col0 = u.pn * BM + wc * 32 + 8 * fq;
        float rs[8];
#pragma unroll
        for (int i = 0; i < 8; ++i) { const int row = row0 + (i >> 2) * HALF + (i & 3) * 16;
            const f32x4 s0 = *(const f32x4*)(SS + (size_t)row * 12), s1 = *(const f32x4*)(SS + (size_t)row * 12 + 4);
            rs[i] = 1.0f / sqrtf((((s0[0] + s0[1]) + (s0[2] + s0[3])) + ((s1[0] + s1[1]) + (s1[2] + s1[3]))) * (1.f / QR) + RMS_EPS); }
#pragma unroll
        for (int ai = 0; ai < 2; ++ai)
#pragma unroll
            for (int m = 0; m < 4; ++m) { const int row = row0 + ai * HALF + m * 16; bf16_t* rowp = Q + (size_t)row * 1536 + col0;
#pragma unroll
                for (int bj = 0; bj < 2; ++bj) { f32x4 v0 = acc[ai][bj][m][0] * rs[ai * 4 + m], v1 = acc[ai][bj][m][1] * rs[ai * 4 + m]; const int jh = (col0 + bj * HALF) % QHD;
                    if (jh >= 128) rope8(v0, v1, RT, row & (SEQ - 1), (jh - 128) >> 1);
                    *(u32x4*)(rowp + bj * HALF) = pack8(v0, v1); }
                asm volatile("" ::: "memory"); }
    }
};
struct EpiKV {
    static constexpr bool PERM = true;
    bf16_t* O; const float* SS;
    __device__ __forceinline__ void operator()(const f32x4 (&acc)[2][2][4][2], const Unit& u) const {
        const int tid_ = tid_opaque(), wid_ = __builtin_amdgcn_readfirstlane(tid_ >> 6), wr = wid_ >> 2, wc = wid_ & 3, fr = tid_ & 15, fq = (tid_ & 63) >> 4;
        const int row0 = u.pm * BM + wr * 64 + fr, col0 = u.pn * BM + wc * 32 + 8 * fq;
        float rs[8];
#pragma unroll
        for (int i = 0; i < 8; ++i) { const int row = row0 + (i >> 2) * HALF + (i & 3) * 16; const f32x4 s0 = *(const f32x4*)(SS + (size_t)row * 12 + 8);
            rs[i] = 1.0f / sqrtf(((s0[0] + s0[1]) + (s0[2] + s0[3])) * (1.f / KVR) + RMS_EPS); }
#pragma unroll
        for (int ai = 0; ai < 2; ++ai)
#pragma unroll
            for (int m = 0; m < 4; ++m) { const int row = row0 + ai * HALF + m * 16; bf16_t* rowp = O + (size_t)row * 2048 + col0;
#pragma unroll
                for (int bj = 0; bj < 2; ++bj) *(u32x4*)(rowp + bj * HALF) = pack8(acc[ai][bj][m][0] * rs[ai * 4 + m], acc[ai][bj][m][1] * rs[ai * 4 + m]); }
    }
};
struct EpiOut {
    static constexpr bool PERM = true;
    bf16_t* Y;
    __device__ __forceinline__ void operator()(const f32x4 (&acc)[2][2][4][2], const Unit& u) const {
        const int tid_ = tid_opaque(), wid_ = __builtin_amdgcn_readfirstlane(tid_ >> 6), wr = wid_ >> 2, wc = wid_ & 3, fr = tid_ & 15, fq = (tid_ & 63) >> 4;
        const int row0 = u.pm * BM + wr * 64 + fr, col0 = u.pn * BM + wc * 32 + 8 * fq;
#pragma unroll
        for (int ai = 0; ai < 2; ++ai)
#pragma unroll
            for (int m = 0; m < 4; ++m) { bf16_t* rowp = Y + (size_t)(row0 + ai * HALF + m * 16) * DM + col0;
#pragma unroll
                for (int bj = 0; bj < 2; ++bj) *(u32x4*)(rowp + bj * HALF) = pack8(acc[ai][bj][m][0], acc[ai][bj][m][1]); }
    }
};
struct EpiMoe1 {
    static constexpr bool PERM = true;
    bf16_t* HID; const int* LIST; const float* WGT;
    __device__ __forceinline__ void operator()(const f32x4 (&acc)[2][2][4][2], const Unit& u) const {
        const int tid_ = tid_opaque(), wid_ = __builtin_amdgcn_readfirstlane(tid_ >> 6), wr = wid_ >> 2, wc = wid_ & 3, fr = tid_ & 15, fq = (tid_ & 63) >> 4;
        const int r0 = wr * 64 + fr, col0 = (u.pn & 3) * 128 + wc * 32 + 8 * fq;
        int sl[8]; float w[8];
#pragma unroll
        for (int i = 0; i < 8; ++i) { const int idx = u.mt * BM + r0 + (i >> 2) * HALF + (i & 3) * 16; sl[i] = idx < u.cnt ? LIST[u.e * NT + idx] : -1; }
#pragma unroll
        for (int i = 0; i < 8; ++i) w[i] = sl[i] >= 0 ? WGT[sl[i]] : 0.f;
#pragma unroll
        for (int ai = 0; ai < 2; ++ai)
#pragma unroll
            for (int m = 0; m < 4; ++m) { const int rl = r0 + ai * HALF + m * 16; const float wv = w[ai * 4 + m];
                f32x4 h0, h1;
#pragma unroll
                for (int j = 0; j < 4; ++j) { h0[j] = silu_f(acc[ai][0][m][0][j]) * acc[ai][1][m][0][j] * wv; h1[j] = silu_f(acc[ai][0][m][1][j]) * acc[ai][1][m][1][j] * wv; }
                *(u32x4*)(HID + (size_t)(u.pm * BM + rl) * FF + col0) = pack8(h0, h1); }
    }
};
struct EpiMoe2 {
    static constexpr bool PERM = true;
    bf16_t* YS; const int* LIST;
    __device__ __forceinline__ void operator()(const f32x4 (&acc)[2][2][4][2], const Unit& u) const {
        const int tid_ = tid_opaque(), wid_ = __builtin_amdgcn_readfirstlane(tid_ >> 6), wr = wid_ >> 2, wc = wid_ & 3, fr = tid_ & 15, fq = (tid_ & 63) >> 4;
        const int r0 = wr * 64 + fr, col0 = (u.pn & 7) * BM + wc * 32 + 8 * fq;
        int sl[8];
#pragma unroll
        for (int i = 0; i < 8; ++i) { const int idx = u.mt * BM + r0 + (i >> 2) * HALF + (i & 3) * 16; sl[i] = idx < u.cnt ? LIST[u.e * NT + idx] : -1; }
#pragma unroll
        for (int ai = 0; ai < 2; ++ai)
#pragma unroll
            for (int m = 0; m < 4; ++m) { const int slot = sl[ai * 4 + m];
                if (slot >= 0) { bf16_t* rowp = YS + (size_t)slot * DM + col0;
#pragma unroll
                    for (int bj = 0; bj < 2; ++bj) *(u32x4*)(rowp + bj * HALF) = pack8(acc[ai][bj][m][0], acc[ai][bj][m][1]); } }
    }
};
}

constexpr int CVT_NCHUNK_FWD = 3 * NE * 512 / 64, CVT_NCHUNK_ATT = 2 * NE * 512 / 64;
__device__ __forceinline__ void cvt_moe_chunk(const Args& a, LAS unsigned char* lds, int chunk);
namespace att {
typedef short bf16x8 __attribute__((ext_vector_type(8)));
typedef short s16x4 __attribute__((ext_vector_type(4)));
typedef float f32x16 __attribute__((ext_vector_type(16)));
constexpr int SHM_V = 16384, SHM_K = 16384, SHM_R = 8192;
constexpr int L_V = 0, L_K = 32768, L_R = 65536, L_WS = 81920, L_LUT = 83968, L_KM = 84992, L_QW = 93184, L_END = 93200;
constexpr float THR = 8.f;
#define KSWZ(row, colB) ((row) * 256 + ((colB) ^ (((row) & 7) << 4)))
#define SBAR() __builtin_amdgcn_sched_barrier(0)
__device__ __forceinline__ int v_st(int k, int c) { const int kk = (k & ~0xC) | ((k & 4) << 1) | ((k & 8) >> 1); return ((kk >> 3) * 4 + (c >> 5)) * 512 + ((kk & 7) * 32 + (c & 31)) * 2; }
__device__ __forceinline__ int v_rd_base(int lane) { return ((lane & 3) << 3) | (((lane >> 2) & 3) << 6) | (((lane >> 4) & 1) << 5) | (((lane >> 5) & 1) << 8); }
constexpr int v_rd_off(int d0, int ks, int half) { return d0 * 512 + ks * 4096 + half * 2048; }
__device__ __forceinline__ int crow(int r, int hi) { return (r & 3) + 8 * (r >> 2) + 4 * hi; }
__device__ __forceinline__ unsigned cvtpk(float lo, float hi) { unsigned r; asm volatile("v_cvt_pk_bf16_f32 %0, %1, %2" : "=v"(r) : "v"(lo), "v"(hi)); return r; }

template <int SC1000> __device__ __forceinline__ void partialSM(f32x16& p0, f32x16& p1, float& m_reg, float& alpha, float SCALE) {
    float pmax = p0[0];
#pragma unroll
    for (int r = 1; r < 16; ++r) pmax = fmaxf(pmax, p0[r]);
#pragma unroll
    for (int r = 0; r < 16; ++r) pmax = fmaxf(pmax, p1[r]);
    { auto rr = __builtin_amdgcn_permlane32_swap(__float_as_uint(pmax), __float_as_uint(pmax), false, false); pmax = fmaxf(__uint_as_float(rr[0]), __uint_as_float(rr[1])); }
    const float C2 = 1.4426950408889634f * SCALE; float mn;
    if (__builtin_expect(__all((pmax - m_reg) * SCALE <= THR), 1)) { mn = m_reg; alpha = 1.f; }
    else { mn = fmaxf(m_reg, pmax); alpha = __builtin_amdgcn_exp2f((m_reg - mn) * C2); m_reg = mn; }
    const float mnL = -mn * C2;
#pragma unroll
    for (int r = 0; r < 16; ++r) p0[r] = fmaf(p0[r], C2, mnL);
#pragma unroll
    for (int r = 0; r < 16; ++r) p1[r] = fmaf(p1[r], C2, mnL);
#pragma unroll
    for (int r = 0; r < 16; ++r) p0[r] = __builtin_amdgcn_exp2f(p0[r]);
}
__device__ __forceinline__ void finishSM(f32x16& p0, f32x16& p1, float alpha, float& l_reg, bf16x8& pa0, bf16x8& pa1, bf16x8& pa2, bf16x8& pa3) {
#pragma unroll
    for (int r = 0; r < 16; ++r) p1[r] = __builtin_amdgcn_exp2f(p1[r]);
    float ps = 0;
#pragma unroll
    for (int r = 0; r < 16; ++r) ps += p0[r];
#pragma unroll
    for (int r = 0; r < 16; ++r) ps += p1[r];
    { auto rr = __builtin_amdgcn_permlane32_swap(__float_as_uint(ps), __float_as_uint(ps), false, false); ps = __uint_as_float(rr[0]) + __uint_as_float(rr[1]); }
    l_reg = l_reg * alpha + ps;
#define PK4(P, B_, OUT) do { unsigned a0 = cvtpk(P[B_+0], P[B_+1]), a1 = cvtpk(P[B_+2], P[B_+3]);                          \
        unsigned b0 = cvtpk(P[B_+4], P[B_+5]), b1 = cvtpk(P[B_+6], P[B_+7]);                                             \
        auto r0 = __builtin_amdgcn_permlane32_swap(a0, b0, false, false); auto r1 = __builtin_amdgcn_permlane32_swap(a1, b1, false, false); \
        u32x4 w = {r0[0], r1[0], r0[1], r1[1]}; OUT = __builtin_bit_cast(bf16x8, w); } while (0)
    PK4(p0, 0, pa0); PK4(p0, 8, pa1); PK4(p1, 0, pa2); PK4(p1, 8, pa3);
#undef PK4
}
template <int KB, int NQ>
__device__ __forceinline__ void qkt(f32x16& p0, f32x16& p1, LAS const unsigned char* lds, int r32, int hi, const bf16x8* qr) {
    p0 = f32x16{}; p1 = f32x16{};
    LAS const unsigned char* kb[4];
#pragma unroll
    for (int dd = 0; dd < 4; ++dd) kb[dd] = lds + L_K + KB * SHM_K + KSWZ(r32, (dd * 16 + hi * 8) * 2);
#pragma unroll
    for (int d0 = 0; d0 < 8; ++d0) { LAS const unsigned char* p = kb[d0 & 3] + (d0 >> 2) * 128;
        const bf16x8 b0 = *(LAS const bf16x8*)p, b1 = *(LAS const bf16x8*)(p + 32 * 256);
        p0 = __builtin_amdgcn_mfma_f32_32x32x16_bf16(b0, qr[d0], p0, 0, 0, 0);
        p1 = __builtin_amdgcn_mfma_f32_32x32x16_bf16(b1, qr[d0], p1, 0, 0, 0); }
    if constexpr (NQ == 12) {
#pragma unroll
        for (int c = 0; c < 4; ++c) { LAS const unsigned char* p = lds + L_R + KB * SHM_R + r32 * 128 + ((c * 32 + hi * 16) ^ ((r32 & 7) << 4));
            const bf16x8 b0 = *(LAS const bf16x8*)p, b1 = *(LAS const bf16x8*)(p + 32 * 128);
            p0 = __builtin_amdgcn_mfma_f32_32x32x16_bf16(b0, qr[8 + c], p0, 0, 0, 0);
            p1 = __builtin_amdgcn_mfma_f32_32x32x16_bf16(b1, qr[8 + c], p1, 0, 0, 0); }
    }
}
template <int VB>
__device__ __forceinline__ void pv_tile(f32x16* o, int vb0, bf16x8 pa0, bf16x8 pa1, bf16x8 pa2, bf16x8 pa3) {
#define TRRD(dst, off) asm volatile("ds_read_b64_tr_b16 %0, %1 offset:%2" : "=&v"(dst) : "v"(vb0), "i"(off) : "memory")
#define PV_D0(d0) do { s16x4 l0, l1, l2, l3, h0, h1, h2, h3; constexpr int b_ = L_V + VB * SHM_V + v_rd_off(d0, 0, 0);   \
        TRRD(l0, b_); TRRD(h0, b_ + 2048); TRRD(l1, b_ + 4096); TRRD(h1, b_ + 6144); TRRD(l2, b_ + 8192); TRRD(h2, b_ + 10240); TRRD(l3, b_ + 12288); TRRD(h3, b_ + 14336); \
        asm volatile("s_waitcnt lgkmcnt(0)" ::: "memory"); SBAR();                                                           \
        o[d0] = __builtin_amdgcn_mfma_f32_32x32x16_bf16(pa0, (bf16x8){l0[0], l0[1], l0[2], l0[3], h0[0], h0[1], h0[2], h0[3]}, o[d0], 0, 0, 0);   \
        o[d0] = __builtin_amdgcn_mfma_f32_32x32x16_bf16(pa1, (bf16x8){l1[0], l1[1], l1[2], l1[3], h1[0], h1[1], h1[2], h1[3]}, o[d0], 0, 0, 0);   \
        o[d0] = __builtin_amdgcn_mfma_f32_32x32x16_bf16(pa2, (bf16x8){l2[0], l2[1], l2[2], l2[3], h2[0], h2[1], h2[2], h2[3]}, o[d0], 0, 0, 0);   \
        o[d0] = __builtin_amdgcn_mfma_f32_32x32x16_bf16(pa3, (bf16x8){l3[0], l3[1], l3[2], l3[3], h3[0], h3[1], h3[2], h3[3]}, o[d0], 0, 0, 0); } while (0)
    PV_D0(0); PV_D0(1); PV_D0(2); PV_D0(3);
#undef PV_D0
#undef TRRD
}

template <bool MLA>
__device__ __forceinline__ void attn_unit(const Args& a, LAS unsigned char* lds, int bh, int qt) {
    constexpr int NQ = MLA ? 12 : 8;
    constexpr float SCALE = MLA ? 0.07216878364870322f : 0.08838834764831845f;
    const int tid = tid_opaque(), wid = __builtin_amdgcn_readfirstlane(tid >> 6), lane = tid & 63, r32 = lane & 31, hi = lane >> 5;
    const int b = bh >> 3, h = bh & 7, q0 = qt * 256; const size_t rb = (size_t)b * SEQ;
    const bf16* PROJ = (const bf16*)(a.ws + WS_PROJ); const bf16* KV = (const bf16*)(a.ws + WS_KV); const bf16* QM = (const bf16*)(a.ws + WS_QM); bf16* ATT = (bf16*)(a.ws + WS_ATT);
    const bf16* Qp = MLA ? QM + (rb + q0 + wid * 32 + r32) * 1536 + h * QHD : PROJ + (rb + q0 + wid * 32 + r32) * PROJ_N + PC_QMO + h * 128;
    const int ldk = MLA ? 2048 : PROJ_N;
    const bf16* Kp = MLA ? KV + rb * 2048 + h * 256 : PROJ + rb * PROJ_N + PC_KMO + h * 128;
    const bf16* Vp = MLA ? KV + rb * 2048 + h * 256 + 128 : PROJ + rb * PROJ_N + PC_VMO + h * 128;
    const bf16* Rp = PROJ + rb * PROJ_N + PC_KR;
    bf16x8 qr[NQ];
#pragma unroll
    for (int d0 = 0; d0 < NQ; ++d0) qr[d0] = *(const bf16x8*)(Qp + d0 * 16 + hi * 8);
    LAS float* wsf = (LAS float*)(lds + L_WS) + wid * 64; LAS float* li_l = wsf; LAS float* al_l = wsf + 32;
    LAS float* LUT = (LAS float*)(lds + L_LUT); LAS float* KMl = (LAS float*)(lds + L_KM);
    unsigned selmask = 0u; float farb = 0.f;
    if constexpr (!MLA) {
        const float invs = 1.0f / SCALE;
        if (tid <= 128) LUT[tid] = a.t5[t5_bucket(tid < 128 ? tid : 128) * NH + h] * invs;
        const float* KMg = (const float*)(a.ws + WS_KMEAN) + (size_t)bh * NBLK * 128;
        for (int i = tid; i < qt * 128; i += 512) KMl[i] = KMg[i];
        farb = a.t5[31 * NH + h] * invs;
        __syncthreads();
        float g[16];
#pragma unroll
        for (int jb = 0; jb < 16; ++jb) { g[jb] = -INFINITY;
            if (jb < qt) { float s = 0.f;
#pragma unroll
                for (int d0 = 0; d0 < 8; ++d0) { const f32x4 k0 = *(LAS const f32x4*)(KMl + jb * 128 + 16 * d0 + 8 * hi), k1 = *(LAS const f32x4*)(KMl + jb * 128 + 16 * d0 + 8 * hi + 4);
                    const u32x4 qu = __builtin_bit_cast(u32x4, qr[d0]);
                    s += __uint_as_float(qu[0] << 16) * k0[0] + __uint_as_float(qu[0] & 0xffff0000u) * k0[1] + __uint_as_float(qu[1] << 16) * k0[2] + __uint_as_float(qu[1] & 0xffff0000u) * k0[3];
                    s += __uint_as_float(qu[2] << 16) * k1[0] + __uint_as_float(qu[2] & 0xffff0000u) * k1[1] + __uint_as_float(qu[3] << 16) * k1[2] + __uint_as_float(qu[3] & 0xffff0000u) * k1[3]; }
                s += __shfl_xor(s, 32); g[jb] = s; } }
        const int nsel = qt < 3 ? qt : 3;
#pragma unroll
        for (int s = 0; s < 3; ++s) if (s < nsel) { float best = -INFINITY; int bi = 0;
#pragma unroll
            for (int jb = 0; jb < 16; ++jb) { const bool ok = jb < qt && !((selmask >> jb) & 1u) && g[jb] > best; best = ok ? g[jb] : best; bi = ok ? jb : bi; }
            selmask |= 1u << bi; }
    }
    const int sr = tid >> 4, sc = (tid & 15) * 8, vst0 = v_st(sr, sc), vst1 = v_st(32 + sr, sc), kws = KSWZ(sr, sc * 2);
    const int rrow = tid >> 3, rch = tid & 7, rws = rrow * 128 + ((rch * 16) ^ ((rrow & 7) << 4));
    const int vb0 = (int)(unsigned)(uintptr_t)lds + v_rd_base(lane);
    bf16x8 st_k0, st_k1, st_v0, st_v1, st_r;
#define SLOAD(tt) do { const size_t kr_ = (size_t)((tt) * 64 + sr); st_k0 = *(const bf16x8*)(Kp + kr_ * ldk + sc); st_k1 = *(const bf16x8*)(Kp + (kr_ + 32) * ldk + sc);      \
        st_v0 = *(const bf16x8*)(Vp + kr_ * ldk + sc); st_v1 = *(const bf16x8*)(Vp + (kr_ + 32) * ldk + sc);                                                          \
        if constexpr (MLA) st_r = *(const bf16x8*)(Rp + (size_t)((tt) * 64 + rrow) * PROJ_N + rch * 8); } while (0)
#define SWRITE(bf) do { *(LAS bf16x8*)(lds + L_K + (bf) * SHM_K + kws) = st_k0; *(LAS bf16x8*)(lds + L_K + (bf) * SHM_K + kws + 32 * 256) = st_k1;                       \
        *(LAS bf16x8*)(lds + L_V + (bf) * SHM_V + vst0) = st_v0; *(LAS bf16x8*)(lds + L_V + (bf) * SHM_V + vst1) = st_v1;                                              \
        if constexpr (MLA) *(LAS bf16x8*)(lds + L_R + (bf) * SHM_R + rws) = st_r; } while (0)
    const int NTL = 4 * (qt + 1);
    const int qlo = q0 + wid * 32, qpos = qlo + r32;
    float m_reg = -1e30f, l_reg = 0.f; f32x16 o[4] = {};
    SLOAD(0); SWRITE(0);
    __syncthreads();
#define STEP(t, BUF) do {                                                                                                                                             \
        const int kbase_ = (t) * 64; const bool more_ = (t) + 1 < NTL;                                                                                               \
        if (more_) SLOAD((t) + 1);                                                                                                                                    \
        bool act_ = kbase_ <= qlo + 31;                                                                                                                               \
        bool sel_ = true;                                                                                                                                             \
        if constexpr (!MLA) { if (kbase_ < q0) { sel_ = ((selmask >> (kbase_ >> 8)) & 1u) != 0u; act_ = __any(sel_) != 0; } }                                         \
        if (act_) {                                                                                                                                                   \
            f32x16 p0, p1; float alpha; bf16x8 pa0, pa1, pa2, pa3;                                                                                                    \
            qkt<BUF, NQ>(p0, p1, lds, r32, hi, qr);                                                                                                                   \
            const int dq_ = qpos - kbase_ - 4 * hi;                                                                                                                   \
            if constexpr (!MLA) {                                                                                                                                     \
                if (kbase_ + 63 + 128 > qlo) {                                                                                                                        \
                    _Pragma("unroll") for (int r = 0; r < 16; ++r) { const int c = (r & 3) + 8 * (r >> 2); int i0 = dq_ - c, i1 = dq_ - c - 32;                       \
                        i0 = i0 < 0 ? 0 : (i0 > 128 ? 128 : i0); i1 = i1 < 0 ? 0 : (i1 > 128 ? 128 : i1); p0[r] += LUT[i0]; p1[r] += LUT[i1]; }                       \
                } else { _Pragma("unroll") for (int r = 0; r < 16; ++r) { p0[r] += farb; p1[r] += farb; } }                                                           \
                if (!sel_) { _Pragma("unroll") for (int r = 0; r < 16; ++r) { p0[r] = -INFINITY; p1[r] = -INFINITY; } }                                               \
            }                                                                                                                                                         \
            if (kbase_ + 63 > qlo) {                                                                                                                                  \
                _Pragma("unroll") for (int r = 0; r < 16; ++r) { const int c = (r & 3) + 8 * (r >> 2); if (dq_ - c < 0) p0[r] = -INFINITY; if (dq_ - c - 32 < 0) p1[r] = -INFINITY; } \
            }                                                                                                                                                         \
            partialSM<0>(p0, p1, m_reg, alpha, SCALE);                                                                                                                \
            if (__any(alpha < 1.f)) { if (hi == 0) al_l[r32] = alpha; asm volatile("s_waitcnt lgkmcnt(0)" ::: "memory");                                              \
                _Pragma("unroll") for (int d_ = 0; d_ < 4; ++d_) _Pragma("unroll") for (int r = 0; r < 16; ++r) o[d_][r] *= al_l[crow(r, hi)]; }                      \
            finishSM(p0, p1, alpha, l_reg, pa0, pa1, pa2, pa3); SBAR();                                                                                               \
            pv_tile<BUF>(o, vb0, pa0, pa1, pa2, pa3);                                                                                                                 \
        }                                                                                                                                                             \
        if (more_) SWRITE((BUF) ^ 1);                                                                                                                                 \
        __syncthreads(); } while (0)
    for (int t = 0; t < NTL; t += 2) { STEP(t, 0); STEP(t + 1, 1); }
#undef STEP
#undef SLOAD
#undef SWRITE
    if (hi == 0) li_l[r32] = l_reg;
    asm volatile("s_waitcnt lgkmcnt(0)" ::: "memory");
    bf16* Ow = ATT + (rb + q0 + wid * 32) * DM + (MLA ? 0 : 1024) + h * 128;
#pragma unroll
    for (int r = 0; r < 16; ++r) { const int orow = crow(r, hi); const float rl = __builtin_amdgcn_rcpf(li_l[orow]);
#pragma unroll
        for (int d0 = 0; d0 < 4; ++d0) { const float v = o[d0][r] * rl; const float vn = __shfl_xor(v, 1);
            if ((r32 & 1) == 0) *(unsigned*)(Ow + (size_t)orow * DM + d0 * 32 + r32) = cvtpk(v, vn); } }
}
__device__ __forceinline__ void attn_phase(const Args& a, LAS unsigned char* lds, int qi) {
    unsigned* queue = (unsigned*)(a.ws + WS_CTL) + CW_QUEUE + 64 * qi;
    volatile LAS unsigned* qw = (volatile LAS unsigned*)(lds + L_QW);
    for (;;) {
        if (threadIdx.x == 0) qw[0] = __hip_atomic_fetch_add(queue, 1u, __ATOMIC_RELAXED, __HIP_MEMORY_SCOPE_AGENT);
        __syncthreads();
        const unsigned u = (unsigned)__builtin_amdgcn_readfirstlane((int)qw[0]);
        __syncthreads();
        if (u >= 512u + (unsigned)CVT_NCHUNK_ATT) break;
        static_assert(CVT_NCHUNK_ATT == 512, "queue interleave assumes as many w1/w3 chunks as attention units");
        if (u & 1u) { cvt_moe_chunk(a, lds, (int)(u >> 1)); continue; }
        const unsigned ua = u >> 1;
        const int cls = (int)(ua >> 4), bh = (int)(ua & 15u);
        const unsigned tybits = 0x54aa552fu;
        const int qts[32] = {15,14,13,12,15,11,14,13,10,12,9,11,8,10,7,9,8,6,7,5,6,4,5,3,4,3,2,2,1,1,0,0};
        int qt = 0;
#pragma unroll
        for (int c = 0; c < 32; ++c) qt = (cls == c) ? qts[c] : qt;
        if ((tybits >> cls) & 1u) attn_unit<true>(a, lds, bh, qt); else attn_unit<false>(a, lds, bh, qt);
    }
}
#undef KSWZ
#undef SBAR
}

constexpr int RING_OFF = 0, RING_BYTES = 131072, SCR_OFF = 131072, MISC_OFF = 139264, LDS_BYTES = 147456;
constexpr int CW_BAR = 4096;
#define LDS_WAIT() asm volatile("s_waitcnt lgkmcnt(0)" ::: "memory")

#define XB_TMO      128
#define XB_XCNT(j)  (256  + 64 * (j))
#define XB_XSUB(j)  (1280 + 64 * (j))
#define XB_XGEN(j)  (2304 + 64 * (j))
#define XB_TOP      3328
#define XB_TOPGEN   3392
#define XCD_BAR_WORDS 3456
#define XB_SPIN_CAP (1u << 18)

__device__ __forceinline__ unsigned xb_ld(unsigned* p)              { return __hip_atomic_load(p, __ATOMIC_RELAXED, __HIP_MEMORY_SCOPE_AGENT); }
__device__ __forceinline__ unsigned xb_add(unsigned* p, unsigned v) { return __hip_atomic_fetch_add(p, v, __ATOMIC_RELAXED, __HIP_MEMORY_SCOPE_AGENT); }
__device__ __forceinline__ unsigned xb_xcc_id() { return (unsigned)__builtin_amdgcn_s_getreg((3 << 11) | 20) & 0xFu; }
#define XB_SPIN(cond, bar) do { unsigned _sp = 0; while (cond) { __builtin_amdgcn_s_sleep(1); \
    if ((++_sp & 255u) == 0u) { if (xb_ld(&(bar)[XB_TMO])) break; if (_sp > XB_SPIN_CAP) { atomicAdd(&(bar)[XB_TMO], 1u); break; } } } } while (0)

struct XcdBarrier {
    unsigned* bar; unsigned x;
    volatile LAS unsigned* st;
};
__device__ __forceinline__ XcdBarrier xcd_barrier_post(unsigned* bar, volatile LAS unsigned* st) {
    XcdBarrier b; b.bar = bar; b.x = xb_xcc_id(); b.st = st;
    if (threadIdx.x == 0) (void)xb_add(&bar[XB_XCNT(b.x)], 1u);
    return b;
}
__device__ __forceinline__ void xcd_barrier_complete(unsigned* bar, unsigned x, unsigned& nloc, unsigned& nx) {
    const unsigned G = gridDim.x * gridDim.y * gridDim.z;
    unsigned sum, cnt, mine, sp = 0u;
    for (;;) {
        sum = 0u; cnt = 0u; mine = 0u;
#pragma unroll
        for (unsigned j = 0; j < 16; ++j) { const unsigned c = xb_ld(&bar[XB_XCNT(j)]); sum += c; cnt += (c > 0u) ? 1u : 0u; mine = (j == x) ? c : mine; }
        if (sum == G) break;
        __builtin_amdgcn_s_sleep(1);
        if ((++sp & 255u) == 0u) { if (xb_ld(&bar[XB_TMO])) break; if (sp > XB_SPIN_CAP) { atomicAdd(&bar[XB_TMO], 1u); break; } }
    }
    nloc = mine > 0u ? mine : 1u; nx = cnt > 0u ? cnt : 1u;
}
__device__ __forceinline__ void xcd_barrier(const XcdBarrier& b) {
    asm volatile("s_waitcnt vmcnt(0)" ::: "memory");
    __syncthreads();
    if (threadIdx.x == 0) {
        unsigned* bar = b.bar;
        __builtin_amdgcn_s_waitcnt(0);
        unsigned nloc = b.st[0], nx = b.st[1];
        if (nloc == 0u) { xcd_barrier_complete(bar, b.x, nloc, nx); b.st[0] = nloc; b.st[1] = nx; }
        const unsigned old = xb_add(&bar[XB_XSUB(b.x)], 1u);
        const unsigned gen = old / nloc;
        if (old + 1u == (gen + 1u) * nloc) {
            __builtin_amdgcn_fence(__ATOMIC_RELEASE, "agent");
            asm volatile("s_waitcnt vmcnt(0)" ::: "memory");
            const unsigned og = xb_add(&bar[XB_TOP], 1u);
            const unsigned tg = og / nx;
            if (og + 1u == (tg + 1u) * nx) xb_add(&bar[XB_TOPGEN], 1u);
            else XB_SPIN(xb_ld(&bar[XB_TOPGEN]) == tg, bar);
            __builtin_amdgcn_fence(__ATOMIC_ACQUIRE, "agent");
            xb_add(&bar[XB_XGEN(b.x)], 1u);
            asm volatile("s_waitcnt vmcnt(0)" ::: "memory");
        } else {
            XB_SPIN(xb_ld(&bar[XB_XGEN(b.x)]) == gen, bar);
            __builtin_amdgcn_fence(__ATOMIC_ACQUIRE, "agent");
            asm volatile("s_waitcnt vmcnt(0)" ::: "memory");
        }
    }
    __syncthreads();
}

struct CvtRegs { f32x4 a[4][2]; };
__device__ __forceinline__ void cvt_load(CvtRegs& v, const float* W, int ldw, int kb, int nb, int lane) {
    const float* p = W + (size_t)(64 * kb + 4 * (lane & 15)) * ldw + 32 * nb + 8 * (lane >> 4);
#pragma unroll
    for (int r = 0; r < 4; ++r) { v.a[r][0] = *(const f32x4*)(p + (size_t)r * ldw); v.a[r][1] = *(const f32x4*)(p + (size_t)r * ldw + 4); }
}
template <class RM> __device__ __forceinline__ void cvt_store(const CvtRegs& v, bf16* WT, int ldt, int kb, int nb, int lane, const float* gain, const RM& rm) {
    const int k0 = 64 * kb + 4 * (lane & 15), n0 = 32 * nb + 8 * (lane >> 4);
    float g[4];
#pragma unroll
    for (int r = 0; r < 4; ++r) g[r] = gain ? gain[k0 + r] : 1.0f;
#pragma unroll
    for (int c = 0; c < 8; ++c) { u32x2 o; o.x = pk2(v.a[0][c >> 2][c & 3] * g[0], v.a[1][c >> 2][c & 3] * g[1]); o.y = pk2(v.a[2][c >> 2][c & 3] * g[2], v.a[3][c >> 2][c & 3] * g[3]);
        *(u32x2*)(WT + (size_t)rm(n0 + c) * ldt + k0) = o; }
}
template <class RM> __device__ __forceinline__ void cvt_item(const float* W, int ldw, bf16* WT, int ldt, LAS float*, int kb, int nb, int lane, const float* gain, const RM& rm) {
    CvtRegs v; cvt_load(v, W, ldw, kb, nb, lane); cvt_store(v, WT, ldt, kb, nb, lane, gain, rm);
}
struct RmId { int base; __device__ __forceinline__ int operator()(int n) const { return base + n; } };
struct RmWin { __device__ __forceinline__ int operator()(int n) const { return n < 768 ? n : (n < 832 ? 768 + 2 * ((n - 768) & 31) + ((n - 768) >> 5) : n + 192); } };
struct RmUq { __device__ __forceinline__ int operator()(int n) const { const int h = n / QHD, j = n % QHD; return j < 128 ? n : h * QHD + 128 + 2 * ((j - 128) & 31) + ((j - 128) >> 5); } };
struct RmW13 { int base; __device__ __forceinline__ int operator()(int f) const { return base + (f >> 7) * 256 + (f & 127); } };
constexpr int CVT_MOE_ITEMS = 3 * NE * 512, CVT_CHUNK = 64, CVT_NCHUNK = CVT_MOE_ITEMS / CVT_CHUNK;
static_assert(CVT_NCHUNK == CVT_NCHUNK_FWD, "chunk count");
__device__ __forceinline__ void cvt_moe_load(const Args& a, CvtRegs& v, int r, int lane) {
    const int which = r >> 14, e = (r >> 9) & 31, q = r & 511;
    if (which == 0) cvt_load(v, a.w1 + (size_t)e * DM * FF, FF, q >> 4, q & 15, lane);
    else if (which == 1) cvt_load(v, a.w3 + (size_t)e * DM * FF, FF, q >> 4, q & 15, lane);
    else cvt_load(v, a.w2 + (size_t)e * FF * DM, DM, q >> 6, q & 63, lane);
}
__device__ __forceinline__ void cvt_moe_store(const Args& a, const CvtRegs& v, int r, int lane) {
    bf16* W13 = (bf16*)(a.ws + WS_W13); bf16* W2 = (bf16*)(a.ws + WS_W2);
    const int which = r >> 14, e = (r >> 9) & 31, q = r & 511;
    if (which == 0) cvt_store(v, W13, DM, q >> 4, q & 15, lane, nullptr, RmW13{e * 1024});
    else if (which == 1) cvt_store(v, W13, DM, q >> 4, q & 15, lane, nullptr, RmW13{e * 1024 + 128});
    else cvt_store(v, W2, FF, q >> 6, q & 63, lane, nullptr, RmId{e * DM});
}
__device__ __forceinline__ void cvt_moe_chunk(const Args& a, LAS unsigned char* lds, int chunk) {
    (void)lds;
    const int tid = tid_opaque(), lane = tid & 63, w = __builtin_amdgcn_readfirstlane(tid >> 6);
    const int r0 = chunk * CVT_CHUNK + w * (CVT_CHUNK / 8);
    CvtRegs va, vb;
    cvt_moe_load(a, va, r0, lane);
#pragma unroll 1
    for (int i = 0; i < CVT_CHUNK / 8; i += 2) {
        cvt_moe_load(a, vb, r0 + i + 1, lane);
        cvt_moe_store(a, va, r0 + i, lane);
        if (i + 2 < CVT_CHUNK / 8) cvt_moe_load(a, va, r0 + i + 2, lane);
        cvt_moe_store(a, vb, r0 + i + 1, lane);
    }
}
__device__ __forceinline__ void ph_convert(const Args& a, LAS unsigned char* lds, int wg, int nwg) {
    const int tid = tid_opaque(), lane = tid & 63, w = __builtin_amdgcn_readfirstlane(tid >> 6), gw = wg * 8 + w, NGW = nwg * 8;
    LAS float* scr = (LAS float*)(lds + w * 8448);
    bf16* WIN = (bf16*)(a.ws + WS_WIN); bf16* WUQ = (bf16*)(a.ws + WS_WUQ); bf16* WUKV = (bf16*)(a.ws + WS_WUKV); bf16* WOUT = (bf16*)(a.ws + WS_WOUT);
    constexpr int I_WIN = 32 * 122, I_WOUT = 32 * 64, I_WUQ = 8 * 48, I_WUKV = 4 * 64;
    constexpr int NITEMS = I_WIN + I_WOUT + I_WUQ + I_WUKV;
    for (int it = gw; it < NITEMS; it += NGW) {
        int r = it;
        if (r < I_WIN) { cvt_item(a.w_in, INCOLS, WIN, DM, scr, r / 122, r % 122, lane, nullptr, RmWin{}); continue; } r -= I_WIN;
        if (r < I_WOUT) { cvt_item(a.w_out, DM, WOUT, DM, scr, r >> 6, r & 63, lane, nullptr, RmId{0}); continue; } r -= I_WOUT;
        if (r < I_WUQ) { cvt_item(a.w_uq, 1536, WUQ, QR, scr, r / 48, r % 48, lane, a.qg, RmUq{}); continue; } r -= I_WUQ;
        cvt_item(a.w_ukv, 2048, WUKV, KVR, scr, r >> 6, r & 63, lane, a.kvg, RmId{0});
    }
    for (int i = wg * 512 + tid; i < 192 * DM / 8; i += nwg * 512) *(u32x4*)(WIN + (size_t)832 * DM + (size_t)i * 8) = (u32x4){0u, 0u, 0u, 0u};
    bf16* WRH = (bf16*)(a.ws + WS_WR); bf16* WRL = WRH + 48 * DM;
    for (int i = wg * 512 + tid; i < 48 * DM; i += nwg * 512) { const int n = i / DM, k = i % DM;
        const float v = n < 32 ? a.w_re[(size_t)k * 32 + n] : (n < 36 ? a.w_rg[(size_t)k * 4 + n - 32] : 0.f);
        const unsigned hb = f2bf(v); WRH[i] = (bf16)hb; WRL[i] = (bf16)f2bf(v - bf2f(hb)); }
}

#ifndef MK_REP
#define MK_REP 0
#endif
struct MArgs { Args a; int ph_lo, ph_hi, li, pad; };
__global__ void __launch_bounds__(512, 2) mega(MArgs m) {
    extern __shared__ __attribute__((aligned(16))) unsigned char lds_[];
    LAS unsigned char* lds = (LAS unsigned char*)lds_;
    volatile LAS unsigned* MISC = (volatile LAS unsigned*)(lds + MISC_OFF);
    const Args& a = m.a;
    const int tid = threadIdx.x, wg = blockIdx.x, nwg = gridDim.x;
    unsigned* ctl = (unsigned*)(a.ws + WS_CTL);
    if (tid < 64) MISC[tid] = 0u;
    __syncthreads();
    XcdBarrier bar = xcd_barrier_post(ctl + CW_BAR + m.li * XCD_BAR_WORDS, MISC + 8);
    const int lo = m.ph_lo, hi = m.ph_hi;
#define IN(k) (lo <= (k) && (k) < hi)
#define SEAM(k) do { if (IN(k) && IN((k) + 1)) xcd_barrier(bar); } while (0)
#define REPEAT(k) _Pragma("unroll") for (int rep_ = 0; rep_ < 1 + ((MK_REP >> (k)) & 1); ++rep_)
#define REP_BAR() do { if (rep_) xcd_barrier(bar); } while (0)
    unsigned char* ws = a.ws;
    const float* RT = (const float*)(ws + WS_ROPE); float* SS = (float*)(ws + WS_SS); const int* LIST = (const int*)(ws + WS_LIST);
    const unsigned* CNT = (const unsigned*)(ws + WS_CTL) + CW_CNT;

    if (IN(0)) REPEAT(0) { REP_BAR(); ph_mod(a, (LAS float*)(lds + SCR_OFF - 24576), wg, nwg); __syncthreads(); ph_rope_table(a, wg, nwg); ph_convert(a, lds, wg, nwg); }
    SEAM(0);
    if (IN(1)) REPEAT(1) { REP_BAR(); ph_ln0(a, wg, nwg); }
    SEAM(1);
    if (IN(2)) REPEAT(2) { REP_BAR();
        pg8::Gemm g{(const bf16*)(ws + WS_H), (const bf16*)(ws + WS_WIN), DM, DM, DM}; pg8::StaticOrder S; S.init(NT, PROJ_N, nwg, wg);
        pg8::EpiProj E{(bf16*)(ws + WS_PROJ), RT, SS};
        pg8::gemm_phase<pg8::EpiProj, pg8::StaticOrder, pg8::ADense, true>(lds + RING_OFF, g, S, pg8::ADense{DM}, E);
    }
    SEAM(2);
    if (IN(3)) REPEAT(3) { REP_BAR();
        ph_kmean(a, wg, nwg);
        {
            pg8::Gemm g{(const bf16*)(ws + WS_PROJ), (const bf16*)(ws + WS_WUQ), QR, PROJ_N, QR}; pg8::StaticOrder S; S.init(NT, 1536, nwg, wg);
            pg8::EpiQ E{(bf16*)(ws + WS_QM), RT, SS};
            pg8::gemm_phase<pg8::EpiQ, pg8::StaticOrder, pg8::ADense, true>(lds + RING_OFF, g, S, pg8::ADense{PROJ_N}, E);
        }
        {
            pg8::Gemm g{(const bf16*)(ws + WS_PROJ) + QR, (const bf16*)(ws + WS_WUKV), KVR, PROJ_N, KVR}; pg8::StaticOrder S; S.init(NT, 2048, nwg, wg);
            pg8::EpiKV E{(bf16*)(ws + WS_KV), SS};
            pg8::gemm_phase<pg8::EpiKV, pg8::StaticOrder, pg8::ADense, true>(lds + RING_OFF, g, S, pg8::ADense{PROJ_N}, E);
        }
    }
    SEAM(3);
    if (IN(4)) REPEAT(4) { REP_BAR(); att::attn_phase(a, lds, rep_); }
    SEAM(4);
    if (IN(5)) REPEAT(5) { REP_BAR();
        pg8::Gemm g{(const bf16*)(ws + WS_ATT), (const bf16*)(ws + WS_WOUT), DM, DM, DM}; pg8::StaticOrder S; S.init(NT, DM, nwg, wg);
        pg8::EpiOut E{(bf16*)(ws + WS_KV)};
        pg8::gemm_phase<pg8::EpiOut, pg8::StaticOrder, pg8::ADense, true>(lds + RING_OFF, g, S, pg8::ADense{DM}, E);
    }
    SEAM(5);
    if (IN(6)) ph_ln1_route(a, lds, wg, nwg);
    SEAM(6);
    if (IN(7)) REPEAT(7) { REP_BAR();
        pg8::Gemm g{(const bf16*)(ws + WS_H), (const bf16*)(ws + WS_W13), DM, DM, DM}; pg8::MoeOrder S{CNT, 4, nwg, wg};
        pg8::EpiMoe1 E{(bf16*)(ws + WS_QM), LIST, (const float*)(ws + WS_ROUTE + 65536)};
        pg8::gemm_phase<pg8::EpiMoe1, pg8::MoeOrder, pg8::AGather, true>(lds + RING_OFF, g, S, pg8::AGather{LIST, DM}, E);
        {   unsigned* queue = ctl + CW_QUEUE + 64 * (2 + rep_); volatile LAS unsigned* qw = (volatile LAS unsigned*)(lds + SCR_OFF);
            for (;;) {
                if (tid == 0) qw[0] = __hip_atomic_fetch_add(queue, 1u, __ATOMIC_RELAXED, __HIP_MEMORY_SCOPE_AGENT);
                __syncthreads();
                const unsigned u = (unsigned)__builtin_amdgcn_readfirstlane((int)qw[0]);
                __syncthreads();
                if (u >= (unsigned)(CVT_NCHUNK_FWD - CVT_NCHUNK_ATT)) break;
                cvt_moe_chunk(a, lds, CVT_NCHUNK_ATT + (int)u);
            } }
    }
    SEAM(7);
    if (IN(8)) REPEAT(8) { REP_BAR();
        pg8::Gemm g{(const bf16*)(ws + WS_QM), (const bf16*)(ws + WS_W2), FF, FF, FF}; pg8::MoeOrder S{CNT, 8, nwg, wg};
        pg8::EpiMoe2 E{(bf16*)(ws + WS_PROJ), LIST};
        pg8::gemm_phase<pg8::EpiMoe2, pg8::MoeOrder, pg8::ADense, true>(lds + RING_OFF, g, S, pg8::ADense{FF}, E);
    }
    SEAM(8);
    if (IN(9)) REPEAT(9) { REP_BAR(); ph_final(a, wg, nwg); }
#undef IN
#undef SEAM
#undef REPEAT
#undef REP_BAR
}

static const int USE_MEGA[10] = {1, 1, 1, 1, 1, 1, 1, 1, 1, 1};
extern "C" void kernel_launch(void* const* d_in, const int* in_sizes, int n_in, void* d_out, int out_size, void* d_ws, size_t ws_size, hipStream_t stream) {
    if (n_in != 22 || in_sizes[0] != NT * DM || out_size != NT * DM || ws_size < WS_END) { fprintf(stderr, "kernel_launch: unexpected shapes (n_in %d, in0 %d, out %d, ws %zu)\n", n_in, n_in > 0 ? in_sizes[0] : -1, out_size, ws_size); return; }
    Args a{};
    const float** ap = (const float**)&a;
    for (int i = 0; i < 22; ++i) ap[i] = (const float*)d_in[i];
    a.out = (float*)d_out; a.ws = (unsigned char*)d_ws;
    unsigned char* ws = a.ws;
    static int grid = 0;
    if (!grid) {
        (void)hipFuncSetAttribute((const void*)k_thin<6>, hipFuncAttributeMaxDynamicSharedMemorySize, P6_LDS);
        (void)hipFuncSetAttribute((const void*)mega, hipFuncAttributeMaxDynamicSharedMemorySize, LDS_BYTES);
        int dev = 0, cus = 0; (void)hipGetDevice(&dev); (void)hipDeviceGetAttribute(&cus, hipDeviceAttributeMultiprocessorCount, dev);
        grid = cus > 0 ? cus : 256;
    }
    (void)hipMemsetAsync(ws + WS_CTL, 0, CTL_ZERO_BYTES, stream);
    const unsigned* cnt = (const unsigned*)(ws + WS_CTL) + CW_CNT;
    int li = 0;
    for (int p = 0; p < 10;) {
        if (USE_MEGA[p]) { int q = p; while (q < 10 && USE_MEGA[q]) ++q;
            MArgs m{}; m.a = a; m.ph_lo = p; m.ph_hi = q; m.li = li++; m.pad = 0;
            hipLaunchKernelGGL(mega, dim3(grid), dim3(512), LDS_BYTES, stream, m);
            p = q; continue; }
        switch (p) {
        case 0: k_thin<0><<<256, 512, 32768, stream>>>(a); break;
        case 1: k_thin<1><<<256, 512, 0, stream>>>(a); break;
        case 2: nk_gemm<FProj><<<dim3(INCOLS / 64, NT / 64, 1), 256, 0, stream>>>(FProj{(const bf16*)(ws + WS_H), a.w_in, (float*)(ws + WS_W13)}, DM);
                nk_epi_proj<<<NT, 256, 0, stream>>>(a); break;
        case 3: nk_gemm<FQ><<<dim3(1536 / 64, NT / 64, 1), 256, 0, stream>>>(FQ{(const bf16*)(ws + WS_PROJ), a.w_uq, a.qg, (float*)(ws + WS_W13)}, QR);
                nk_epi_q<<<NT, 256, 0, stream>>>(a);
                nk_gemm<FKV><<<dim3(2048 / 64, NT / 64, 1), 256, 0, stream>>>(FKV{(const bf16*)(ws + WS_PROJ), a.w_ukv, a.kvg, (const float*)(ws + WS_SS), (bf16*)(ws + WS_KV)}, KVR);
                k_thin<3><<<256, 512, 0, stream>>>(a); break;
        case 4: nk_attn_mla<<<dim3(SEQ / 2, NH, NB), 128, 0, stream>>>(a);
                nk_attn_moba<<<dim3(SEQ / 4, NH, NB), 256, 0, stream>>>(a); break;
        case 5: nk_gemm<FOut><<<dim3(DM / 64, NT / 64, 1), 256, 0, stream>>>(FOut{(const bf16*)(ws + WS_ATT), a.w_out, (bf16*)(ws + WS_KV)}, DM); break;
        case 6: k_thin<6><<<256, 512, P6_LDS, stream>>>(a); break;
        case 7: nk_gemm<FMoe1><<<dim3(1024 / 64, NT / 64, NE), 256, 0, stream>>>(FMoe1{(const bf16*)(ws + WS_H), a.w1, a.w3, cnt, (const int*)(ws + WS_LIST), (float*)(ws + WS_W13)}, DM);
                nk_epi_moe1<<<dim3(NE, NT / 64), 256, 0, stream>>>(a); break;
        case 8: nk_gemm<FMoe2><<<dim3(DM / 64, NT / 64, NE), 256, 0, stream>>>(FMoe2{(const bf16*)(ws + WS_QM), a.w2, cnt, (const int*)(ws + WS_LIST), (bf16*)(ws + WS_PROJ)}, FF); break;
        case 9: k_thin<9><<<256, 512, 0, stream>>>(a); break;
        }
        ++p;
    }
}
```

```cpp
#include <hip/hip_runtime.h>
#include <cstdio>
#include <cstdint>

#define LAS __attribute__((address_space(3)))
typedef unsigned short bf16;
typedef float f32x4 __attribute__((ext_vector_type(4)));
typedef unsigned u32x4 __attribute__((ext_vector_type(4)));
typedef unsigned u32x2 __attribute__((ext_vector_type(2)));

constexpr int NB = 2, SEQ = 4096, DM = 2048, NT = NB * SEQ;
constexpr int QR = 512, KVR = 256, NH = 8, QHD = 192, MBLK = 256, NBLK = 16;
constexpr int INCOLS = 3904, PROJ_N = 4096, MODN = 6 * DM;
constexpr int NE = 32, FF = 512;
constexpr float LN_EPS = 1e-5f, RMS_EPS = 1e-6f;
constexpr float ALPHA = 1.189207115002721f;
constexpr int MOD_SH1 = 0, MOD_SC1 = DM, MOD_G1 = 2 * DM, MOD_SH2 = 3 * DM, MOD_SC2 = 4 * DM, MOD_G2 = 5 * DM;
constexpr int PC_KR = 768, PC_QMO = 1024, PC_KMO = 2048, PC_VMO = 3072;

constexpr size_t MiB = 1u << 20;
constexpr size_t WS_CTL = 0, CTL_ZERO_BYTES = 256 * 1024;
constexpr size_t WS_MOD = 1 * MiB;
constexpr size_t WS_ROPE = 2 * MiB;
constexpr size_t WS_KMEAN = 3 * MiB;
constexpr size_t WS_SS = 3 * MiB + 512 * 1024;
constexpr size_t WS_ROUTE = 4 * MiB;
constexpr size_t WS_LIST = 5 * MiB;
constexpr size_t WS_WIN = 8 * MiB;
constexpr size_t WS_WUQ = 24 * MiB;
constexpr size_t WS_WUKV = 26 * MiB;
constexpr size_t WS_WOUT = 28 * MiB;
constexpr size_t WS_WR = 36 * MiB;
constexpr size_t WS_W13 = 40 * MiB;
constexpr size_t WS_W2 = 168 * MiB;
constexpr size_t WS_H = 232 * MiB;
constexpr size_t WS_PROJ = 264 * MiB;
constexpr size_t WS_QM = 328 * MiB;
constexpr size_t WS_KV = 352 * MiB;
constexpr size_t WS_ATT = 384 * MiB;
constexpr size_t WS_X1 = 416 * MiB;
constexpr size_t WS_END = 480 * MiB;
constexpr int CW_CNT = 64;
constexpr int CW_QUEUE = 128;
constexpr int CW_MODCNT = 1024;

__device__ __forceinline__ unsigned f2bf(float f) { unsigned u = __builtin_bit_cast(unsigned, f); return (u + 0x7fffu + ((u >> 16) & 1u)) >> 16; }
__device__ __forceinline__ float bf2f(unsigned b) { return __builtin_bit_cast(float, b << 16); }
__device__ __forceinline__ unsigned pk2(float lo, float hi) { return f2bf(lo) | (f2bf(hi) << 16); }
__device__ __forceinline__ float wave_sum(float v) {
#pragma unroll
    for (int o = 1; o < 64; o <<= 1) v += __shfl_xor(v, o);
    return v;
}
__device__ __forceinline__ float wave_max(float v) {
#pragma unroll
    for (int o = 1; o < 64; o <<= 1) v = fmaxf(v, __shfl_xor(v, o));
    return v;
}
__device__ __forceinline__ int tid_opaque() { int t = threadIdx.x; asm volatile("" : "+v"(t)); return t; }
__device__ __forceinline__ float silu_f(float v) { return v / (1.f + __expf(-v)); }
__device__ __forceinline__ int t5_bucket(int n) {
    if (n < 16) return n;
    int l = 16 + (int)(logf((float)n / 16.f) / 2.0794415416798357f * 16.f);
    return l < 31 ? l : 31;
}
__device__ __forceinline__ int moe_rowbase(const unsigned* cnt, int e) { int s = 0; for (int i = 0; i < e; ++i) s += (int)((cnt[i] + 255u) >> 8) << 8; return s; }

struct Args {
    const float *x, *c, *w_ada, *b_ada, *w_in, *qg, *w_uq, *kvg, *w_ukv, *w_out, *t5, *ln1g, *ln1b, *w_rg, *b_rg, *w_re, *b_re, *w1, *w3, *w2, *ln2g, *ln2b;
    float* out; unsigned char* ws;
};


__device__ __forceinline__ void ph_mod(const Args& a, LAS float* sm, int wg, int nwg) {
    const int tid = tid_opaque(), lane = tid & 63, w = __builtin_amdgcn_readfirstlane(tid >> 6);
    float* MOD = (float*)(a.ws + WS_MOD);
    LAS float* sc = sm;
    LAS float* red = sm + 2 * DM;
    if (wg >= 192) return;
    for (int i = tid; i < 2 * DM; i += 512) sc[i] = silu_f(a.c[i]);
    __syncthreads();
    for (int cg = wg; cg < 192; cg += nwg) {
        const int c4 = lane & 15, ksub = lane >> 4, col = cg * 64 + 4 * c4;
        f32x4 a0 = {0.f, 0.f, 0.f, 0.f}, a1 = {0.f, 0.f, 0.f, 0.f};
#pragma unroll 8
        for (int it = 0; it < 64; ++it) {
            const int k = w * 256 + it * 4 + ksub;
            const f32x4 wv = *(const f32x4*)(a.w_ada + (size_t)k * MODN + col);
            a0 += wv * sc[k]; a1 += wv * sc[DM + k];
        }
#pragma unroll
        for (int j = 0; j < 4; ++j) { a0[j] += __shfl_xor(a0[j], 16); a0[j] += __shfl_xor(a0[j], 32); a1[j] += __shfl_xor(a1[j], 16); a1[j] += __shfl_xor(a1[j], 32); }
        if (ksub == 0) {
#pragma unroll
            for (int j = 0; j < 4; ++j) { red[(w * 2 + 0) * 64 + 4 * c4 + j] = a0[j]; red[(w * 2 + 1) * 64 + 4 * c4 + j] = a1[j]; }
        }
        __syncthreads();
        if (tid < 128) { const int b = tid >> 6, cc = tid & 63; float s = 0.f;
#pragma unroll
            for (int ww = 0; ww < 8; ++ww) s += red[(ww * 2 + b) * 64 + cc];
            __hip_atomic_store((unsigned*)MOD + b * MODN + cg * 64 + cc, __float_as_uint(s + a.b_ada[cg * 64 + cc]), __ATOMIC_RELAXED, __HIP_MEMORY_SCOPE_AGENT); }
        asm volatile("s_waitcnt vmcnt(0)" ::: "memory");
        __syncthreads();
        if (tid == 0) __hip_atomic_fetch_add((unsigned*)(a.ws + WS_CTL) + CW_MODCNT, 1u, __ATOMIC_RELAXED, __HIP_MEMORY_SCOPE_AGENT);
    }
}
__device__ __forceinline__ void wait_mod(const Args& a) {
    if (tid_opaque() == 0) {
        unsigned* c = (unsigned*)(a.ws + WS_CTL) + CW_MODCNT; unsigned sp = 0;
        while (__hip_atomic_load(c, __ATOMIC_RELAXED, __HIP_MEMORY_SCOPE_AGENT) < 192u) { __builtin_amdgcn_s_sleep(2); if (++sp > (1u << 22)) { __hip_atomic_store((unsigned*)(a.ws + WS_CTL), 1u, __ATOMIC_RELAXED, __HIP_MEMORY_SCOPE_AGENT); break; } }
        __builtin_amdgcn_fence(__ATOMIC_ACQUIRE, "agent");
        asm volatile("s_waitcnt vmcnt(0)" ::: "memory");
    }
    __syncthreads();
}
__device__ __forceinline__ void ph_rope_table(const Args& a, int wg, int nwg) {
    float* RT = (float*)(a.ws + WS_ROPE);
    for (int idx = wg * 512 + tid_opaque(); idx < SEQ * 32; idx += nwg * 512) {
        const int pos = idx >> 5, i = idx & 31;
        const float inv = 1.0f / powf(10000.0f, (float)(2 * i) / 64.0f);
        const float ang = (float)pos * inv;
        const double ad = (double)ang, q = rint(ad * 0.6366197723675814), r = ad - q * 1.5707963267948966;
        const int qi = ((int)q) & 3; const float rf = (float)r, r2 = rf * rf;
        const float s = rf * (1.f + r2 * (-1.6666667e-1f + r2 * (8.3333333e-3f + r2 * (-1.9841270e-4f + r2 * 2.7557319e-6f))));
        const float c = 1.f + r2 * (-0.5f + r2 * (4.1666667e-2f + r2 * (-1.3888889e-3f + r2 * (2.4801587e-5f + r2 * (-2.7557319e-7f)))));
        float cs, sn;
        if (qi == 0) { cs = c; sn = s; } else if (qi == 1) { cs = -s; sn = c; } else if (qi == 2) { cs = -c; sn = -s; } else { cs = s; sn = -c; }
        RT[2 * idx] = cs; RT[2 * idx + 1] = sn;
    }
}
__device__ __forceinline__ void ph_ln0(const Args& a, int wg, int nwg) {
    const int tid = tid_opaque(), lane = tid & 63, gw = wg * 8 + __builtin_amdgcn_readfirstlane(tid >> 6), NGW = nwg * 8;
    const float* MOD = (const float*)(a.ws + WS_MOD); bf16* H = (bf16*)(a.ws + WS_H);
    for (int b = 0; b < NB; ++b) {
        f32x4 sc[8], sh[8];
#pragma unroll
        for (int j = 0; j < 8; ++j) { sc[j] = *(const f32x4*)(MOD + b * MODN + MOD_SC1 + 4 * lane + 256 * j) + 1.0f; sh[j] = *(const f32x4*)(MOD + b * MODN + MOD_SH1 + 4 * lane + 256 * j); }
        for (int r = gw; r < SEQ; r += NGW) {
            const size_t row = (size_t)b * SEQ + r;
            const float* xr = a.x + row * DM + 4 * lane;
            f32x4 v[8]; float s = 0.f;
#pragma unroll
            for (int j = 0; j < 8; ++j) { v[j] = *(const f32x4*)(xr + 256 * j); s += (v[j][0] + v[j][1]) + (v[j][2] + v[j][3]); }
            const float mean = wave_sum(s) * (1.f / DM); float s2 = 0.f;
#pragma unroll
            for (int j = 0; j < 8; ++j) { v[j] = v[j] - mean; s2 += (v[j][0] * v[j][0] + v[j][1] * v[j][1]) + (v[j][2] * v[j][2] + v[j][3] * v[j][3]); }
            const float rstd = 1.0f / sqrtf(wave_sum(s2) * (1.f / DM) + LN_EPS);
            bf16* hr = H + row * DM + 4 * lane;
#pragma unroll
            for (int j = 0; j < 8; ++j) { const f32x4 o = v[j] * rstd * sc[j] + sh[j]; u32x2 w; w.x = pk2(o[0], o[1]); w.y = pk2(o[2], o[3]); *(u32x2*)(hr + 256 * j) = w; }
        }
    }
}
__device__ __forceinline__ void ph_kmean(const Args& a, int wg, int nwg) {
    const int tid = tid_opaque(), lane = tid & 63, gw = wg * 8 + __builtin_amdgcn_readfirstlane(tid >> 6), NGW = nwg * 8;
    const bf16* PROJ = (const bf16*)(a.ws + WS_PROJ); float* KM = (float*)(a.ws + WS_KMEAN);
    for (int t = gw; t < 16 * NBLK; t += NGW) {
        const int bh = t >> 4, blk = t & 15, b = bh >> 3, h = bh & 7, rs = lane >> 4, c8 = lane & 15;
        const bf16* p = PROJ + ((size_t)b * SEQ + blk * MBLK + rs) * PROJ_N + PC_KMO + h * 128 + 8 * c8;
        float s[8];
#pragma unroll
        for (int j = 0; j < 8; ++j) s[j] = 0.f;
#pragma unroll 16
        for (int it = 0; it < 64; ++it) { const u32x4 u = *(const u32x4*)(p + (size_t)(4 * it) * PROJ_N);
#pragma unroll
            for (int j = 0; j < 4; ++j) { s[2 * j] += bf2f(u[j] & 0xffffu); s[2 * j + 1] += bf2f(u[j] >> 16); } }
#pragma unroll
        for (int j = 0; j < 8; ++j) { s[j] += __shfl_xor(s[j], 16); s[j] += __shfl_xor(s[j], 32); }
        if (rs == 0) { f32x4 o0, o1;
#pragma unroll
            for (int j = 0; j < 4; ++j) { o0[j] = s[j] * (1.f / MBLK); o1[j] = s[4 + j] * (1.f / MBLK); }
            *(f32x4*)(KM + (size_t)t * 128 + 8 * c8) = o0; *(f32x4*)(KM + (size_t)t * 128 + 8 * c8 + 4) = o1; }
    }
}
constexpr int P6_ROWB = 4112, P6_ALO = 16 * P6_ROWB, P6_RS = 132096, P6_LDS = 133120;
typedef short p6_bf16x8 __attribute__((ext_vector_type(8)));
__device__ __forceinline__ void ph_ln1_route(const Args& a, LAS unsigned char* lds, int wg, int nwg) {
    const int tid = tid_opaque(), lane = tid & 63, w = __builtin_amdgcn_readfirstlane(tid >> 6);
    const float* MOD = (const float*)(a.ws + WS_MOD); bf16* H = (bf16*)(a.ws + WS_H); bf16* X1 = (bf16*)(a.ws + WS_X1);
    int* EID = (int*)(a.ws + WS_ROUTE); float* WGT = (float*)(a.ws + WS_ROUTE + 65536); int* LIST = (int*)(a.ws + WS_LIST);
    unsigned* CNT = (unsigned*)(a.ws + WS_CTL) + CW_CNT;
    const bf16* WRH = (const bf16*)(a.ws + WS_WR); const bf16* WRL = WRH + 48 * DM; const bf16* Y1 = (const bf16*)(a.ws + WS_KV);
    LAS float* PART = (LAS float*)lds; LAS float* LG = (LAS float*)(lds + 24576);
    LAS unsigned* lcnt = (LAS unsigned*)(lds + P6_RS); LAS unsigned* lbase = lcnt + 32; LAS int* sl_e = (LAS int*)(lcnt + 64); LAS int* sl_pos = sl_e + 32;
    if (tid < 32) lcnt[tid] = 0u;
    for (int r0 = wg * 16; r0 < NT; r0 += nwg * 16) {
        const int b = r0 / SEQ;
        for (int rr = 0; rr < 2; ++rr) {
            const int row = r0 + 2 * w + rr;
            bf16* xr = X1 + (size_t)row * DM + 4 * lane; const float* xin = a.x + (size_t)row * DM + 4 * lane; const bf16* yr = Y1 + (size_t)row * DM + 4 * lane;
            f32x4 v[8]; float s = 0.f;
#pragma unroll
            for (int j = 0; j < 8; ++j) { const f32x4 xv = *(const f32x4*)(xin + 256 * j); const u32x2 yu = *(const u32x2*)(yr + 256 * j); const f32x4 g1 = *(const f32x4*)(MOD + b * MODN + MOD_G1 + 4 * lane + 256 * j);
                f32x4 y; y[0] = bf2f(yu.x & 0xffffu); y[1] = bf2f(yu.x >> 16); y[2] = bf2f(yu.y & 0xffffu); y[3] = bf2f(yu.y >> 16);
                v[j] = xv * ALPHA + g1 * y; s += (v[j][0] + v[j][1]) + (v[j][2] + v[j][3]); }
            float mean = wave_sum(s) * (1.f / DM), s2 = 0.f;
#pragma unroll
            for (int j = 0; j < 8; ++j) { v[j] = v[j] - mean; s2 += (v[j][0] * v[j][0] + v[j][1] * v[j][1]) + (v[j][2] * v[j][2] + v[j][3] * v[j][3]); }
            float rstd = 1.0f / sqrtf(wave_sum(s2) * (1.f / DM) + LN_EPS);
            s = 0.f;
#pragma unroll
            for (int j = 0; j < 8; ++j) { const f32x4 g = *(const f32x4*)(a.ln1g + 4 * lane + 256 * j), bb = *(const f32x4*)(a.ln1b + 4 * lane + 256 * j);
                v[j] = v[j] * rstd * g + bb; { u32x2 xw; xw.x = pk2(v[j][0], v[j][1]); xw.y = pk2(v[j][2], v[j][3]); *(u32x2*)(xr + 256 * j) = xw; } s += (v[j][0] + v[j][1]) + (v[j][2] + v[j][3]); }
            mean = wave_sum(s) * (1.f / DM); s2 = 0.f;
#pragma unroll
            for (int j = 0; j < 8; ++j) { v[j] = v[j] - mean; s2 += (v[j][0] * v[j][0] + v[j][1] * v[j][1]) + (v[j][2] * v[j][2] + v[j][3] * v[j][3]); }
            rstd = 1.0f / sqrtf(wave_sum(s2) * (1.f / DM) + LN_EPS);
            bf16* hr = H + (size_t)row * DM + 4 * lane; LAS unsigned char* hl = lds + (2 * w + rr) * P6_ROWB + 8 * lane;
#pragma unroll
            for (int j = 0; j < 8; ++j) { const f32x4 sc = *(const f32x4*)(MOD + b * MODN + MOD_SC2 + 4 * lane + 256 * j) + 1.0f, sh = *(const f32x4*)(MOD + b * MODN + MOD_SH2 + 4 * lane + 256 * j);
                const f32x4 o = v[j] * rstd * sc + sh;
                unsigned hb[4], lb[4];
#pragma unroll
                for (int i = 0; i < 4; ++i) { hb[i] = f2bf(o[i]); lb[i] = f2bf(o[i] - bf2f(hb[i])); }
                u32x2 wh, wl; wh.x = hb[0] | (hb[1] << 16); wh.y = hb[2] | (hb[3] << 16); wl.x = lb[0] | (lb[1] << 16); wl.y = lb[2] | (lb[3] << 16);
                *(u32x2*)(hr + 256 * j) = wh; *(LAS u32x2*)(hl + 512 * j) = wh; *(LAS u32x2*)(hl + P6_ALO + 512 * j) = wl; }
        }
        __syncthreads();
        {
            const int row16 = lane & 15, quad = lane >> 4;
            f32x4 acc[3];
#pragma unroll
            for (int t = 0; t < 3; ++t) acc[t] = (f32x4){0.f, 0.f, 0.f, 0.f};
#pragma unroll 2
            for (int ks = 0; ks < 8; ++ks) { const int k0 = w * 256 + ks * 32 + quad * 8;
                const p6_bf16x8 ah = *(LAS const p6_bf16x8*)(lds + row16 * P6_ROWB + k0 * 2), al = *(LAS const p6_bf16x8*)(lds + P6_ALO + row16 * P6_ROWB + k0 * 2);
#pragma unroll
                for (int t = 0; t < 3; ++t) { const p6_bf16x8 bh = *(const p6_bf16x8*)(WRH + (size_t)(16 * t + row16) * DM + k0), bl = *(const p6_bf16x8*)(WRL + (size_t)(16 * t + row16) * DM + k0);
                    acc[t] = __builtin_amdgcn_mfma_f32_16x16x32_bf16(ah, bh, acc[t], 0, 0, 0);
                    acc[t] = __builtin_amdgcn_mfma_f32_16x16x32_bf16(ah, bl, acc[t], 0, 0, 0);
                    acc[t] = __builtin_amdgcn_mfma_f32_16x16x32_bf16(al, bh, acc[t], 0, 0, 0); } }
            __syncthreads();
#pragma unroll
            for (int t = 0; t < 3; ++t)
#pragma unroll
                for (int j = 0; j < 4; ++j) PART[(w * 16 + quad * 4 + j) * 48 + 16 * t + row16] = acc[t][j];
        }
        __syncthreads();
        for (int idx = tid; idx < 16 * 36; idx += 512) { const int r = idx / 36, n = idx % 36; float sum = 0.f;
#pragma unroll
            for (int ww = 0; ww < 8; ++ww) sum += PART[(ww * 16 + r) * 48 + n];
            LG[idx] = sum; }
        __syncthreads();
        if (tid < 16) {
            const int t = r0 + tid; const LAS float* lg = LG + tid * 36;
            float g[4]; int gi = 0;
#pragma unroll
            for (int i = 0; i < 4; ++i) g[i] = lg[32 + i] + a.b_rg[i];
            float gm = g[0];
#pragma unroll
            for (int i = 1; i < 4; ++i) if (g[i] > gm) { gm = g[i]; gi = i; }
            float gs = 0.f;
#pragma unroll
            for (int i = 0; i < 4; ++i) gs += expf(g[i] - gm);
            const float gp = 1.0f / gs;
            float el[8];
#pragma unroll
            for (int i = 0; i < 8; ++i) el[i] = lg[gi * 8 + i] + a.b_re[gi * 8 + i];
            int i1 = 0; float m1 = el[0];
#pragma unroll
            for (int i = 1; i < 8; ++i) if (el[i] > m1) { m1 = el[i]; i1 = i; }
            int i2 = -1; float m2 = -INFINITY;
#pragma unroll
            for (int i = 0; i < 8; ++i) if (i != i1 && el[i] > m2) { m2 = el[i]; i2 = i; }
            const float p2 = expf(m2 - m1), inv = 1.0f / (1.0f + p2);
            const int e1 = gi * 8 + i1, e2 = gi * 8 + i2;
            EID[2 * t] = e1; EID[2 * t + 1] = e2; WGT[2 * t] = gp * inv; WGT[2 * t + 1] = gp * p2 * inv;
            sl_e[2 * tid] = e1; sl_pos[2 * tid] = (int)__hip_atomic_fetch_add(&lcnt[e1], 1u, __ATOMIC_RELAXED, __HIP_MEMORY_SCOPE_WORKGROUP);
            sl_e[2 * tid + 1] = e2; sl_pos[2 * tid + 1] = (int)__hip_atomic_fetch_add(&lcnt[e2], 1u, __ATOMIC_RELAXED, __HIP_MEMORY_SCOPE_WORKGROUP);
        }
        __syncthreads();
        if (tid < 32) { const unsigned n = lcnt[tid]; lbase[tid] = n ? atomicAdd(CNT + tid, n) : 0u; lcnt[tid] = 0u; }
        __syncthreads();
        if (tid < 32) { const int e = sl_e[tid]; LIST[e * NT + (int)lbase[e] + sl_pos[tid]] = 2 * (r0 + (tid >> 1)) + (tid & 1); }
        __syncthreads();
    }
}
__device__ __forceinline__ void ph_final(const Args& a, int wg, int nwg) {
    const int tid = tid_opaque(), lane = tid & 63, gw = wg * 8 + __builtin_amdgcn_readfirstlane(tid >> 6), NGW = nwg * 8;
    const float* MOD = (const float*)(a.ws + WS_MOD); const bf16* X1 = (const bf16*)(a.ws + WS_X1); const bf16* YS = (const bf16*)(a.ws + WS_PROJ);
    for (int row = gw; row < NT; row += NGW) {
        const int b = row / SEQ;
        const bf16* xr = X1 + (size_t)row * DM + 4 * lane; const bf16* y0 = YS + (size_t)(2 * row) * DM + 4 * lane; const bf16* y1 = y0 + DM;
        f32x4 v[8]; float s = 0.f;
#pragma unroll
        for (int j = 0; j < 8; ++j) { const f32x4 g2 = *(const f32x4*)(MOD + b * MODN + MOD_G2 + 4 * lane + 256 * j); const u32x2 u0 = *(const u32x2*)(y0 + 256 * j), u1 = *(const u32x2*)(y1 + 256 * j);
            f32x4 y; y[0] = bf2f(u0.x & 0xffffu) + bf2f(u1.x & 0xffffu); y[1] = bf2f(u0.x >> 16) + bf2f(u1.x >> 16); y[2] = bf2f(u0.y & 0xffffu) + bf2f(u1.y & 0xffffu); y[3] = bf2f(u0.y >> 16) + bf2f(u1.y >> 16);
            const u32x2 xu = *(const u32x2*)(xr + 256 * j); f32x4 xv; xv[0] = bf2f(xu.x & 0xffffu); xv[1] = bf2f(xu.x >> 16); xv[2] = bf2f(xu.y & 0xffffu); xv[3] = bf2f(xu.y >> 16);
            v[j] = xv * ALPHA + g2 * y; s += (v[j][0] + v[j][1]) + (v[j][2] + v[j][3]); }
        const float mean = wave_sum(s) * (1.f / DM); float s2 = 0.f;
#pragma unroll
        for (int j = 0; j < 8; ++j) { v[j] = v[j] - mean; s2 += (v[j][0] * v[j][0] + v[j][1] * v[j][1]) + (v[j][2] * v[j][2] + v[j][3] * v[j][3]); }
        const float rstd = 1.0f / sqrtf(wave_sum(s2) * (1.f / DM) + LN_EPS);
        float* o = a.out + (size_t)row * DM + 4 * lane;
#pragma unroll
        for (int j = 0; j < 8; ++j) { const f32x4 g = *(const f32x4*)(a.ln2g + 4 * lane + 256 * j), bb = *(const f32x4*)(a.ln2b + 4 * lane + 256 * j); *(f32x4*)(o + 256 * j) = v[j] * rstd * g + bb; }
    }
}

template <int PH> __global__ void __launch_bounds__(512, 2) k_thin(Args a) {
    extern __shared__ __attribute__((aligned(16))) unsigned char lds[];
    const int wg = blockIdx.x, nwg = gridDim.x;
    if (PH == 0) { ph_mod(a, (LAS float*)lds, wg, nwg); ph_rope_table(a, wg, nwg); }
    if (PH == 1) ph_ln0(a, wg, nwg);
    if (PH == 3) ph_kmean(a, wg, nwg);
    if (PH == 6) ph_ln1_route(a, (LAS unsigned char*)lds, wg, nwg);
    if (PH == 9) ph_final(a, wg, nwg);
}

template <class F> __global__ void __launch_bounds__(256) nk_gemm(F f, int K) {
    __shared__ float As[16][68]; __shared__ float Bs[16][68];
    const int tid = threadIdx.x, tx = tid & 15, ty = tid >> 4, z = blockIdx.z, m0 = blockIdx.y * 64, n0 = blockIdx.x * 64;
    if (!f.active(z, m0)) return;
    float acc[4][4] = {};
    const int ar = tid >> 2, ak = (tid & 3) * 4; const bf16* arow = f.arow(z, m0 + ar);
    const int bk = tid >> 4, bn = (tid & 15) * 4;
    for (int k0 = 0; k0 < K; k0 += 16) {
        float a4[4] = {0.f, 0.f, 0.f, 0.f};
        if (arow) { const u32x2 u = *(const u32x2*)(arow + k0 + ak); a4[0] = bf2f(u.x & 0xffffu); a4[1] = bf2f(u.x >> 16); a4[2] = bf2f(u.y & 0xffffu); a4[3] = bf2f(u.y >> 16); }
#pragma unroll
        for (int i = 0; i < 4; ++i) As[ak + i][ar] = a4[i];
#pragma unroll
        for (int i = 0; i < 4; ++i) Bs[bk][bn + i] = f.b(z, k0 + bk, n0 + bn + i);
        __syncthreads();
#pragma unroll
        for (int kk = 0; kk < 16; ++kk) { float av[4], bv[4];
#pragma unroll
            for (int i = 0; i < 4; ++i) { av[i] = As[kk][ty * 4 + i]; bv[i] = Bs[kk][tx * 4 + i]; }
#pragma unroll
            for (int i = 0; i < 4; ++i)
#pragma unroll
                for (int j = 0; j < 4; ++j) acc[i][j] += av[i] * bv[j]; }
        __syncthreads();
    }
#pragma unroll
    for (int i = 0; i < 4; ++i)
#pragma unroll
        for (int j = 0; j < 4; ++j) f.store(z, m0 + ty * 4 + i, n0 + tx * 4 + j, acc[i][j]);
}
struct FProj { const bf16* A; const float* W; float* C;
    __device__ bool active(int, int) const { return true; }
    __device__ const bf16* arow(int, int m) const { return A + (size_t)m * DM; }
    __device__ float b(int, int k, int n) const { return W[(size_t)k * INCOLS + n]; }
    __device__ void store(int, int m, int n, float v) const { C[(size_t)m * INCOLS + n] = v; } };
struct FQ { const bf16* PROJ; const float* W; const float* g; float* C;
    __device__ bool active(int, int) const { return true; }
    __device__ const bf16* arow(int, int m) const { return PROJ + (size_t)m * PROJ_N; }
    __device__ float b(int, int k, int n) const { return g[k] * W[(size_t)k * 1536 + n]; }
    __device__ void store(int, int m, int n, float v) const { C[(size_t)m * 1536 + n] = v; } };
struct FKV { const bf16* PROJ; const float* W; const float* g; const float* SS; bf16* KV;
    __device__ bool active(int, int) const { return true; }
    __device__ const bf16* arow(int, int m) const { return PROJ + (size_t)m * PROJ_N + QR; }
    __device__ float b(int, int k, int n) const { return g[k] * W[(size_t)k * 2048 + n]; }
    __device__ void store(int, int m, int n, float v) const { const float* s = SS + (size_t)m * 12 + 8; const float rs = 1.0f / sqrtf(((s[0] + s[1]) + (s[2] + s[3])) * (1.f / KVR) + RMS_EPS); KV[(size_t)m * 2048 + n] = (bf16)f2bf(v * rs); } };
struct FOut { const bf16* ATT; const float* W; bf16* Y;
    __device__ bool active(int, int) const { return true; }
    __device__ const bf16* arow(int, int m) const { return ATT + (size_t)m * DM; }
    __device__ float b(int, int k, int n) const { return W[(size_t)k * DM + n]; }
    __device__ void store(int, int m, int n, float v) const { Y[(size_t)m * DM + n] = (bf16)f2bf(v); } };
struct FMoe1 { const bf16* H; const float* w1; const float* w3; const unsigned* cnt; const int* LIST; float* C;
    __device__ bool active(int e, int m0) const { return m0 < (int)cnt[e]; }
    __device__ const bf16* arow(int e, int m) const { return m < (int)cnt[e] ? H + (size_t)(LIST[e * NT + m] >> 1) * DM : nullptr; }
    __device__ float b(int e, int k, int n) const { return n < FF ? w1[((size_t)e * DM + k) * FF + n] : w3[((size_t)e * DM + k) * FF + n - FF]; }
    __device__ void store(int e, int m, int n, float v) const { if (m < (int)cnt[e]) C[(size_t)(moe_rowbase(cnt, e) + m) * 1024 + n] = v; } };
struct FMoe2 { const bf16* HID; const float* w2; const unsigned* cnt; const int* LIST; bf16* YS;
    __device__ bool active(int e, int m0) const { return m0 < (int)cnt[e]; }
    __device__ const bf16* arow(int e, int m) const { return m < (int)cnt[e] ? HID + (size_t)(moe_rowbase(cnt, e) + m) * FF : nullptr; }
    __device__ float b(int e, int k, int n) const { return w2[((size_t)e * FF + k) * DM + n]; }
    __device__ void store(int e, int m, int n, float v) const { if (m < (int)cnt[e]) YS[(size_t)LIST[e * NT + m] * DM + n] = (bf16)f2bf(v); } };

__global__ void __launch_bounds__(256) nk_epi_proj(Args a) {
    const int row = blockIdx.x, tid = threadIdx.x, pos = row % SEQ;
    const float* T = (const float*)(a.ws + WS_W13) + (size_t)row * INCOLS; bf16* P = (bf16*)(a.ws + WS_PROJ) + (size_t)row * PROJ_N;
    const float* RT = (const float*)(a.ws + WS_ROPE); float* SS = (float*)(a.ws + WS_SS) + (size_t)row * 12;
    __shared__ float red[2][256];
    float sq = 0.f, skv = 0.f;
    for (int n = tid; n < PROJ_N; n += 256) {
        float v;
        if (n < PC_KR) { v = T[n]; if (n < QR) sq += v * v; else skv += v * v; }
        else if (n < PC_KR + 64) { const int jj = n - PC_KR, i = jj >> 1, s = jj & 1; const float x1 = T[768 + i], x2 = T[768 + 32 + i], cs = RT[2 * (pos * 32 + i)], sn = RT[2 * (pos * 32 + i) + 1]; v = s == 0 ? x1 * cs - x2 * sn : x1 * sn + x2 * cs; }
        else if (n < PC_QMO) v = 0.f;
        else v = T[n - 192];
        P[n] = (bf16)f2bf(v);
    }
    red[0][tid] = sq; red[1][tid] = skv; __syncthreads();
    for (int o = 128; o > 0; o >>= 1) { if (tid < o) { red[0][tid] += red[0][tid + o]; red[1][tid] += red[1][tid + o]; } __syncthreads(); }
    if (tid < 12) SS[tid] = tid == 0 ? red[0][0] : (tid == 8 ? red[1][0] : 0.f);
}
__global__ void __launch_bounds__(256) nk_epi_q(Args a) {
    const int row = blockIdx.x, tid = threadIdx.x, pos = row % SEQ;
    const float* T = (const float*)(a.ws + WS_W13) + (size_t)row * 1536; bf16* Q = (bf16*)(a.ws + WS_QM) + (size_t)row * 1536;
    const float* RT = (const float*)(a.ws + WS_ROPE); const float* s = (const float*)(a.ws + WS_SS) + (size_t)row * 12;
    const float rs = 1.0f / sqrtf((((s[0] + s[1]) + (s[2] + s[3])) + ((s[4] + s[5]) + (s[6] + s[7]))) * (1.f / QR) + RMS_EPS);
    for (int n = tid; n < 1536; n += 256) {
        const int h = n / QHD, j = n % QHD; float v;
        if (j < 128) v = T[n] * rs;
        else { const int jj = j - 128, i = jj >> 1, sx = jj & 1; const float x1 = T[h * QHD + 128 + i] * rs, x2 = T[h * QHD + 160 + i] * rs, cs = RT[2 * (pos * 32 + i)], sn = RT[2 * (pos * 32 + i) + 1]; v = sx == 0 ? x1 * cs - x2 * sn : x1 * sn + x2 * cs; }
        Q[n] = (bf16)f2bf(v);
    }
}
__global__ void __launch_bounds__(256) nk_epi_moe1(Args a) {
    const unsigned* cnt = (const unsigned*)(a.ws + WS_CTL) + CW_CNT; const int e = blockIdx.x, m0 = blockIdx.y * 64;
    if (m0 >= (int)cnt[e]) return;
    const int* LIST = (const int*)(a.ws + WS_LIST); const float* WGT = (const float*)(a.ws + WS_ROUTE + 65536);
    const float* T = (const float*)(a.ws + WS_W13); bf16* HID = (bf16*)(a.ws + WS_QM); const int rb = moe_rowbase(cnt, e);
    for (int m = m0; m < m0 + 64 && m < (int)cnt[e]; ++m) { const float w = WGT[LIST[e * NT + m]]; const size_t R = (size_t)(rb + m);
        for (int f = threadIdx.x; f < FF; f += 256) { const float a1 = T[R * 1024 + f], a3 = T[R * 1024 + FF + f]; HID[R * FF + f] = (bf16)f2bf(silu_f(a1) * a3 * w); } }
}
__global__ void __launch_bounds__(128) nk_attn_mla(Args a) {
    __shared__ float sc[2][SEQ]; __shared__ float qv[2][QHD];
    const int lane = threadIdx.x & 63, w = threadIdx.x >> 6, b = blockIdx.z, h = blockIdx.y, q = blockIdx.x * 2 + w;
    const bf16* QM = (const bf16*)(a.ws + WS_QM); const bf16* KV = (const bf16*)(a.ws + WS_KV); const bf16* PROJ = (const bf16*)(a.ws + WS_PROJ); bf16* ATT = (bf16*)(a.ws + WS_ATT);
    const size_t row = (size_t)b * SEQ + q; const float scale = 0.07216878364870322f;
    for (int d = lane; d < QHD; d += 64) qv[w][d] = bf2f(QM[row * 1536 + h * QHD + d]);
    __syncthreads();
    float mx = -INFINITY;
    for (int k = lane; k <= q; k += 64) { const size_t kr = (size_t)b * SEQ + k; const bf16* kn = KV + kr * 2048 + h * 256; const bf16* kp = PROJ + kr * PROJ_N + PC_KR; float dsum = 0.f;
        for (int d = 0; d < 128; ++d) dsum += qv[w][d] * bf2f(kn[d]);
        for (int d = 0; d < 64; ++d) dsum += qv[w][128 + d] * bf2f(kp[d]);
        dsum *= scale; sc[w][k] = dsum; mx = fmaxf(mx, dsum); }
    mx = wave_max(mx); float sum = 0.f;
    for (int k = lane; k <= q; k += 64) { const float p = expf(sc[w][k] - mx); sc[w][k] = p; sum += p; }
    sum = wave_sum(sum);
    __syncthreads();
    float o0 = 0.f, o1 = 0.f;
    for (int k = 0; k <= q; ++k) { const unsigned u = *(const unsigned*)(KV + ((size_t)b * SEQ + k) * 2048 + h * 256 + 128 + 2 * lane); const float p = sc[w][k]; o0 += p * bf2f(u & 0xffffu); o1 += p * bf2f(u >> 16); }
    const float inv = 1.0f / sum;
    *(unsigned*)(ATT + row * DM + h * 128 + 2 * lane) = pk2(o0 * inv, o1 * inv);
}
__global__ void __launch_bounds__(256) nk_attn_moba(Args a) {
    __shared__ float sc[4][1024]; __shared__ float qv[4][128]; __shared__ int selb[4][4];
    const int lane = threadIdx.x & 63, w = threadIdx.x >> 6, b = blockIdx.z, h = blockIdx.y, q = blockIdx.x * 4 + w, qblk = q / MBLK;
    const bf16* PROJ = (const bf16*)(a.ws + WS_PROJ); bf16* ATT = (bf16*)(a.ws + WS_ATT); const float* KM = (const float*)(a.ws + WS_KMEAN) + (size_t)(b * NH + h) * NBLK * 128;
    const size_t row = (size_t)b * SEQ + q; const float scale = 0.08838834764831845f;
    for (int d = lane; d < 128; d += 64) qv[w][d] = bf2f(PROJ[row * PROJ_N + PC_QMO + h * 128 + d]);
    __syncthreads();
    float gate = -INFINITY;
    if (lane < qblk) { float s = 0.f; for (int d = 0; d < 128; ++d) s += qv[w][d] * KM[lane * 128 + d]; gate = s; }
    const int nsel = qblk < 3 ? qblk : 3;
    for (int s = 0; s < nsel; ++s) {
        float bv = gate; int bi = lane;
#pragma unroll
        for (int o = 1; o < 64; o <<= 1) { const float ov = __shfl_xor(bv, o); const int oi = __shfl_xor(bi, o); if (ov > bv || (ov == bv && oi < bi)) { bv = ov; bi = oi; } }
        if (lane == 0) selb[w][s] = bi;
        if (lane == bi) gate = -INFINITY;
    }
    if (lane == 0) selb[w][nsel] = qblk;
    __syncthreads();
    float mx = -INFINITY;
    for (int s = 0; s <= nsel; ++s) { const int blk = selb[w][s];
        for (int kk = lane; kk < MBLK; kk += 64) { const int key = blk * MBLK + kk; float v = -INFINITY;
            if (key <= q) { const bf16* kp = PROJ + ((size_t)b * SEQ + key) * PROJ_N + PC_KMO + h * 128; float dsum = 0.f;
                for (int d = 0; d < 128; ++d) dsum += qv[w][d] * bf2f(kp[d]);
                v = dsum * scale + a.t5[t5_bucket(q - key) * NH + h]; }
            sc[w][s * MBLK + kk] = v; mx = fmaxf(mx, v); } }
    mx = wave_max(mx); float sum = 0.f;
    for (int i = lane; i < (nsel + 1) * MBLK; i += 64) { const float p = expf(sc[w][i] - mx); sc[w][i] = p; sum += p; }
    sum = wave_sum(sum);
    __syncthreads();
    float o0 = 0.f, o1 = 0.f;
    for (int s = 0; s <= nsel; ++s) { const int blk = selb[w][s];
        for (int kk = 0; kk < MBLK; ++kk) { const int key = blk * MBLK + kk; if (key > q) break;
            const unsigned u = *(const unsigned*)(PROJ + ((size_t)b * SEQ + key) * PROJ_N + PC_VMO + h * 128 + 2 * lane); const float p = sc[w][s * MBLK + kk]; o0 += p * bf2f(u & 0xffffu); o1 += p * bf2f(u >> 16); } }
    const float inv = 1.0f / sum;
    *(unsigned*)(ATT + row * DM + 1024 + h * 128 + 2 * lane) = pk2(o0 * inv, o1 * inv);
}

namespace pg8 {
typedef unsigned short bf16_t;
typedef short bf16x8 __attribute__((ext_vector_type(8)));
constexpr int BM = 256, BK = 64, HALF = 128, HTB = HALF * BK * 2, STAGE_BYTES = 8 * HTB, NXCD = 8, WGM = 8;
__host__ __device__ __forceinline__ int lds_byte(int r, int c) { const int st = (r >> 4) * 2 + (c >> 5), rr = r & 15, cc = c & 31, ob = rr * 64 + cc * 2; return st * 1024 + (ob ^ (((ob >> 9) & 1) << 5)); }
__host__ __device__ __forceinline__ void stage_rc(int b, int& R, int& C) { const int st = b / 1024, sb = b % 1024, swz = sb ^ (((sb >> 9) & 1) << 5); R = (st >> 1) * 16 + swz / 64; C = (st & 1) * 32 + (swz % 64) / 2; }
__host__ __device__ __forceinline__ int perm32(int rho) { const int n = rho >> 4, i = rho & 15; return 8 * (i >> 2) + 4 * n + (i & 3); }

struct Unit { int pm, pn, e, mt, cnt; };
struct Gemm { const bf16_t* A; const bf16_t* Bt; int K, lda, ldb; };

struct StaticOrder {
    int nM, nN, nwg, G, c;
    __device__ void init(int M, int N, int G_, int c_) { nM = M / BM; nN = N / BM; nwg = nM * nN; G = G_; c = c_; }
    __device__ bool next(int i, Unit& u) const {
        const long L = (long)i * G + c; if (L >= nwg) return false;
        int wgid = (int)L; { const int q = nwg / NXCD, r = nwg % NXCD, xcd = wgid % NXCD, off = wgid / NXCD; wgid = (xcd < r ? xcd * (q + 1) : r * (q + 1) + (xcd - r) * q) + off; }
        const int nig = WGM * nN, gid = wgid / nig, fm = gid * WGM, gsz = (nM - fm) < WGM ? (nM - fm) : WGM;
        u.pm = fm + ((wgid % nig) % gsz); u.pn = (wgid % nig) / gsz; u.e = 0; u.mt = 0; u.cnt = 0; return true;
    }
};
struct MoeOrder {
    const unsigned* cnt; int NPN, G, c;
    __device__ bool next(int i, Unit& u) const {
        int nmt = 0;
        for (int e = 0; e < NE; ++e) nmt += (int)((cnt[e] + 255u) >> 8);
        const int x = c & 7, nl = G >> 3, lw = c >> 3;
        const int g0 = (nmt * x) >> 3, g1 = (nmt * (x + 1)) >> 3;
        const int L = i * nl + lw, gl = L / NPN;
        if (lw >= nl || g0 + gl >= g1) return false;
        int g = g0 + gl, rb = 0;
        for (int e = 0; e < NE; ++e) { const int ce = (int)cnt[e], nm = (ce + 255) >> 8;
            if (g < nm) { u.e = e; u.mt = g; u.pn = e * NPN + L % NPN; u.pm = rb + g; u.cnt = ce; return true; }
            g -= nm; rb += nm; }
        return false;
    }
};
struct ADense { int lda;
    __device__ __forceinline__ void get(const Unit& u, unsigned (&off)[2][2]) const {
        const int tid = tid_opaque();
#pragma unroll
        for (int i = 0; i < 2; ++i) { int R, C; stage_rc(tid * 16 + i * 8192, R, C);
#pragma unroll
            for (int h = 0; h < 2; ++h) off[h][i] = (unsigned)((u.pm * BM + h * HALF + R) * lda + C) * 2u; } } };
struct AGather { const int* LIST; int lda;
    __device__ __forceinline__ void get(const Unit& u, unsigned (&off)[2][2]) const {
        const int tid = tid_opaque();
#pragma unroll
        for (int i = 0; i < 2; ++i) { int R, C; stage_rc(tid * 16 + i * 8192, R, C);
#pragma unroll
            for (int h = 0; h < 2; ++h) { const int idx = u.mt * BM + h * HALF + R; const int tok = idx < u.cnt ? (LIST[u.e * NT + idx] >> 1) : 0; off[h][i] = (unsigned)(tok * lda + C) * 2u; } } } };

template <class Epi, class Sched, class AOff, bool ALIGN_EPI>
__device__ __forceinline__ void gemm_phase(LAS unsigned char* lds, const Gemm g, const Sched& S, const AOff& AO, const Epi& E) {
    const int tid = tid_opaque(), wid = __builtin_amdgcn_readfirstlane(tid >> 6), lane = tid & 63, wr = wid >> 2, wc = wid & 3, fr = lane & 15, fq = lane >> 4;
    const int K = g.K, nt = K / BK;
    unsigned voffB[2];
#pragma unroll
    for (int i = 0; i < 2; ++i) { int R, C; stage_rc(tid * 16 + i * 8192, R, C); const int Rb = Epi::PERM ? ((R & ~31) + perm32(R & 31)) : R;
        voffB[i] = (unsigned)(Rb * g.ldb + C) * 2u; }
    const size_t kstep = (size_t)(BK * 2);
    const size_t hstepB = (size_t)HALF * g.ldb * 2, tstepB = 2 * hstepB;
    const unsigned ldsw = (unsigned)wid * 1024u;
    const int aoff = lds_byte(wr * 64 + fr, fq * 8), boff = lds_byte(wc * 32 + fr, fq * 8);
#define PG8_SA(b, h) (((b) * 2 + (h)) * HTB)
#define PG8_SB(b, h) ((4 + (b) * 2 + (h)) * HTB)
#define PG8_STAGE(bufoff, gbase, voff) do { _Pragma("unroll") for (int _i = 0; _i < 2; ++_i) \
        __builtin_amdgcn_global_load_lds((const unsigned*)((const char*)(gbase) + (voff)[_i]), (LAS unsigned*)(lds + (bufoff) + ldsw + _i * 8192), 16, 0, 0); } while (0)
#define PG8_LDA(dst, b, h) do { _Pragma("unroll") for (int m = 0; m < 4; ++m) _Pragma("unroll") for (int k = 0; k < 2; ++k) dst[m][k] = *(const LAS bf16x8*)(lds + PG8_SA(b, h) + aoff + m * 2048 + k * 1024); } while (0)
#define PG8_LDB(dst, b, h) do { _Pragma("unroll") for (int n = 0; n < 2; ++n) _Pragma("unroll") for (int k = 0; k < 2; ++k) dst[n][k] = *(const LAS bf16x8*)(lds + PG8_SB(b, h) + boff + n * 2048 + k * 1024); } while (0)
#define PG8_MMA(ai, bj, At, Bt) do { __builtin_amdgcn_s_setprio(1); _Pragma("unroll") for (int m = 0; m < 4; ++m) _Pragma("unroll") for (int n = 0; n < 2; ++n) _Pragma("unroll") for (int k = 0; k < 2; ++k) \
        acc[ai][bj][m][n] = __builtin_amdgcn_mfma_f32_16x16x32_bf16(Bt[n][k], At[m][k], acc[ai][bj][m][n], 0, 0, 0); __builtin_amdgcn_s_setprio(0); } while (0)
#define PG8_WAIT_V(n) asm volatile("s_waitcnt vmcnt(" #n ")" ::: "memory")
#define PG8_WAIT_L(n) asm volatile("s_waitcnt lgkmcnt(" #n ")" ::: "memory")
#define PG8_BAR __builtin_amdgcn_s_barrier()
#define PG8_SCHED __builtin_amdgcn_sched_barrier(0)
    Unit cur, nxt; int ui = 0;
    if (!S.next(0, cur)) return;
    f32x4 acc[2][2][4][2];
#pragma unroll
    for (int a = 0; a < 2; ++a)
#pragma unroll
        for (int b = 0; b < 2; ++b)
#pragma unroll
            for (int m = 0; m < 4; ++m)
#pragma unroll
                for (int n = 0; n < 2; ++n) acc[a][b][m][n] = (f32x4){0.f, 0.f, 0.f, 0.f};
    bf16x8 At[4][2], B0[2][2], B1[2][2];
    const char* Ab = (const char*)g.A;
    const char* cB = (const char*)g.Bt + (size_t)cur.pn * tstepB;
    unsigned offC[2][2], offN[2][2];
    AO.get(cur, offC);
    PG8_STAGE(PG8_SB(0, 0), cB, voffB); PG8_STAGE(PG8_SB(0, 1), cB + hstepB, voffB); PG8_STAGE(PG8_SA(0, 0), Ab, offC[0]); PG8_STAGE(PG8_SA(0, 1), Ab, offC[1]);
    if (wr == 1) PG8_BAR;
    PG8_WAIT_V(2); PG8_BAR;
    PG8_STAGE(PG8_SB(1, 0), cB + kstep, voffB); PG8_STAGE(PG8_SA(1, 0), Ab + kstep, offC[0]); PG8_STAGE(PG8_SB(1, 1), cB + hstepB + kstep, voffB);
    PG8_WAIT_V(6); PG8_BAR;
    for (;;) {
        const bool has_next = S.next(ui + 1, nxt);
        if (!has_next) nxt = cur;
        AO.get(nxt, offN);
        const char* nB = (const char*)g.Bt + (size_t)nxt.pn * tstepB;
#pragma unroll 1
        for (int t = 0; t < nt; t += 2) {
            const bool last = (t == nt - 2);
            const char* a1 = Ab + (size_t)(t + 1) * kstep;
            const char* a2 = last ? Ab : Ab + (size_t)(t + 2) * kstep; const char* b2 = last ? nB : cB + (size_t)(t + 2) * kstep;
            const char* a3 = a2 + kstep; const char* b3 = b2 + kstep;
            PG8_LDB(B0, 0, 0); PG8_LDB(B1, 0, 1); PG8_SCHED; PG8_LDA(At, 0, 0); PG8_STAGE(PG8_SA(1, 1), a1, offC[1]);
            if (last) {
#pragma unroll
                for (int h = 0; h < 2; ++h)
#pragma unroll
                    for (int i = 0; i < 2; ++i) offC[h][i] = offN[h][i]; }
            PG8_WAIT_V(8); PG8_WAIT_L(0); PG8_BAR; PG8_MMA(0, 0, At, B0); PG8_MMA(0, 1, At, B1); PG8_BAR; PG8_SCHED;
            PG8_LDA(At, 0, 1); PG8_STAGE(PG8_SB(0, 0), b2, voffB); PG8_STAGE(PG8_SB(0, 1), b2 + hstepB, voffB); PG8_STAGE(PG8_SA(0, 0), a2, offC[0]);
            PG8_WAIT_V(8); PG8_WAIT_L(0); PG8_BAR; PG8_MMA(1, 0, At, B0); PG8_MMA(1, 1, At, B1); PG8_BAR; PG8_SCHED;
            PG8_LDB(B0, 1, 0); PG8_LDB(B1, 1, 1); PG8_SCHED; PG8_LDA(At, 1, 0); PG8_STAGE(PG8_SA(0, 1), a2, offC[1]);
            PG8_WAIT_V(8); PG8_WAIT_L(0); PG8_BAR; PG8_MMA(0, 0, At, B0); PG8_MMA(0, 1, At, B1); PG8_BAR; PG8_SCHED;
            PG8_LDA(At, 1, 1); PG8_STAGE(PG8_SB(1, 0), b3, voffB); PG8_STAGE(PG8_SB(1, 1), b3 + hstepB, voffB); PG8_STAGE(PG8_SA(1, 0), a3, offC[0]);
            PG8_WAIT_V(8); PG8_WAIT_L(0); PG8_BAR; PG8_MMA(1, 0, At, B0); PG8_MMA(1, 1, At, B1); PG8_BAR; PG8_SCHED;
        }
        if constexpr (ALIGN_EPI) { if (wr == 0) PG8_BAR; }
        E(acc, cur);
        if (!has_next) break;
#pragma unroll
        for (int a = 0; a < 2; ++a)
#pragma unroll
            for (int b = 0; b < 2; ++b)
#pragma unroll
                for (int m = 0; m < 4; ++m)
#pragma unroll
                    for (int n = 0; n < 2; ++n) acc[a][b][m][n] = (f32x4){0.f, 0.f, 0.f, 0.f};
        cur = nxt; cB = nB; ++ui;
        if constexpr (ALIGN_EPI) { if (wr == 1) PG8_BAR; }
    }
    PG8_WAIT_V(0);
    if constexpr (!ALIGN_EPI) { if (wr == 0) PG8_BAR; }
    PG8_BAR;
#undef PG8_SA
#undef PG8_SB
#undef PG8_STAGE
#undef PG8_LDA
#undef PG8_LDB
#undef PG8_MMA
#undef PG8_WAIT_V
#undef PG8_WAIT_L
#undef PG8_BAR
#undef PG8_SCHED
}

__device__ __forceinline__ unsigned cvt_pk_bf16(float lo, float hi) { unsigned r; asm volatile("v_cvt_pk_bf16_f32 %0, %1, %2" : "=v"(r) : "v"(lo), "v"(hi)); return r; }
__device__ __forceinline__ u32x4 pack8(const f32x4 v0, const f32x4 v1) { u32x4 w; w.x = cvt_pk_bf16(v0[0], v0[1]); w.y = cvt_pk_bf16(v0[2], v0[3]); w.z = cvt_pk_bf16(v1[0], v1[1]); w.w = cvt_pk_bf16(v1[2], v1[3]); return w; }
__device__ __forceinline__ void rope8(f32x4& v0, f32x4& v1, const float* RT, int pos, int i0) {
    const f32x4 t0 = *(const f32x4*)(RT + (size_t)(pos * 32 + i0) * 2), t1 = *(const f32x4*)(RT + (size_t)(pos * 32 + i0) * 2 + 4);
    f32x4 o0, o1;
    o0[0] = v0[0] * t0[0] - v0[1] * t0[1]; o0[1] = v0[0] * t0[1] + v0[1] * t0[0]; o0[2] = v0[2] * t0[2] - v0[3] * t0[3]; o0[3] = v0[2] * t0[3] + v0[3] * t0[2];
    o1[0] = v1[0] * t1[0] - v1[1] * t1[1]; o1[1] = v1[0] * t1[1] + v1[1] * t1[0]; o1[2] = v1[2] * t1[2] - v1[3] * t1[3]; o1[3] = v1[2] * t1[3] + v1[3] * t1[2];
    v0 = o0; v1 = o1;
}
struct EpiProj {
    static constexpr bool PERM = true;
    bf16_t* P; const float* RT; float* SS;
    __device__ __forceinline__ void operator()(const f32x4 (&acc)[2][2][4][2], const Unit& u) const {
        const int tid_ = tid_opaque(), wid_ = __builtin_amdgcn_readfirstlane(tid_ >> 6), wr = wid_ >> 2, wc = wid_ & 3, fr = tid_ & 15, fq = (tid_ & 63) >> 4;
        const int row0 = u.pm * BM + wr * 64 + fr, col0 = u.pn * BM + wc * 32 + 8 * fq;
#pragma unroll
        for (int ai = 0; ai < 2; ++ai)
#pragma unroll
            for (int m = 0; m < 4; ++m) { const int row = row0 + ai * HALF + m * 16; bf16_t* rowp = P + (size_t)row * PROJ_N + col0;
                if (u.pn < 3) { float s = 0.f;
#pragma unroll
                    for (int bj = 0; bj < 2; ++bj)
#pragma unroll
                        for (int n = 0; n < 2; ++n) { const f32x4 x = acc[ai][bj][m][n]; s += (x[0] * x[0] + x[1] * x[1]) + (x[2] * x[2] + x[3] * x[3]); }
                    s += __shfl_xor(s, 16); s += __shfl_xor(s, 32);
                    if (fq == 0) SS[(size_t)row * 12 + (u.pn < 2 ? u.pn * 4 + wc : 8 + wc)] = s; }
#pragma unroll
                for (int bj = 0; bj < 2; ++bj) { f32x4 v0 = acc[ai][bj][m][0], v1 = acc[ai][bj][m][1];
                    if (bj == 0 && u.pn == 3 && wc < 2) rope8(v0, v1, RT, row & (SEQ - 1), 16 * wc + 4 * fq);
                    *(u32x4*)(rowp + bj * HALF) = pack8(v0, v1); }
                asm volatile("" ::: "memory"); }
    }
};
struct EpiQ {
    static constexpr bool PERM = true;
    bf16_t* Q; const float* RT; const float* SS;
    __device__ __forceinline__ void operator()(const f32x4 (&acc)[2][2][4][2], const Unit& u) const {
        const int tid_ = tid_opaque(), wid_ = __builtin_amdgcn_readfirstlane(tid_ >> 6), wr = wid_ >> 2, wc = wid_ & 3, fr = tid_ & 15, fq = (tid_ & 63) >> 4;
        const int row0 = u.pm * BM + wr * 64 + fr, col0 = u.pn * BM + wc * 32 + 8 * fq;
        float rs[8];
#pragma unroll
        for (int i = 0; i < 8; ++i) { const int row = row0 + (i >> 2) * HALF + (i & 3) * 16;
            const f32x4 s0 = *(const f32x4*)(SS + (size_t)row * 12), s1 = *(const f32x4*)(SS + (size_t)row * 12 + 4);
            rs[i] = 1.0f / sqrtf((((s0[0] + s0[1]) + (s0[2] + s0[3])) + ((s1[0] + s1[1]) + (s1[2] + s1[3]))) * (1.f / QR) + RMS_EPS); }
#pragma unroll
        for (int ai = 0; ai < 2; ++ai)
#pragma unroll
            for (int m = 0; m < 4; ++m) { const int row = row0 + ai * HALF + m * 16; bf16_t* rowp = Q + (size_t)row * 1536 + col0;
#pragma unroll
                for (int bj = 0; bj < 2; ++bj) { f32x4 v0 = acc[ai][bj][m][0] * rs[ai * 4 + m], v1 = acc[ai][bj][m][1] * rs[ai * 4 + m]; const int jh = (col0 + bj * HALF) % QHD;
                    if (jh >= 128) rope8(v0, v1, RT, row & (SEQ - 1), (jh - 128) >> 1);
                    *(u32x4*)(rowp + bj * HALF) = pack8(v0, v1); }
                asm volatile("" ::: "memory"); }
    }
};
struct EpiKV {
    static constexpr bool PERM = true;
    bf16_t* O; const float* SS;
    __device__ __forceinline__ void operator()(const f32x4 (&acc)[2][2][4][2], const Unit& u) const {
        const int tid_ = tid_opaque(), wid_ = __builtin_amdgcn_readfirstlane(tid_ >> 6), wr = wid_ >> 2, wc = wid_ & 3, fr = tid_ & 15, fq = (tid_ & 63) >> 4;
        const int row0 = u.pm * BM + wr * 64 + fr, col0 = u.pn * BM + wc * 32 + 8 * fq;
        float rs[8];
#pragma unroll
        for (int i = 0; i < 8; ++i) { const int row = row0 + (i >> 2) * HALF + (i & 3) * 16; const f32x4 s0 = *(const f32x4*)(SS + (size_t)row * 12 + 8);
            rs[i] = 1.0f / sqrtf(((s0[0] + s0[1]) + (s0[2] + s0[3])) * (1.f / KVR) + RMS_EPS); }
#pragma unroll
        for (int ai = 0; ai < 2; ++ai)
#pragma unroll
            for (int m = 0; m < 4; ++m) { const int row = row0 + ai * HALF + m * 16; bf16_t* rowp = O + (size_t)row * 2048 + col0;
#pragma unroll
                for (int bj = 0; bj < 2; ++bj) *(u32x4*)(rowp + bj * HALF) = pack8(acc[ai][bj][m][0] * rs[ai * 4 + m], acc[ai][bj][m][1] * rs[ai * 4 + m]); }
    }
};
struct EpiOut {
    static constexpr bool PERM = true;
    bf16_t* Y;
    __device__ __forceinline__ void operator()(const f32x4 (&acc)[2][2][4][2], const Unit& u) const {
        const int tid_ = tid_opaque(), wid_ = __builtin_amdgcn_readfirstlane(tid_ >> 6), wr = wid_ >> 2, wc = wid_ & 3, fr = tid_ & 15, fq = (tid_ & 63) >> 4;
        const int row0 = u.pm * BM + wr * 64 + fr, col0 = u.pn * BM + wc * 32 + 8 * fq;
#pragma unroll
        for (int ai = 0; ai < 2; ++ai)
#pragma unroll
            for (int m = 0; m < 4; ++m) { bf16_t* rowp = Y + (size_t)(row0 + ai * HALF + m * 16) * DM + col0;
#pragma unroll
                for (int bj = 0; bj < 2; ++bj) *(u32x4*)(rowp + bj * HALF) = pack8(acc[ai][bj][m][0], acc[ai][bj][m][1]); }
    }
};
struct EpiMoe1 {
    static constexpr bool PERM = true;
    bf16_t* HID; const int* LIST; const float* WGT;
    __device__ __forceinline__ void operator()(const f32x4 (&acc)[2][2][4][2], const Unit& u) const {
        const int tid_ = tid_opaque(), wid_ = __builtin_amdgcn_readfirstlane(tid_ >> 6), wr = wid_ >> 2, wc = wid_ & 3, fr = tid_ & 15, fq = (tid_ & 63) >> 4;
        const int r0 = wr * 64 + fr, col0 = (u.pn & 3) * 128 + wc * 32 + 8 * fq;
        int sl[8]; float w[8];
#pragma unroll
        for (int i = 0; i < 8; ++i) { const int idx = u.mt * BM + r0 + (i >> 2) * HALF + (i & 3) * 16; sl[i] = idx < u.cnt ? LIST[u.e * NT + idx] : -1; }
#pragma unroll
        for (int i = 0; i < 8; ++i) w[i] = sl[i] >= 0 ? WGT[sl[i]] : 0.f;
#pragma unroll
        for (int ai = 0; ai < 2; ++ai)
#pragma unroll
            for (int m = 0; m < 4; ++m) { const int rl = r0 + ai * HALF + m * 16; const float wv = w[ai * 4 + m];
                f32x4 h0, h1;
#pragma unroll
                for (int j = 0; j < 4; ++j) { h0[j] = silu_f(acc[ai][0][m][0][j]) * acc[ai][1][m][0][j] * wv; h1[j] = silu_f(acc[ai][0][m][1][j]) * acc[ai][1][m][1][j] * wv; }
                *(u32x4*)(HID + (size_t)(u.pm * BM + rl) * FF + col0) = pack8(h0, h1); }
    }
};
struct EpiMoe2 {
    static constexpr bool PERM = true;
    bf16_t* YS; const int* LIST;
    __device__ __forceinline__ void operator()(const f32x4 (&acc)[2][2][4][2], const Unit& u) const {
        const int tid_ = tid_opaque(), wid_ = __builtin_amdgcn_readfirstlane(tid_ >> 6), wr = wid_ >> 2, wc = wid_ & 3, fr = tid_ & 15, fq = (tid_ & 63) >> 4;
        const int r0 = wr * 64 + fr, col0 = (u.pn & 7) * BM + wc * 32 + 8 * fq;
        int sl[8];
#pragma unroll
        for (int i = 0; i < 8; ++i) { const int idx = u.mt * BM + r0 + (i >> 2) * HALF + (i & 3) * 16; sl[i] = idx < u.cnt ? LIST[u.e * NT + idx] : -1; }
#pragma unroll
        for (int ai = 0; ai < 2; ++ai)
#pragma unroll
            for (int m = 0; m < 4; ++m) { const int slot = sl[ai * 4 + m];
                if (slot >= 0) { bf16_t* rowp = YS + (size_t)slot * DM + col0;
#pragma unroll
                    for (int bj = 0; bj < 2; ++bj) *(u32x4*)(rowp + bj * HALF) = pack8(acc[ai][bj][m][0], acc[ai][bj][m][1]); } }
    }
};
}

constexpr int CVT_NCHUNK_FWD = 3 * NE * 512 / 64, CVT_NCHUNK_ATT = 2 * NE * 512 / 64;
__device__ __forceinline__ void cvt_moe_chunk(const Args& a, LAS unsigned char* lds, int chunk);
namespace att {
typedef short bf16x8 __attribute__((ext_vector_type(8)));
typedef short s16x4 __attribute__((ext_vector_type(4)));
typedef float f32x16 __attribute__((ext_vector_type(16)));
constexpr int SHM_V = 16384, SHM_K = 16384, SHM_R = 8192;
constexpr int L_V = 0, L_K = 32768, L_R = 65536, L_WS = 81920, L_LUT = 83968, L_KM = 84992, L_QW = 93184, L_END = 93200;
constexpr float THR = 8.f;
#define KSWZ(row, colB) ((row) * 256 + ((colB) ^ (((row) & 7) << 4)))
#define SBAR() __builtin_amdgcn_sched_barrier(0)
__device__ __forceinline__ int v_st(int k, int c) { const int kk = (k & ~0xC) | ((k & 4) << 1) | ((k & 8) >> 1); return ((kk >> 3) * 4 + (c >> 5)) * 512 + ((kk & 7) * 32 + (c & 31)) * 2; }
__device__ __forceinline__ int v_rd_base(int lane) { return ((lane & 3) << 3) | (((lane >> 2) & 3) << 6) | (((lane >> 4) & 1) << 5) | (((lane >> 5) & 1) << 8); }
constexpr int v_rd_off(int d0, int ks, int half) { return d0 * 512 + ks * 4096 + half * 2048; }
__device__ __forceinline__ int crow(int r, int hi) { return (r & 3) + 8 * (r >> 2) + 4 * hi; }
__device__ __forceinline__ unsigned cvtpk(float lo, float hi) { unsigned r; asm volatile("v_cvt_pk_bf16_f32 %0, %1, %2" : "=v"(r) : "v"(lo), "v"(hi)); return r; }

template <int SC1000> __device__ __forceinline__ void partialSM(f32x16& p0, f32x16& p1, float& m_reg, float& alpha, float SCALE) {
    float pmax = p0[0];
#pragma unroll
    for (int r = 1; r < 16; ++r) pmax = fmaxf(pmax, p0[r]);
#pragma unroll
    for (int r = 0; r < 16; ++r) pmax = fmaxf(pmax, p1[r]);
    { auto rr = __builtin_amdgcn_permlane32_swap(__float_as_uint(pmax), __float_as_uint(pmax), false, false); pmax = fmaxf(__uint_as_float(rr[0]), __uint_as_float(rr[1])); }
    const float C2 = 1.4426950408889634f * SCALE; float mn;
    if (__builtin_expect(__all((pmax - m_reg) * SCALE <= THR), 1)) { mn = m_reg; alpha = 1.f; }
    else { mn = fmaxf(m_reg, pmax); alpha = __builtin_amdgcn_exp2f((m_reg - mn) * C2); m_reg = mn; }
    const float mnL = -mn * C2;
#pragma unroll
    for (int r = 0; r < 16; ++r) p0[r] = fmaf(p0[r], C2, mnL);
#pragma unroll
    for (int r = 0; r < 16; ++r) p1[r] = fmaf(p1[r], C2, mnL);
#pragma unroll
    for (int r = 0; r < 16; ++r) p0[r] = __builtin_amdgcn_exp2f(p0[r]);
}
__device__ __forceinline__ void finishSM(f32x16& p0, f32x16& p1, float alpha, float& l_reg, bf16x8& pa0, bf16x8& pa1, bf16x8& pa2, bf16x8& pa3) {
#pragma unroll
    for (int r = 0; r < 16; ++r) p1[r] = __builtin_amdgcn_exp2f(p1[r]);
    float ps = 0;
#pragma unroll
    for (int r = 0; r < 16; ++r) ps += p0[r];
#pragma unroll
    for (int r = 0; r < 16; ++r) ps += p1[r];
    { auto rr = __builtin_amdgcn_permlane32_swap(__float_as_uint(ps), __float_as_uint(ps), false, false); ps = __uint_as_float(rr[0]) + __uint_as_float(rr[1]); }
    l_reg = l_reg * alpha + ps;
#define PK4(P, B_, OUT) do { unsigned a0 = cvtpk(P[B_+0], P[B_+1]), a1 = cvtpk(P[B_+2], P[B_+3]);                          \
        unsigned b0 = cvtpk(P[B_+4], P[B_+5]), b1 = cvtpk(P[B_+6], P[B_+7]);                                             \
        auto r0 = __builtin_amdgcn_permlane32_swap(a0, b0, false, false); auto r1 = __builtin_amdgcn_permlane32_swap(a1, b1, false, false); \
        u32x4 w = {r0[0], r1[0], r0[1], r1[1]}; OUT = __builtin_bit_cast(bf16x8, w); } while (0)
    PK4(p0, 0, pa0); PK4(p0, 8, pa1); PK4(p1, 0, pa2); PK4(p1, 8, pa3);
#undef PK4
}
template <int KB, int NQ>
__device__ __forceinline__ void qkt(f32x16& p0, f32x16& p1, LAS const unsigned char* lds, int r32, int hi, const bf16x8* qr) {
    p0 = f32x16{}; p1 = f32x16{};
    LAS const unsigned char* kb[4];
#pragma unroll
    for (int dd = 0; dd < 4; ++dd) kb[dd] = lds + L_K + KB * SHM_K + KSWZ(r32, (dd * 16 + hi * 8) * 2);
#pragma unroll
    for (int d0 = 0; d0 < 8; ++d0) { LAS const unsigned char* p = kb[d0 & 3] + (d0 >> 2) * 128;
        const bf16x8 b0 = *(LAS const bf16x8*)p, b1 = *(LAS const bf16x8*)(p + 32 * 256);
        p0 = __builtin_amdgcn_mfma_f32_32x32x16_bf16(b0, qr[d0], p0, 0, 0, 0);
        p1 = __builtin_amdgcn_mfma_f32_32x32x16_bf16(b1, qr[d0], p1, 0, 0, 0); }
    if constexpr (NQ == 12) {
#pragma unroll
        for (int c = 0; c < 4; ++c) { LAS const unsigned char* p = lds + L_R + KB * SHM_R + r32 * 128 + ((c * 32 + hi * 16) ^ ((r32 & 7) << 4));
            const bf16x8 b0 = *(LAS const bf16x8*)p, b1 = *(LAS const bf16x8*)(p + 32 * 128);
            p0 = __builtin_amdgcn_mfma_f32_32x32x16_bf16(b0, qr[8 + c], p0, 0, 0, 0);
            p1 = __builtin_amdgcn_mfma_f32_32x32x16_bf16(b1, qr[8 + c], p1, 0, 0, 0); }
    }
}
template <int VB>
__device__ __forceinline__ void pv_tile(f32x16* o, int vb0, bf16x8 pa0, bf16x8 pa1, bf16x8 pa2, bf16x8 pa3) {
#define TRRD(dst, off) asm volatile("ds_read_b64_tr_b16 %0, %1 offset:%2" : "=&v"(dst) : "v"(vb0), "i"(off) : "memory")
#define PV_D0(d0) do { s16x4 l0, l1, l2, l3, h0, h1, h2, h3; constexpr int b_ = L_V + VB * SHM_V + v_rd_off(d0, 0, 0);   \
        TRRD(l0, b_); TRRD(h0, b_ + 2048); TRRD(l1, b_ + 4096); TRRD(h1, b_ + 6144); TRRD(l2, b_ + 8192); TRRD(h2, b_ + 10240); TRRD(l3, b_ + 12288); TRRD(h3, b_ + 14336); \
        asm volatile("s_waitcnt lgkmcnt(0)" ::: "memory"); SBAR();                                                           \
        o[d0] = __builtin_amdgcn_mfma_f32_32x32x16_bf16(pa0, (bf16x8){l0[0], l0[1], l0[2], l0[3], h0[0], h0[1], h0[2], h0[3]}, o[d0], 0, 0, 0);   \
        o[d0] = __builtin_amdgcn_mfma_f32_32x32x16_bf16(pa1, (bf16x8){l1[0], l1[1], l1[2], l1[3], h1[0], h1[1], h1[2], h1[3]}, o[d0], 0, 0, 0);   \
        o[d0] = __builtin_amdgcn_mfma_f32_32x32x16_bf16(pa2, (bf16x8){l2[0], l2[1], l2[2], l2[3], h2[0], h2[1], h2[2], h2[3]}, o[d0], 0, 0, 0);   \
        o[d0] = __builtin_amdgcn_mfma_f32_32x32x16_bf16(pa3, (bf16x8){l3[0], l3[1], l3[2], l3[3], h3[0], h3[1], h3[2], h3[3]}, o[d0], 0, 0, 0); } while (0)
    PV_D0(0); PV_D0(1); PV_D0(2); PV_D0(3);
#undef PV_D0
#undef TRRD
}

template <bool MLA>
__device__ __forceinline__ void attn_unit(const Args& a, LAS unsigned char* lds, int bh, int qt) {
    constexpr int NQ = MLA ? 12 : 8;
    constexpr float SCALE = MLA ? 0.07216878364870322f : 0.08838834764831845f;
    const int tid = tid_opaque(), wid = __builtin_amdgcn_readfirstlane(tid >> 6), lane = tid & 63, r32 = lane & 31, hi = lane >> 5;
    const int b = bh >> 3, h = bh & 7, q0 = qt * 256; const size_t rb = (size_t)b * SEQ;
    const bf16* PROJ = (const bf16*)(a.ws + WS_PROJ); const bf16* KV = (const bf16*)(a.ws + WS_KV); const bf16* QM = (const bf16*)(a.ws + WS_QM); bf16* ATT = (bf16*)(a.ws + WS_ATT);
    const bf16* Qp = MLA ? QM + (rb + q0 + wid * 32 + r32) * 1536 + h * QHD : PROJ + (rb + q0 + wid * 32 + r32) * PROJ_N + PC_QMO + h * 128;
    const int ldk = MLA ? 2048 : PROJ_N;
    const bf16* Kp = MLA ? KV + rb * 2048 + h * 256 : PROJ + rb * PROJ_N + PC_KMO + h * 128;
    const bf16* Vp = MLA ? KV + rb * 2048 + h * 256 + 128 : PROJ + rb * PROJ_N + PC_VMO + h * 128;
    const bf16* Rp = PROJ + rb * PROJ_N + PC_KR;
    bf16x8 qr[NQ];
#pragma unroll
    for (int d0 = 0; d0 < NQ; ++d0) qr[d0] = *(const bf16x8*)(Qp + d0 * 16 + hi * 8);
    LAS float* wsf = (LAS float*)(lds + L_WS) + wid * 64; LAS float* li_l = wsf; LAS float* al_l = wsf + 32;
    LAS float* LUT = (LAS float*)(lds + L_LUT); LAS float* KMl = (LAS float*)(lds + L_KM);
    unsigned selmask = 0u; float farb = 0.f;
    if constexpr (!MLA) {
        const float invs = 1.0f / SCALE;
        if (tid <= 128) LUT[tid] = a.t5[t5_bucket(tid < 128 ? tid : 128) * NH + h] * invs;
        const float* KMg = (const float*)(a.ws + WS_KMEAN) + (size_t)bh * NBLK * 128;
        for (int i = tid; i < qt * 128; i += 512) KMl[i] = KMg[i];
        farb = a.t5[31 * NH + h] * invs;
        __syncthreads();
        float g[16];
#pragma unroll
        for (int jb = 0; jb < 16; ++jb) { g[jb] = -INFINITY;
            if (jb < qt) { float s = 0.f;
#pragma unroll
                for (int d0 = 0; d0 < 8; ++d0) { const f32x4 k0 = *(LAS const f32x4*)(KMl + jb * 128 + 16 * d0 + 8 * hi), k1 = *(LAS const f32x4*)(KMl + jb * 128 + 16 * d0 + 8 * hi + 4);
                    const u32x4 qu = __builtin_bit_cast(u32x4, qr[d0]);
                    s += __uint_as_float(qu[0] << 16) * k0[0] + __uint_as_float(qu[0] & 0xffff0000u) * k0[1] + __uint_as_float(qu[1] << 16) * k0[2] + __uint_as_float(qu[1] & 0xffff0000u) * k0[3];
                    s += __uint_as_float(qu[2] << 16) * k1[0] + __uint_as_float(qu[2] & 0xffff0000u) * k1[1] + __uint_as_float(qu[3] << 16) * k1[2] + __uint_as_float(qu[3] & 0xffff0000u) * k1[3]; }
                s += __shfl_xor(s, 32); g[jb] = s; } }
        const int nsel = qt < 3 ? qt : 3;
#pragma unroll
        for (int s = 0; s < 3; ++s) if (s < nsel) { float best = -INFINITY; int bi = 0;
#pragma unroll
            for (int jb = 0; jb < 16; ++jb) { const bool ok = jb < qt && !((selmask >> jb) & 1u) && g[jb] > best; best = ok ? g[jb] : best; bi = ok ? jb : bi; }
            selmask |= 1u << bi; }
    }
    const int sr = tid >> 4, sc = (tid & 15) * 8, vst0 = v_st(sr, sc), vst1 = v_st(32 + sr, sc), kws = KSWZ(sr, sc * 2);
    const int rrow = tid >> 3, rch = tid & 7, rws = rrow * 128 + ((rch * 16) ^ ((rrow & 7) << 4));
    const int vb0 = (int)(unsigned)(uintptr_t)lds + v_rd_base(lane);
    bf16x8 st_k0, st_k1, st_v0, st_v1, st_r;
#define SLOAD(tt) do { const size_t kr_ = (size_t)((tt) * 64 + sr); st_k0 = *(const bf16x8*)(Kp + kr_ * ldk + sc); st_k1 = *(const bf16x8*)(Kp + (kr_ + 32) * ldk + sc);      \
        st_v0 = *(const bf16x8*)(Vp + kr_ * ldk + sc); st_v1 = *(const bf16x8*)(Vp + (kr_ + 32) * ldk + sc);                                                          \
        if constexpr (MLA) st_r = *(const bf16x8*)(Rp + (size_t)((tt) * 64 + rrow) * PROJ_N + rch * 8); } while (0)
#define SWRITE(bf) do { *(LAS bf16x8*)(lds + L_K + (bf) * SHM_K + kws) = st_k0; *(LAS bf16x8*)(lds + L_K + (bf) * SHM_K + kws + 32 * 256) = st_k1;                       \
        *(LAS bf16x8*)(lds + L_V + (bf) * SHM_V + vst0) = st_v0; *(LAS bf16x8*)(lds + L_V + (bf) * SHM_V + vst1) = st_v1;                                              \
        if constexpr (MLA) *(LAS bf16x8*)(lds + L_R + (bf) * SHM_R + rws) = st_r; } while (0)
    const int NTL = 4 * (qt + 1);
    const int qlo = q0 + wid * 32, qpos = qlo + r32;
    float m_reg = -1e30f, l_reg = 0.f; f32x16 o[4] = {};
    SLOAD(0); SWRITE(0);
    __syncthreads();
#define STEP(t, BUF) do {                                                                                                                                             \
        const int kbase_ = (t) * 64; const bool more_ = (t) + 1 < NTL;                                                                                               \
        if (more_) SLOAD((t) + 1);                                                                                                                                    \
        bool act_ = kbase_ <= qlo + 31;                                                                                                                               \
        bool sel_ = true;                                                                                                                                             \
        if constexpr (!MLA) { if (kbase_ < q0) { sel_ = ((selmask >> (kbase_ >> 8)) & 1u) != 0u; act_ = __any(sel_) != 0; } }                                         \
        if (act_) {                                                                                                                                                   \
            f32x16 p0, p1; float alpha; bf16x8 pa0, pa1, pa2, pa3;                                                                                                    \
            __builtin_amdgcn_s_setprio(1); qkt<BUF, NQ>(p0, p1, lds, r32, hi, qr); __builtin_amdgcn_s_setprio(0);                                                  \
            const int dq_ = qpos - kbase_ - 4 * hi;                                                                                                                   \
            if constexpr (!MLA) {                                                                                                                                     \
                if (kbase_ + 63 + 128 > qlo) {                                                                                                                        \
                    _Pragma("unroll") for (int r = 0; r < 16; ++r) { const int c = (r & 3) + 8 * (r >> 2); int i0 = dq_ - c, i1 = dq_ - c - 32;                       \
                        i0 = i0 < 0 ? 0 : (i0 > 128 ? 128 : i0); i1 = i1 < 0 ? 0 : (i1 > 128 ? 128 : i1); p0[r] += LUT[i0]; p1[r] += LUT[i1]; }                       \
                } else { _Pragma("unroll") for (int r = 0; r < 16; ++r) { p0[r] += farb; p1[r] += farb; } }                                                           \
                if (!sel_) { _Pragma("unroll") for (int r = 0; r < 16; ++r) { p0[r] = -INFINITY; p1[r] = -INFINITY; } }                                               \
            }                                                                                                                                                         \
            if (kbase_ + 63 > qlo) {                                                                                                                                  \
                _Pragma("unroll") for (int r = 0; r < 16; ++r) { const int c = (r & 3) + 8 * (r >> 2); if (dq_ - c < 0) p0[r] = -INFINITY; if (dq_ - c - 32 < 0) p1[r] = -INFINITY; } \
            }                                                                                                                                                         \
            partialSM<0>(p0, p1, m_reg, alpha, SCALE);                                                                                                                \
            if (__any(alpha < 1.f)) { if (hi == 0) al_l[r32] = alpha; asm volatile("s_waitcnt lgkmcnt(0)" ::: "memory");                                              \
                _Pragma("unroll") for (int d_ = 0; d_ < 4; ++d_) _Pragma("unroll") for (int r = 0; r < 16; ++r) o[d_][r] *= al_l[crow(r, hi)]; }                      \
            finishSM(p0, p1, alpha, l_reg, pa0, pa1, pa2, pa3); SBAR();                                                                                               \
            __builtin_amdgcn_s_setprio(1); pv_tile<BUF>(o, vb0, pa0, pa1, pa2, pa3); __builtin_amdgcn_s_setprio(0);                                                \
        }                                                                                                                                                             \
        if (more_) SWRITE((BUF) ^ 1);                                                                                                                                 \
        __syncthreads(); } while (0)
    for (int t = 0; t < NTL; t += 2) { STEP(t, 0); STEP(t + 1, 1); }
#undef STEP
#undef SLOAD
#undef SWRITE
    if (hi == 0) li_l[r32] = l_reg;
    asm volatile("s_waitcnt lgkmcnt(0)" ::: "memory");
    bf16* Ow = ATT + (rb + q0 + wid * 32) * DM + (MLA ? 0 : 1024) + h * 128;
#pragma unroll
    for (int r = 0; r < 16; ++r) { const int orow = crow(r, hi); const float rl = __builtin_amdgcn_rcpf(li_l[orow]);
#pragma unroll
        for (int d0 = 0; d0 < 4; ++d0) { const float v = o[d0][r] * rl; const float vn = __shfl_xor(v, 1);
            if ((r32 & 1) == 0) *(unsigned*)(Ow + (size_t)orow * DM + d0 * 32 + r32) = cvtpk(v, vn); } }
}
__device__ __forceinline__ void attn_phase(const Args& a, LAS unsigned char* lds, int qi) {
    unsigned* queue = (unsigned*)(a.ws + WS_CTL) + CW_QUEUE + 64 * qi;
    volatile LAS unsigned* qw = (volatile LAS unsigned*)(lds + L_QW);
    for (;;) {
        if (threadIdx.x == 0) qw[0] = __hip_atomic_fetch_add(queue, 1u, __ATOMIC_RELAXED, __HIP_MEMORY_SCOPE_AGENT);
        __syncthreads();
        const unsigned u = (unsigned)__builtin_amdgcn_readfirstlane((int)qw[0]);
        __syncthreads();
        if (u >= 512u + (unsigned)CVT_NCHUNK_ATT) break;
        static_assert(CVT_NCHUNK_ATT == 512, "queue interleave assumes as many w1/w3 chunks as attention units");
        unsigned ua;
        if (u < 256u) ua = u;
        else { const unsigned v = u - 256u, g = v / 3u, r = v - 3u * g; if (r != 0u) { cvt_moe_chunk(a, lds, (int)(2u * g + r - 1u)); continue; } ua = 256u + g; }
        const int cls = (int)(ua >> 4), bh = (int)(ua & 15u);
        const unsigned tybits = 0x54aa552fu;
        const int qts[32] = {15,14,13,12,15,11,14,13,10,12,9,11,8,10,7,9,8,6,7,5,6,4,5,3,4,3,2,2,1,1,0,0};
        int qt = 0;
#pragma unroll
        for (int c = 0; c < 32; ++c) qt = (cls == c) ? qts[c] : qt;
        if ((tybits >> cls) & 1u) attn_unit<true>(a, lds, bh, qt); else attn_unit<false>(a, lds, bh, qt);
    }
}
#undef KSWZ
#undef SBAR
}

constexpr int RING_OFF = 0, RING_BYTES = 131072, SCR_OFF = 131072, MISC_OFF = 139264, LDS_BYTES = 147456;
constexpr int CW_BAR = 4096;
#define LDS_WAIT() asm volatile("s_waitcnt lgkmcnt(0)" ::: "memory")

#define XB_TMO      128
#define XB_XCNT(j)  (256  + 64 * (j))
#define XB_XSUB(j)  (1280 + 64 * (j))
#define XB_XGEN(j)  (2304 + 64 * (j))
#define XB_TOP      3328
#define XB_TOPGEN   3392
#define XCD_BAR_WORDS 3456
#define XB_SPIN_CAP (1u << 18)

__device__ __forceinline__ unsigned xb_ld(unsigned* p)              { return __hip_atomic_load(p, __ATOMIC_RELAXED, __HIP_MEMORY_SCOPE_AGENT); }
__device__ __forceinline__ unsigned xb_add(unsigned* p, unsigned v) { return __hip_atomic_fetch_add(p, v, __ATOMIC_RELAXED, __HIP_MEMORY_SCOPE_AGENT); }
__device__ __forceinline__ unsigned xb_xcc_id() { return (unsigned)__builtin_amdgcn_s_getreg((3 << 11) | 20) & 0xFu; }
#define XB_SPIN(cond, bar) do { unsigned _sp = 0; while (cond) { __builtin_amdgcn_s_sleep(1); \
    if ((++_sp & 255u) == 0u) { if (xb_ld(&(bar)[XB_TMO])) break; if (_sp > XB_SPIN_CAP) { atomicAdd(&(bar)[XB_TMO], 1u); break; } } } } while (0)

struct XcdBarrier {
    unsigned* bar; unsigned x;
    volatile LAS unsigned* st;
};
__device__ __forceinline__ XcdBarrier xcd_barrier_post(unsigned* bar, volatile LAS unsigned* st) {
    XcdBarrier b; b.bar = bar; b.x = xb_xcc_id(); b.st = st;
    if (threadIdx.x == 0) (void)xb_add(&bar[XB_XCNT(b.x)], 1u);
    return b;
}
__device__ __forceinline__ void xcd_barrier_complete(unsigned* bar, unsigned x, unsigned& nloc, unsigned& nx) {
    const unsigned G = gridDim.x * gridDim.y * gridDim.z;
    unsigned sum, cnt, mine, sp = 0u;
    for (;;) {
        sum = 0u; cnt = 0u; mine = 0u;
#pragma unroll
        for (unsigned j = 0; j < 16; ++j) { const unsigned c = xb_ld(&bar[XB_XCNT(j)]); sum += c; cnt += (c > 0u) ? 1u : 0u; mine = (j == x) ? c : mine; }
        if (sum == G) break;
        __builtin_amdgcn_s_sleep(1);
        if ((++sp & 255u) == 0u) { if (xb_ld(&bar[XB_TMO])) break; if (sp > XB_SPIN_CAP) { atomicAdd(&bar[XB_TMO], 1u); break; } }
    }
    nloc = mine > 0u ? mine : 1u; nx = cnt > 0u ? cnt : 1u;
}
__device__ __forceinline__ void xcd_barrier(const XcdBarrier& b) {
    asm volatile("s_waitcnt vmcnt(0)" ::: "memory");
    __syncthreads();
    if (threadIdx.x == 0) {
        unsigned* bar = b.bar;
        __builtin_amdgcn_s_waitcnt(0);
        unsigned nloc = b.st[0], nx = b.st[1];
        if (nloc == 0u) { xcd_barrier_complete(bar, b.x, nloc, nx); b.st[0] = nloc; b.st[1] = nx; }
        const unsigned old = xb_add(&bar[XB_XSUB(b.x)], 1u);
        const unsigned gen = old / nloc;
        if (old + 1u == (gen + 1u) * nloc) {
            __builtin_amdgcn_fence(__ATOMIC_RELEASE, "agent");
            asm volatile("s_waitcnt vmcnt(0)" ::: "memory");
            const unsigned og = xb_add(&bar[XB_TOP], 1u);
            const unsigned tg = og / nx;
            if (og + 1u == (tg + 1u) * nx) xb_add(&bar[XB_TOPGEN], 1u);
            else XB_SPIN(xb_ld(&bar[XB_TOPGEN]) == tg, bar);
            __builtin_amdgcn_fence(__ATOMIC_ACQUIRE, "agent");
            xb_add(&bar[XB_XGEN(b.x)], 1u);
            asm volatile("s_waitcnt vmcnt(0)" ::: "memory");
        } else {
            XB_SPIN(xb_ld(&bar[XB_XGEN(b.x)]) == gen, bar);
            __builtin_amdgcn_fence(__ATOMIC_ACQUIRE, "agent");
            asm volatile("s_waitcnt vmcnt(0)" ::: "memory");
        }
    }
    __syncthreads();
}

struct CvtRegs { f32x4 a[4][2]; };
__device__ __forceinline__ void cvt_load(CvtRegs& v, const float* W, int ldw, int kb, int nb, int lane) {
    const float* p = W + (size_t)(64 * kb + 4 * (lane & 15)) * ldw + 32 * nb + 8 * (lane >> 4);
#pragma unroll
    for (int r = 0; r < 4; ++r) { v.a[r][0] = *(const f32x4*)(p + (size_t)r * ldw); v.a[r][1] = *(const f32x4*)(p + (size_t)r * ldw + 4); }
}
template <class RM> __device__ __forceinline__ void cvt_store(const CvtRegs& v, bf16* WT, int ldt, int kb, int nb, int lane, const float* gain, const RM& rm) {
    const int k0 = 64 * kb + 4 * (lane & 15), n0 = 32 * nb + 8 * (lane >> 4);
    float g[4];
#pragma unroll
    for (int r = 0; r < 4; ++r) g[r] = gain ? gain[k0 + r] : 1.0f;
#pragma unroll
    for (int c = 0; c < 8; ++c) { u32x2 o; o.x = pk2(v.a[0][c >> 2][c & 3] * g[0], v.a[1][c >> 2][c & 3] * g[1]); o.y = pk2(v.a[2][c >> 2][c & 3] * g[2], v.a[3][c >> 2][c & 3] * g[3]);
        *(u32x2*)(WT + (size_t)rm(n0 + c) * ldt + k0) = o; }
}
template <class RM> __device__ __forceinline__ void cvt_item(const float* W, int ldw, bf16* WT, int ldt, LAS float*, int kb, int nb, int lane, const float* gain, const RM& rm) {
    CvtRegs v; cvt_load(v, W, ldw, kb, nb, lane); cvt_store(v, WT, ldt, kb, nb, lane, gain, rm);
}
struct RmId { int base; __device__ __forceinline__ int operator()(int n) const { return base + n; } };
struct RmWin { __device__ __forceinline__ int operator()(int n) const { return n < 768 ? n : (n < 832 ? 768 + 2 * ((n - 768) & 31) + ((n - 768) >> 5) : n + 192); } };
struct RmUq { __device__ __forceinline__ int operator()(int n) const { const int h = n / QHD, j = n % QHD; return j < 128 ? n : h * QHD + 128 + 2 * ((j - 128) & 31) + ((j - 128) >> 5); } };
struct RmW13 { int base; __device__ __forceinline__ int operator()(int f) const { return base + (f >> 7) * 256 + (f & 127); } };
constexpr int CVT_MOE_ITEMS = 3 * NE * 512, CVT_CHUNK = 64, CVT_NCHUNK = CVT_MOE_ITEMS / CVT_CHUNK;
static_assert(CVT_NCHUNK == CVT_NCHUNK_FWD, "chunk count");
__device__ __forceinline__ void cvt_moe_load(const Args& a, CvtRegs& v, int r, int lane) {
    const int which = r >> 14, e = (r >> 9) & 31, q = r & 511;
    if (which == 0) cvt_load(v, a.w1 + (size_t)e * DM * FF, FF, q >> 4, q & 15, lane);
    else if (which == 1) cvt_load(v, a.w3 + (size_t)e * DM * FF, FF, q >> 4, q & 15, lane);
    else cvt_load(v, a.w2 + (size_t)e * FF * DM, DM, q >> 6, q & 63, lane);
}
__device__ __forceinline__ void cvt_moe_store(const Args& a, const CvtRegs& v, int r, int lane) {
    bf16* W13 = (bf16*)(a.ws + WS_W13); bf16* W2 = (bf16*)(a.ws + WS_W2);
    const int which = r >> 14, e = (r >> 9) & 31, q = r & 511;
    if (which == 0) cvt_store(v, W13, DM, q >> 4, q & 15, lane, nullptr, RmW13{e * 1024});
    else if (which == 1) cvt_store(v, W13, DM, q >> 4, q & 15, lane, nullptr, RmW13{e * 1024 + 128});
    else cvt_store(v, W2, FF, q >> 6, q & 63, lane, nullptr, RmId{e * DM});
}
__device__ __forceinline__ void cvt_moe_chunk(const Args& a, LAS unsigned char* lds, int chunk) {
    (void)lds;
    const int tid = tid_opaque(), lane = tid & 63, w = __builtin_amdgcn_readfirstlane(tid >> 6);
    const int r0 = chunk * CVT_CHUNK + w * (CVT_CHUNK / 8);
    CvtRegs va, vb;
    cvt_moe_load(a, va, r0, lane);
#pragma unroll 1
    for (int i = 0; i < CVT_CHUNK / 8; i += 2) {
        cvt_moe_load(a, vb, r0 + i + 1, lane);
        cvt_moe_store(a, va, r0 + i, lane);
        if (i + 2 < CVT_CHUNK / 8) cvt_moe_load(a, va, r0 + i + 2, lane);
        cvt_moe_store(a, vb, r0 + i + 1, lane);
    }
}
__device__ __forceinline__ void ph_convert(const Args& a, LAS unsigned char* lds, int wg, int nwg) {
    const int tid = tid_opaque(), lane = tid & 63, w = __builtin_amdgcn_readfirstlane(tid >> 6), gw = wg * 8 + w, NGW = nwg * 8;
    LAS float* scr = (LAS float*)(lds + w * 8448);
    bf16* WIN = (bf16*)(a.ws + WS_WIN); bf16* WUQ = (bf16*)(a.ws + WS_WUQ); bf16* WUKV = (bf16*)(a.ws + WS_WUKV); bf16* WOUT = (bf16*)(a.ws + WS_WOUT);
    constexpr int I_WIN = 32 * 122, I_WOUT = 32 * 64, I_WUQ = 8 * 48, I_WUKV = 4 * 64;
    constexpr int NITEMS = I_WIN + I_WOUT + I_WUQ + I_WUKV;
    for (int it = gw; it < NITEMS; it += NGW) {
        int r = it;
        if (r < I_WIN) { cvt_item(a.w_in, INCOLS, WIN, DM, scr, r / 122, r % 122, lane, nullptr, RmWin{}); continue; } r -= I_WIN;
        if (r < I_WOUT) { cvt_item(a.w_out, DM, WOUT, DM, scr, r >> 6, r & 63, lane, nullptr, RmId{0}); continue; } r -= I_WOUT;
        if (r < I_WUQ) { cvt_item(a.w_uq, 1536, WUQ, QR, scr, r / 48, r % 48, lane, a.qg, RmUq{}); continue; } r -= I_WUQ;
        cvt_item(a.w_ukv, 2048, WUKV, KVR, scr, r >> 6, r & 63, lane, a.kvg, RmId{0});
    }
    for (int i = wg * 512 + tid; i < 192 * DM / 8; i += nwg * 512) *(u32x4*)(WIN + (size_t)832 * DM + (size_t)i * 8) = (u32x4){0u, 0u, 0u, 0u};
    bf16* WRH = (bf16*)(a.ws + WS_WR); bf16* WRL = WRH + 48 * DM;
    for (int i = wg * 512 + tid; i < 48 * DM; i += nwg * 512) { const int n = i / DM, k = i % DM;
        const float v = n < 32 ? a.w_re[(size_t)k * 32 + n] : (n < 36 ? a.w_rg[(size_t)k * 4 + n - 32] : 0.f);
        const unsigned hb = f2bf(v); WRH[i] = (bf16)hb; WRL[i] = (bf16)f2bf(v - bf2f(hb)); }
}

#ifndef MK_REP
#define MK_REP 0
#endif
struct MArgs { Args a; int ph_lo, ph_hi, li, pad; };
__global__ void __launch_bounds__(512, 2) mega(MArgs m) {
    extern __shared__ __attribute__((aligned(16))) unsigned char lds_[];
    LAS unsigned char* lds = (LAS unsigned char*)lds_;
    volatile LAS unsigned* MISC = (volatile LAS unsigned*)(lds + MISC_OFF);
    const Args& a = m.a;
    const int tid = threadIdx.x, wg = blockIdx.x, nwg = gridDim.x;
    unsigned* ctl = (unsigned*)(a.ws + WS_CTL);
    if (tid < 64) MISC[tid] = 0u;
    __syncthreads();
    XcdBarrier bar = xcd_barrier_post(ctl + CW_BAR + m.li * XCD_BAR_WORDS, MISC + 8);
    const int lo = m.ph_lo, hi = m.ph_hi;
#define IN(k) (lo <= (k) && (k) < hi)
#define SEAM(k) do { if (IN(k) && IN((k) + 1)) xcd_barrier(bar); } while (0)
#define REPEAT(k) _Pragma("unroll") for (int rep_ = 0; rep_ < 1 + ((MK_REP >> (k)) & 1); ++rep_)
#define REP_BAR() do { if (rep_) xcd_barrier(bar); } while (0)
    unsigned char* ws = a.ws;
    const float* RT = (const float*)(ws + WS_ROPE); float* SS = (float*)(ws + WS_SS); const int* LIST = (const int*)(ws + WS_LIST);
    const unsigned* CNT = (const unsigned*)(ws + WS_CTL) + CW_CNT;

    if (IN(0)) REPEAT(0) { REP_BAR(); ph_mod(a, (LAS float*)(lds + SCR_OFF - 24576), wg, nwg); __syncthreads(); ph_rope_table(a, wg, nwg); ph_convert(a, lds, wg, nwg); }
    if (IN(1)) REPEAT(1) { REP_BAR(); wait_mod(a); ph_ln0(a, wg, nwg); }
    SEAM(1);
    if (IN(2)) REPEAT(2) { REP_BAR();
        pg8::Gemm g{(const bf16*)(ws + WS_H), (const bf16*)(ws + WS_WIN), DM, DM, DM}; pg8::StaticOrder S; S.init(NT, PROJ_N, nwg, wg);
        pg8::EpiProj E{(bf16*)(ws + WS_PROJ), RT, SS};
        pg8::gemm_phase<pg8::EpiProj, pg8::StaticOrder, pg8::ADense, true>(lds + RING_OFF, g, S, pg8::ADense{DM}, E);
    }
    SEAM(2);
    if (IN(3)) REPEAT(3) { REP_BAR();
        if (nwg == 256) { if (wg >= 192) ph_kmean(a, wg - 192, 64); } else ph_kmean(a, wg, nwg);
        {
            pg8::Gemm g{(const bf16*)(ws + WS_PROJ), (const bf16*)(ws + WS_WUQ), QR, PROJ_N, QR}; pg8::StaticOrder S; S.init(NT, 1536, nwg, wg);
            pg8::EpiQ E{(bf16*)(ws + WS_QM), RT, SS};
            pg8::gemm_phase<pg8::EpiQ, pg8::StaticOrder, pg8::ADense, true>(lds + RING_OFF, g, S, pg8::ADense{PROJ_N}, E);
        }
        {
            pg8::Gemm g{(const bf16*)(ws + WS_PROJ) + QR, (const bf16*)(ws + WS_WUKV), KVR, PROJ_N, KVR}; pg8::StaticOrder S; S.init(NT, 2048, nwg, wg);
            pg8::EpiKV E{(bf16*)(ws + WS_KV), SS};
            pg8::gemm_phase<pg8::EpiKV, pg8::StaticOrder, pg8::ADense, true>(lds + RING_OFF, g, S, pg8::ADense{PROJ_N}, E);
        }
    }
    SEAM(3);
    if (IN(4)) REPEAT(4) { REP_BAR(); att::attn_phase(a, lds, rep_); }
    SEAM(4);
    if (IN(5)) REPEAT(5) { REP_BAR();
        pg8::Gemm g{(const bf16*)(ws + WS_ATT), (const bf16*)(ws + WS_WOUT), DM, DM, DM}; pg8::StaticOrder S; S.init(NT, DM, nwg, wg);
        pg8::EpiOut E{(bf16*)(ws + WS_KV)};
        pg8::gemm_phase<pg8::EpiOut, pg8::StaticOrder, pg8::ADense, true>(lds + RING_OFF, g, S, pg8::ADense{DM}, E);
    }
    SEAM(5);
    if (IN(6)) ph_ln1_route(a, lds, wg, nwg);
    SEAM(6);
    if (IN(7)) REPEAT(7) { REP_BAR();
        pg8::Gemm g{(const bf16*)(ws + WS_H), (const bf16*)(ws + WS_W13), DM, DM, DM}; pg8::MoeOrder S{CNT, 4, nwg, wg};
        pg8::EpiMoe1 E{(bf16*)(ws + WS_QM), LIST, (const float*)(ws + WS_ROUTE + 65536)};
        pg8::gemm_phase<pg8::EpiMoe1, pg8::MoeOrder, pg8::AGather, true>(lds + RING_OFF, g, S, pg8::AGather{LIST, DM}, E);
        {   unsigned* queue = ctl + CW_QUEUE + 64 * (2 + rep_); volatile LAS unsigned* qw = (volatile LAS unsigned*)(lds + SCR_OFF);
            for (;;) {
                if (tid == 0) qw[0] = __hip_atomic_fetch_add(queue, 1u, __ATOMIC_RELAXED, __HIP_MEMORY_SCOPE_AGENT);
                __syncthreads();
                const unsigned u = (unsigned)__builtin_amdgcn_readfirstlane((int)qw[0]);
                __syncthreads();
                if (u >= (unsigned)(CVT_NCHUNK_FWD - CVT_NCHUNK_ATT)) break;
                cvt_moe_chunk(a, lds, CVT_NCHUNK_ATT + (int)u);
            } }
    }
    SEAM(7);
    if (IN(8)) REPEAT(8) { REP_BAR();
        pg8::Gemm g{(const bf16*)(ws + WS_QM), (const bf16*)(ws + WS_W2), FF, FF, FF}; pg8::MoeOrder S{CNT, 8, nwg, wg};
        pg8::EpiMoe2 E{(bf16*)(ws + WS_PROJ), LIST};
        pg8::gemm_phase<pg8::EpiMoe2, pg8::MoeOrder, pg8::ADense, true>(lds + RING_OFF, g, S, pg8::ADense{FF}, E);
    }
    SEAM(8);
    if (IN(9)) REPEAT(9) { REP_BAR(); ph_final(a, wg, nwg); }
#undef IN
#undef SEAM
#undef REPEAT
#undef REP_BAR
}

static const int USE_MEGA[10] = {1, 1, 1, 1, 1, 1, 1, 1, 1, 1};
extern "C" void kernel_launch(void* const* d_in, const int* in_sizes, int n_in, void* d_out, int out_size, void* d_ws, size_t ws_size, hipStream_t stream) {
    if (n_in != 22 || in_sizes[0] != NT * DM || out_size != NT * DM || ws_size < WS_END) { fprintf(stderr, "kernel_launch: unexpected shapes (n_in %d, in0 %d, out %d, ws %zu)\n", n_in, n_in > 0 ? in_sizes[0] : -1, out_size, ws_size); return; }
    Args a{};
    const float** ap = (const float**)&a;
    for (int i = 0; i < 22; ++i) ap[i] = (const float*)d_in[i];
    a.out = (float*)d_out; a.ws = (unsigned char*)d_ws;
    unsigned char* ws = a.ws;
    static int grid = 0;
    if (!grid) {
        (void)hipFuncSetAttribute((const void*)k_thin<6>, hipFuncAttributeMaxDynamicSharedMemorySize, P6_LDS);
        (void)hipFuncSetAttribute((const void*)mega, hipFuncAttributeMaxDynamicSharedMemorySize, LDS_BYTES);
        int dev = 0, cus = 0; (void)hipGetDevice(&dev); (void)hipDeviceGetAttribute(&cus, hipDeviceAttributeMultiprocessorCount, dev);
        grid = cus > 0 ? cus : 256;
    }
    (void)hipMemsetAsync(ws + WS_CTL, 0, CTL_ZERO_BYTES, stream);
    const unsigned* cnt = (const unsigned*)(ws + WS_CTL) + CW_CNT;
    int li = 0;
    for (int p = 0; p < 10;) {
        if (USE_MEGA[p]) { int q = p; while (q < 10 && USE_MEGA[q]) ++q;
            MArgs m{}; m.a = a; m.ph_lo = p; m.ph_hi = q; m.li = li++; m.pad = 0;
            hipLaunchKernelGGL(mega, dim3(grid), dim3(512), LDS_BYTES, stream, m);
            p = q; continue; }
        switch (p) {
        case 0: k_thin<0><<<256, 512, 32768, stream>>>(a); break;
        case 1: k_thin<1><<<256, 512, 0, stream>>>(a); break;
        case 2: nk_gemm<FProj><<<dim3(INCOLS / 64, NT / 64, 1), 256, 0, stream>>>(FProj{(const bf16*)(ws + WS_H), a.w_in, (float*)(ws + WS_W13)}, DM);
                nk_epi_proj<<<NT, 256, 0, stream>>>(a); break;
        case 3: nk_gemm<FQ><<<dim3(1536 / 64, NT / 64, 1), 256, 0, stream>>>(FQ{(const bf16*)(ws + WS_PROJ), a.w_uq, a.qg, (float*)(ws + WS_W13)}, QR);
                nk_epi_q<<<NT, 256, 0, stream>>>(a);
                nk_gemm<FKV><<<dim3(2048 / 64, NT / 64, 1), 256, 0, stream>>>(FKV{(const bf16*)(ws + WS_PROJ), a.w_ukv, a.kvg, (const float*)(ws + WS_SS), (bf16*)(ws + WS_KV)}, KVR);
                k_thin<3><<<256, 512, 0, stream>>>(a); break;
        case 4: nk_attn_mla<<<dim3(SEQ / 2, NH, NB), 128, 0, stream>>>(a);
                nk_attn_moba<<<dim3(SEQ / 4, NH, NB), 256, 0, stream>>>(a); break;
        case 5: nk_gemm<FOut><<<dim3(DM / 64, NT / 64, 1), 256, 0, stream>>>(FOut{(const bf16*)(ws + WS_ATT), a.w_out, (bf16*)(ws + WS_KV)}, DM); break;
        case 6: k_thin<6><<<256, 512, P6_LDS, stream>>>(a); break;
        case 7: nk_gemm<FMoe1><<<dim3(1024 / 64, NT / 64, NE), 256, 0, stream>>>(FMoe1{(const bf16*)(ws + WS_H), a.w1, a.w3, cnt, (const int*)(ws + WS_LIST), (float*)(ws + WS_W13)}, DM);
                nk_epi_moe1<<<dim3(NE, NT / 64), 256, 0, stream>>>(a); break;
        case 8: nk_gemm<FMoe2><<<dim3(DM / 64, NT / 64, NE), 256, 0, stream>>>(FMoe2{(const bf16*)(ws + WS_QM), a.w2, cnt, (const int*)(ws + WS_LIST), (bf16*)(ws + WS_PROJ)}, FF); break;
        case 9: k_thin<9><<<256, 512, 0, stream>>>(a); break;
        }
        ++p;
    }
}
```
